# Optimizing an MI355X kernel written in HIP

```python
import jax, jax.numpy as jnp
from jax import lax
import numpy as np

D_MODEL = 1024
BATCH = 16
SEQ = 4096
DEPTH = 1

PLE_DIM = 256
CHUNK = 128
RET_HEADS = 4
RET_V_DIM = D_MODEL // RET_HEADS
RET_QK_DIM = RET_V_DIM // 2
RET_WIDTH = RET_HEADS * RET_V_DIM
SGU_GROUPS = 4
SGU_WIDTH = D_MODEL
SGU_GROUP_DIM = SGU_WIDTH // SGU_GROUPS
ROPE_BASE = 10000.0
NORM_EPS = 1e-6
GN_EPS = 1e-5
IN_SPLITS = (RET_HEADS * RET_QK_DIM, RET_HEADS * RET_QK_DIM, RET_WIDTH, RET_WIDTH,
             SGU_WIDTH, SGU_WIDTH, SGU_WIDTH, D_MODEL, D_MODEL)
IN_WIDTH = sum(IN_SPLITS)

kernel_name = 'hybrid_retention_sgu_block'


def rms_norm(x, g):
    xf = x.astype(jnp.float32)
    y = xf * lax.rsqrt(jnp.mean(xf * xf, axis=-1, keepdims=True) + NORM_EPS)
    return (y * g.astype(jnp.float32)).astype(x.dtype)


def unit_norm(x, eps):
    xf = x.astype(jnp.float32)
    mu = jnp.mean(xf, axis=-1, keepdims=True)
    var = jnp.mean(jnp.square(xf - mu), axis=-1, keepdims=True)
    return ((xf - mu) * lax.rsqrt(var + eps)).astype(x.dtype)


def rotary(x):
    s, d = x.shape[1], x.shape[-1]
    half = d // 2
    inv = ROPE_BASE ** (-jnp.arange(half, dtype=jnp.float32) / half)
    ang = jnp.arange(s, dtype=jnp.float32)[:, None] * inv[None, :]
    cos = jnp.cos(ang)[None, :, None, :].astype(x.dtype)
    sin = jnp.sin(ang)[None, :, None, :].astype(x.dtype)
    x1, x2 = x[..., :half], x[..., half:]
    return jnp.concatenate([x1 * cos - x2 * sin, x2 * cos + x1 * sin], axis=-1)


def retention(q, k, v):
    b, s, h, dk = q.shape
    dv = v.shape[-1]
    n = s // CHUNK
    log_g = jnp.log(1.0 - 2.0 ** (-5.0 - jnp.arange(h, dtype=jnp.float32)))
    idx = jnp.arange(CHUNK, dtype=jnp.float32)
    diff = idx[:, None] - idx[None, :]
    decay_in = jnp.where(diff[None] >= 0,
                         jnp.exp(jnp.maximum(diff, 0.0)[None] * log_g[:, None, None]),
                         0.0).astype(q.dtype)
    zeta = jnp.exp((CHUNK - 1.0 - idx)[:, None] * log_g[None, :]).astype(q.dtype)
    xi = jnp.exp((idx + 1.0)[:, None] * log_g[None, :]).astype(q.dtype)
    chunk_decay = jnp.exp(CHUNK * log_g).astype(v.dtype)

    qc = (q * (dk ** -0.5)).reshape(b, n, CHUNK, h, dk)
    kc = k.reshape(b, n, CHUNK, h, dk)
    vc = v.reshape(b, n, CHUNK, h, dv)

    scores = jnp.einsum('bnihd,bnjhd->bnhij', qc, kc) * decay_in
    inner = jnp.einsum('bnhij,bnjhe->bnihe', scores, vc)

    kv = jnp.einsum('bnjhd,bnjhe->nbhde', kc * zeta[:, :, None], vc)

    def step(state, kv_n):
        return kv_n + chunk_decay[None, :, None, None] * state, state

    _, prev = lax.scan(step, jnp.zeros_like(kv[0]), kv)
    cross = jnp.einsum('bnihd,nbhde->bnihe', qc * xi[:, :, None], prev)
    return (inner + cross).reshape(b, s, h, dv)


def spatial_gating(u, v, ws, bs):
    b, s, _ = u.shape
    n = s // CHUNK
    v = unit_norm(v, GN_EPS).reshape(b, n, CHUNK, SGU_GROUPS, SGU_GROUP_DIM)
    ws_causal = ws * jnp.tril(jnp.ones((CHUNK, CHUNK), ws.dtype))[None]
    mixed = jnp.einsum('gij,bnjgd->bnigd', ws_causal, v) + bs.T[None, None, :, :, None]
    return u * mixed.reshape(b, s, SGU_WIDTH)


def setup_inputs(seed: int = 0) -> dict:
    key = jax.random.key(seed)
    ks = jax.random.split(key, 13)
    f32 = jnp.float32
    nrm = lambda k, shape, scale: jax.random.normal(k, shape, f32) * scale
    return {
        'x': jax.random.normal(ks[0], (BATCH, SEQ, D_MODEL), f32),
        'p': jax.random.normal(ks[1], (DEPTH, BATCH, SEQ, PLE_DIM), f32),
        'w_in': nrm(ks[2], (DEPTH, D_MODEL, IN_WIDTH), D_MODEL ** -0.5),
        'w_ret_out': nrm(ks[3], (DEPTH, RET_WIDTH, D_MODEL), RET_WIDTH ** -0.5),
        'w_sgu_out': nrm(ks[4], (DEPTH, SGU_WIDTH, D_MODEL), SGU_WIDTH ** -0.5),
        'w_out': nrm(ks[5], (DEPTH, D_MODEL, D_MODEL), D_MODEL ** -0.5),
        'sgu_ws': nrm(ks[6], (DEPTH, SGU_GROUPS, CHUNK, CHUNK), CHUNK ** -0.5),
        'sgu_bs': 1.0 + nrm(ks[7], (DEPTH, SGU_GROUPS, CHUNK), 0.01),
        'w_ple_gate': nrm(ks[8], (DEPTH, D_MODEL, D_MODEL), D_MODEL ** -0.5),
        'w_ple_proj': nrm(ks[9], (DEPTH, PLE_DIM, D_MODEL), PLE_DIM ** -0.5),
        'g_mixer': 1.0 + nrm(ks[10], (DEPTH, D_MODEL), 0.05),
        'g_ple': 1.0 + nrm(ks[11], (DEPTH, D_MODEL), 0.05),
        'g_final': 1.0 + nrm(ks[12], (D_MODEL,), 0.05),
    }


def reference(x, p, w_in, w_ret_out, w_sgu_out, w_out, sgu_ws, sgu_bs,
              w_ple_gate, w_ple_proj, g_mixer, g_ple, g_final):
    b, s, _ = x.shape
    split_at = np.cumsum(IN_SPLITS)[:-1].tolist()
    for i in range(DEPTH):
        h = rms_norm(x, g_mixer[i])
        proj = jnp.einsum('bsd,de->bse', h, w_in[i])
        q, k, v, ret_gate, su, sv, sgu_gate, merge_ret, merge_sgu = jnp.split(proj, split_at, axis=-1)

        q = rotary(q.reshape(b, s, RET_HEADS, RET_QK_DIM))
        k = rotary(k.reshape(b, s, RET_HEADS, RET_QK_DIM))
        ret = retention(q, k, v.reshape(b, s, RET_HEADS, RET_V_DIM))
        ret = unit_norm(ret, GN_EPS).reshape(b, s, RET_WIDTH) * jax.nn.silu(ret_gate)

        sgu = spatial_gating(jax.nn.gelu(su, approximate=False), jax.nn.gelu(sv, approximate=False),
                             sgu_ws[i], sgu_bs[i]) * jax.nn.silu(sgu_gate)

        merged = (jax.nn.sigmoid(merge_ret) * jnp.einsum('bse,ed->bsd', ret, w_ret_out[i])
                  + jax.nn.sigmoid(merge_sgu) * jnp.einsum('bse,ed->bsd', sgu, w_sgu_out[i]))
        x = x + jnp.einsum('bsd,de->bse', merged, w_out[i])

        ple_gate = jax.nn.sigmoid(jnp.einsum('bsd,de->bse', rms_norm(x, g_ple[i]), w_ple_gate[i]))
        x = x + ple_gate * jnp.einsum('bsp,pd->bsd', p[i], w_ple_proj[i])
    return rms_norm(x, g_final)
```

```cpp
#include <hip/hip_runtime.h>
#include <hip/hip_cooperative_groups.h>
#include <cstdio>
namespace cg = cooperative_groups;

#define LAS __attribute__((address_space(3)))
typedef unsigned short bf16_t;
typedef short bf16x8 __attribute__((ext_vector_type(8)));
typedef float f32x4 __attribute__((ext_vector_type(4)));
typedef float f32x2 __attribute__((ext_vector_type(2)));
typedef unsigned u32x4 __attribute__((ext_vector_type(4)));
typedef unsigned u32x2 __attribute__((ext_vector_type(2)));

constexpr int T_ALL = 65536, DM = 1024, NSL = 2, TS = T_ALL / NSL, BSL = 16 / NSL;
constexpr int NTHR = 512;
constexpr int LDS_STAGE = 131072, LDS_BYTES = LDS_STAGE + 16;
constexpr size_t MiB = 1ull << 20;
constexpr size_t UB = (size_t)TS * 1024 * 2;
constexpr size_t WS_WIN = 0, WS_WR = 16 * MiB, WS_WS = 18 * MiB, WS_WO = 20 * MiB, WS_WG = 22 * MiB, WS_WPP = 24 * MiB, WS_WC = 24 * MiB + 512 * 1024,
                 WS_COS = 25 * MiB, WS_SIN = 26 * MiB, WS_RSQ1 = 27 * MiB, WS_RSQ2 = 27 * MiB + 256 * 1024, WS_BAR = 28 * MiB,
                 WS_H = 32 * MiB, WS_PB = 160 * MiB, WS_SL = 192 * MiB;
constexpr size_t WS_QK = WS_SL, WS_V = WS_SL + UB, WS_SV = WS_SL + 2 * UB, WS_RG2 = WS_SL + 3 * UB, WS_UG2 = WS_SL + 5 * UB, WS_MR2 = WS_SL + 7 * UB, WS_MS2 = WS_SL + 9 * UB,
                 WS_PP = WS_SL + 11 * UB, WS_END = WS_SL + 13 * UB;
static_assert(WS_END == 1024 * MiB, "workspace map");

__device__ __forceinline__ unsigned cvt_pk_bf16(float lo, float hi) { unsigned r; asm volatile("v_cvt_pk_bf16_f32 %0, %1, %2" : "=v"(r) : "v"(lo), "v"(hi)); return r; }
__device__ __forceinline__ float bf_lo(unsigned w) { return __uint_as_float(w << 16); }
__device__ __forceinline__ float bf_hi(unsigned w) { return __uint_as_float(w & 0xffff0000u); }
__device__ __forceinline__ float bf2f(unsigned short b) { return __uint_as_float(((unsigned)b) << 16); }
__device__ __forceinline__ float wave_sum(float v) {
#pragma unroll
    for (int o = 32; o >= 1; o >>= 1) v += __shfl_xor(v, o);
    return v;
}
__device__ __forceinline__ float sigmoidf_(float x) { return __builtin_amdgcn_rcpf(1.0f + __builtin_amdgcn_exp2f(-1.4426950408889634f * x)); }
__device__ __forceinline__ float fexp(float x) { return __builtin_amdgcn_exp2f(1.4426950408889634f * x); }
__device__ __forceinline__ f32x2 gelu_pk(f32x2 v) {
    const f32x2 av = __builtin_elementwise_abs(v), d = av * 0.2316418882f + 1.0f;
    f32x2 t; t.x = __builtin_amdgcn_rcpf(d.x); t.y = __builtin_amdgcn_rcpf(d.y);
    f32x2 q = t * 0.5307027145f + (-0.7265760135f); q = q * t + 0.7107068705f; q = q * t + (-0.142248368f); q = q * t + 0.127414796f; q = q * t;
    const f32x2 s = (v * v) * (-0.72134752044f);
    f32x2 e; e.x = __builtin_amdgcn_exp2f(s.x); e.y = __builtin_amdgcn_exp2f(s.y);
    const f32x2 m = v * (q * e), r = v - m;
    f32x2 o; o.x = v.x < 0.f ? m.x : r.x; o.y = v.y < 0.f ? m.y : r.y; return o;
}
__device__ __forceinline__ f32x4 gelu4(f32x4 v) { f32x2 a = gelu_pk((f32x2){v[0], v[1]}), b = gelu_pk((f32x2){v[2], v[3]}); return (f32x4){a.x, a.y, b.x, b.y}; }
__device__ __forceinline__ f32x4 sig4(f32x4 v) { return (f32x4){sigmoidf_(v[0]), sigmoidf_(v[1]), sigmoidf_(v[2]), sigmoidf_(v[3])}; }
__device__ __forceinline__ float lgam(int h) { return h == 0 ? -0.03174869831458027f : h == 1 ? -0.01574835696813892f : h == 2 ? -0.007843177461025892f : -0.003913899321136329f; }

namespace pg8 {
constexpr int BM = 256, BK = 64, HALF = 128, HTB = HALF * BK * 2, STAGE_BYTES = 8 * HTB, NXCD = 8, WGM = 8;
__host__ __device__ __forceinline__ int lds_byte(int r, int c) { const int st = (r >> 4) * 2 + (c >> 5), rr = r & 15, cc = c & 31, ob = rr * 64 + cc * 2; return st * 1024 + (ob ^ (((ob >> 9) & 1) << 5)); }
__host__ __device__ __forceinline__ void stage_rc(int b, int& R, int& C) { const int st = b / 1024, sb = b % 1024, swz = sb ^ (((sb >> 9) & 1) << 5); R = (st >> 1) * 16 + swz / 64; C = (st & 1) * 32 + (swz % 64) / 2; }
__host__ __device__ __forceinline__ int perm32(int rho) { const int n = rho >> 4, i = rho & 15; return 8 * (i >> 2) + 4 * n + (i & 3); }

struct Unit { int pm, pn, part; };
struct StaticOrder {
    int nM, nN, nwg, G, c;
    __device__ void init(int M, int N, int G_, int c_) { nM = M / BM; nN = N / BM; nwg = nM * nN; G = G_; c = c_; }
    __device__ bool next(int i, Unit& u) const {
        const long L = (long)i * G + c; if (L >= nwg) return false;
        int wgid = (int)L; { const int q = nwg / NXCD, r = nwg % NXCD, xcd = wgid % NXCD, off = wgid / NXCD; wgid = (xcd < r ? xcd * (q + 1) : r * (q + 1) + (xcd - r) * q) + off; }
        const int nig = WGM * nN, gid = wgid / nig, fm = gid * WGM, gsz = (nM - fm) < WGM ? (nM - fm) : WGM;
        u.pm = fm + ((wgid % nig) % gsz); u.pn = (wgid % nig) / gsz; u.part = 0; return true;
    }
};
struct DualOrder : StaticOrder {
    __device__ bool next(int i, Unit& u) const { if (!StaticOrder::next(i >> 1, u)) return false; u.part = i & 1; return true; }
};
struct Src1 { const bf16_t* A; const bf16_t* Bt; int K;
    __device__ __forceinline__ const char* a(const Unit& u) const { return (const char*)A + (size_t)u.pm * BM * K * 2; }
    __device__ __forceinline__ const char* b(const Unit& u) const { return (const char*)Bt + (size_t)u.pn * BM * K * 2; } };
struct Src1V { const bf16_t* A; const bf16_t* Bt; int K;
    __device__ __forceinline__ const char* a(const Unit& u) const { const char* pa = (const char*)A + (size_t)u.pm * BM * K * 2; const char* pb = (const char*)Bt + (size_t)u.pn * BM * K * 2; const long sw = (u.pn >= 4 && u.pn < 8) ? 1 : 0; return pa + sw * (long)(pb - pa); }
    __device__ __forceinline__ const char* b(const Unit& u) const { const char* pa = (const char*)A + (size_t)u.pm * BM * K * 2; const char* pb = (const char*)Bt + (size_t)u.pn * BM * K * 2; const long sw = (u.pn >= 4 && u.pn < 8) ? 1 : 0; return pb - sw * (long)(pb - pa); } };
struct Src2 { const bf16_t* A0; const bf16_t* B0; long dA, dB; int K;
    __device__ __forceinline__ const char* a(const Unit& u) const { return (const char*)A0 + (long)u.part * dA + (size_t)u.pm * BM * K * 2; }
    __device__ __forceinline__ const char* b(const Unit& u) const { return (const char*)B0 + (long)u.part * dB + (size_t)u.pn * BM * K * 2; } };

template <class Epi, class Sched, class Src>
__device__ __forceinline__ void gemm_phase(LAS unsigned char* lds, const Src& g, const int K, const Sched& S, const Epi& E) {
    int tid_ = threadIdx.x; asm volatile("" : "+v"(tid_));
    const int tid = tid_, wid = __builtin_amdgcn_readfirstlane(tid >> 6), lane = tid & 63, wr = wid >> 2, wc = wid & 3, fr = lane & 15, fq = lane >> 4;
    const int nt = K / BK;
    unsigned voffA[2], voffB[2];
#pragma unroll
    for (int i = 0; i < 2; ++i) { int R, C; stage_rc(tid * 16 + i * 8192, R, C); const int Rb = Epi::PERM ? ((R & ~31) + perm32(R & 31)) : R;
        voffA[i] = (unsigned)(R * K + C) * 2u; voffB[i] = (unsigned)(Rb * K + C) * 2u; }
    const size_t kstep = (size_t)(BK * 2);
    const size_t hstep = (size_t)HALF * K * 2;
    const unsigned ldsw = (unsigned)wid * 1024u;
    const int aoff = lds_byte(wr * 64 + fr, fq * 8), boff = lds_byte(wc * 32 + fr, fq * 8);
#define PG8_SA(b, h) (((b) * 2 + (h)) * HTB)
#define PG8_SB(b, h) ((4 + (b) * 2 + (h)) * HTB)
#define PG8_STAGE(bufoff, gbase, voff) do { _Pragma("unroll") for (int _i = 0; _i < 2; ++_i) \
        __builtin_amdgcn_global_load_lds((const unsigned*)((const char*)(gbase) + (voff)[_i]), (LAS unsigned*)(lds + (bufoff) + ldsw + _i * 8192), 16, 0, 0); } while (0)
#define PG8_LDA(dst, b, h) do { _Pragma("unroll") for (int m = 0; m < 4; ++m) _Pragma("unroll") for (int k = 0; k < 2; ++k) dst[m][k] = *(const LAS bf16x8*)(lds + PG8_SA(b, h) + aoff + m * 2048 + k * 1024); } while (0)
#define PG8_LDB(dst, b, h) do { _Pragma("unroll") for (int n = 0; n < 2; ++n) _Pragma("unroll") for (int k = 0; k < 2; ++k) dst[n][k] = *(const LAS bf16x8*)(lds + PG8_SB(b, h) + boff + n * 2048 + k * 1024); } while (0)
#define PG8_MMA(ai, bj, At, Bt) do { __builtin_amdgcn_s_setprio(1); _Pragma("unroll") for (int m = 0; m < 4; ++m) _Pragma("unroll") for (int n = 0; n < 2; ++n) _Pragma("unroll") for (int k = 0; k < 2; ++k) \
        acc[ai][bj][m][n] = __builtin_amdgcn_mfma_f32_16x16x32_bf16(Bt[n][k], At[m][k], acc[ai][bj][m][n], 0, 0, 0); __builtin_amdgcn_s_setprio(0); } while (0)
#define PG8_WAIT_V(n) asm volatile("s_waitcnt vmcnt(" #n ")" ::: "memory")
#define PG8_WAIT_L(n) asm volatile("s_waitcnt lgkmcnt(" #n ")" ::: "memory")
#define PG8_BAR __builtin_amdgcn_s_barrier()
#define PG8_SCHED __builtin_amdgcn_sched_barrier(0)
    Unit cur, nxt; int ui = 0;
    if (!S.next(0, cur)) return;
    f32x4 acc[2][2][4][2];
#pragma unroll
    for (int a = 0; a < 2; ++a)
#pragma unroll
        for (int b = 0; b < 2; ++b)
#pragma unroll
            for (int m = 0; m < 4; ++m)
#pragma unroll
                for (int n = 0; n < 2; ++n) acc[a][b][m][n] = (f32x4){0.f, 0.f, 0.f, 0.f};
    bf16x8 At[4][2], B0[2][2], B1[2][2];
    const char* cA = g.a(cur); const char* cB = g.b(cur);
    PG8_STAGE(PG8_SB(0, 0), cB, voffB); PG8_STAGE(PG8_SA(0, 0), cA, voffA); PG8_STAGE(PG8_SB(0, 1), cB + hstep, voffB); PG8_STAGE(PG8_SA(0, 1), cA + hstep, voffA);
    if (wr == 1) PG8_BAR;
    PG8_WAIT_V(4); PG8_BAR;
    PG8_STAGE(PG8_SB(1, 0), cB + kstep, voffB); PG8_STAGE(PG8_SA(1, 0), cA + kstep, voffA); PG8_STAGE(PG8_SB(1, 1), cB + hstep + kstep, voffB);
    PG8_WAIT_V(6); PG8_BAR;
    for (;;) {
        const bool has_next = S.next(ui + 1, nxt);
        const char* nA = has_next ? g.a(nxt) : cA; const char* nB = has_next ? g.b(nxt) : cB;
        for (int t = 0; t < nt; t += 2) {
            const bool last = (t == nt - 2);
            const char* a1 = cA + (size_t)(t + 1) * kstep;
            const char* a2 = last ? nA : cA + (size_t)(t + 2) * kstep; const char* b2 = last ? nB : cB + (size_t)(t + 2) * kstep;
            const char* a3 = a2 + kstep; const char* b3 = b2 + kstep;
            PG8_LDB(B0, 0, 0); PG8_SCHED; PG8_LDA(At, 0, 0); PG8_STAGE(PG8_SA(1, 1), a1 + hstep, voffA);
            PG8_WAIT_L(8); PG8_BAR; PG8_WAIT_L(0); PG8_MMA(0, 0, At, B0); PG8_BAR; PG8_SCHED;
            PG8_LDB(B1, 0, 1); PG8_STAGE(PG8_SB(0, 0), b2, voffB);
            PG8_BAR; PG8_WAIT_L(0); PG8_MMA(0, 1, At, B1); PG8_BAR;
            PG8_LDA(At, 0, 1); PG8_STAGE(PG8_SA(0, 0), a2, voffA);
            PG8_BAR; PG8_WAIT_L(0); PG8_MMA(1, 0, At, B0); PG8_BAR; PG8_SCHED;
            PG8_STAGE(PG8_SB(0, 1), b2 + hstep, voffB);
            PG8_WAIT_V(6); PG8_BAR; PG8_MMA(1, 1, At, B1); PG8_BAR;
            PG8_LDB(B0, 1, 0); PG8_SCHED; PG8_LDA(At, 1, 0); PG8_STAGE(PG8_SA(0, 1), a2 + hstep, voffA);
            PG8_WAIT_L(8); PG8_BAR; PG8_WAIT_L(0); PG8_MMA(0, 0, At, B0); PG8_BAR; PG8_SCHED;
            PG8_LDB(B1, 1, 1); PG8_STAGE(PG8_SB(1, 0), b3, voffB);
            PG8_BAR; PG8_WAIT_L(0); PG8_MMA(0, 1, At, B1); PG8_BAR;
            PG8_LDA(At, 1, 1); PG8_STAGE(PG8_SA(1, 0), a3, voffA);
            PG8_BAR; PG8_WAIT_L(0); PG8_MMA(1, 0, At, B0); PG8_BAR; PG8_SCHED;
            PG8_STAGE(PG8_SB(1, 1), b3 + hstep, voffB);
            PG8_WAIT_V(6); PG8_BAR; PG8_MMA(1, 1, At, B1); PG8_BAR;
        }
        {
            int epm = cur.pm, epn = cur.pn, efr = fr, efq = fq; asm volatile("" : "+s"(epm), "+s"(epn), "+v"(efr), "+v"(efq));
            const Unit eu{epm, epn, cur.part};
            E(acc, eu, wr, wc, efr, efq);
        }
        if (!has_next) break;
        if (!E.keep(cur)) {
#pragma unroll
            for (int a = 0; a < 2; ++a)
#pragma unroll
                for (int b = 0; b < 2; ++b)
#pragma unroll
                    for (int m = 0; m < 4; ++m)
#pragma unroll
                        for (int n = 0; n < 2; ++n) acc[a][b][m][n] = (f32x4){0.f, 0.f, 0.f, 0.f};
        }
        cur = nxt; cA = nA; cB = nB; ++ui;
    }
    PG8_WAIT_V(0);
    if (wr == 0) PG8_BAR;
    PG8_BAR;
#undef PG8_SA
#undef PG8_SB
#undef PG8_STAGE
#undef PG8_LDA
#undef PG8_LDB
#undef PG8_MMA
#undef PG8_WAIT_V
#undef PG8_WAIT_L
#undef PG8_BAR
#undef PG8_SCHED
}
}
using pg8::Unit;
typedef f32x4 AccT[2][2][4][2];

__device__ __forceinline__ u32x4 pack8(f32x4 a, f32x4 b) { u32x4 w; w.x = cvt_pk_bf16(a[0], a[1]); w.y = cvt_pk_bf16(a[2], a[3]); w.z = cvt_pk_bf16(b[0], b[1]); w.w = cvt_pk_bf16(b[2], b[3]); return w; }
__device__ __forceinline__ u32x2 pack4(f32x4 a) { u32x2 w; w.x = cvt_pk_bf16(a[0], a[1]); w.y = cvt_pk_bf16(a[2], a[3]); return w; }
__device__ __forceinline__ void unpack8(u32x4 w, f32x4& a, f32x4& b) { a = (f32x4){bf_lo(w.x), bf_hi(w.x), bf_lo(w.y), bf_hi(w.y)}; b = (f32x4){bf_lo(w.z), bf_hi(w.z), bf_lo(w.w), bf_hi(w.w)}; }
__device__ __forceinline__ f32x4 unpack4(u32x2 w) { return (f32x4){bf_lo(w.x), bf_hi(w.x), bf_lo(w.y), bf_hi(w.y)}; }

struct Epi1 {
    static constexpr bool PERM = true;
    bf16_t *QK, *UG; const float* cs; const float* sn; int sl; float* svs;
    __device__ __forceinline__ bool keep(const Unit&) const { return false; }
    __device__ __forceinline__ void operator()(AccT& acc, const Unit& u, int wr, int wc, int fr, int fq) const {
        const int pn = u.pn, cl = wc * 32 + 8 * fq, row0 = u.pm * 256 + wr * 64 + fr;
        if (pn < 4) {
            const int isk = pn >> 1, t = pn & 1, head = 2 * t + (cl >> 6), dim0 = cl & 63;
            const float sc = isk ? 1.0f : 0.08838834764831845f;
            bf16_t* base = QK + isk * 512 + head * 128 + dim0;
            f32x4 tb[2][2][4];
#define ROT_LD(b, buf) do { _Pragma("unroll") for (int mm = 0; mm < 2; ++mm) { const int pos_ = (row0 + ((b) >> 1) * 128 + (((b) & 1) * 2 + mm) * 16) & 4095; \
                tb[buf][mm][0] = *(const f32x4*)(cs + pos_ * 64 + dim0); tb[buf][mm][1] = *(const f32x4*)(cs + pos_ * 64 + dim0 + 4); \
                tb[buf][mm][2] = *(const f32x4*)(sn + pos_ * 64 + dim0); tb[buf][mm][3] = *(const f32x4*)(sn + pos_ * 64 + dim0 + 4); } } while (0)
            ROT_LD(0, 0);
#pragma unroll
            for (int b = 0; b < 4; ++b) {
                if (b + 1 < 4) ROT_LD(b + 1, (b + 1) & 1);
#pragma unroll
                for (int mm = 0; mm < 2; ++mm) {
                    const int ai = b >> 1, m = (b & 1) * 2 + mm, row = row0 + ai * 128 + m * 16;
                    const f32x4 c0 = tb[b & 1][mm][0], c1 = tb[b & 1][mm][1], s0 = tb[b & 1][mm][2], s1 = tb[b & 1][mm][3];
                    const f32x4 x1a = acc[ai][0][m][0], x1b = acc[ai][0][m][1], x2a = acc[ai][1][m][0], x2b = acc[ai][1][m][1];
                    const f32x4 o1a = (x1a * c0 - x2a * s0) * sc, o1b = (x1b * c1 - x2b * s1) * sc, o2a = (x2a * c0 + x1a * s0) * sc, o2b = (x2b * c1 + x1b * s1) * sc;
                    *(u32x4*)(base + (size_t)row * 1024) = pack8(o1a, o1b);
                    *(u32x4*)(base + (size_t)row * 1024 + 64) = pack8(o2a, o2b);
                }
            }
#undef ROT_LD
        } else if (pn >= 12 && pn < 20) {
            bf16_t* base = UG + 128 * (pn - 12) + cl;
#pragma unroll
            for (int ai = 0; ai < 2; ++ai)
#pragma unroll
                for (int m = 0; m < 4; ++m) {
                    const int row = row0 + ai * 128 + m * 16;
                    const f32x4 ua = gelu4(acc[ai][0][m][0]), ub = gelu4(acc[ai][0][m][1]);
                    const f32x4 ga = acc[ai][1][m][0], gb = acc[ai][1][m][1];
                    *(u32x4*)(base + (size_t)row * 1024) = pack8(ua * ga * sig4(ga), ub * gb * sig4(gb));
                }
        } else if (pn < 8) {
            bf16_t* vt = QK + (size_t)TS * 1024;
#pragma unroll
            for (int ai = 0; ai < 2; ++ai)
#pragma unroll
                for (int m = 0; m < 4; ++m) {
                    const int e = ai * 128 + wr * 64 + m * 16 + fr;
#pragma unroll
                    for (int bj = 0; bj < 2; ++bj)
                        *(u32x4*)(vt + (((size_t)(u.pm * 2 + bj) * 4 + (pn - 4)) * 256 + e) * 128 + cl) = pack8(acc[ai][bj][m][0], acc[ai][bj][m][1]);
                }
        } else {
            const int act = pn < 8 ? 0 : pn < 12 ? 1 : pn < 24 ? 2 : 3;
            const int bidx = pn < 8 ? 1 : pn < 12 ? 3 + sl : pn < 24 ? 2 : pn < 28 ? 7 + sl : 9 + sl;
            const int tl = pn < 8 ? pn - 4 : pn < 12 ? pn - 8 : pn < 24 ? pn - 20 : pn < 28 ? pn - 24 : pn - 28;
            bf16_t* base = QK + (size_t)bidx * ((size_t)TS * 1024) + tl * 256 + cl;
#pragma unroll
            for (int ai = 0; ai < 2; ++ai)
#pragma unroll
                for (int m = 0; m < 4; ++m) {
                    const int row = row0 + ai * 128 + m * 16; float ssum = 0.f, ssq = 0.f;
#pragma unroll
                    for (int bj = 0; bj < 2; ++bj) {
                        f32x4 a = acc[ai][bj][m][0], b = acc[ai][bj][m][1];
                        if (act == 1) { a = a * sig4(a); b = b * sig4(b); }
                        else if (act == 2) { a = gelu4(a); b = gelu4(b);
                            ssum += ((a[0] + a[1]) + (a[2] + a[3])) + ((b[0] + b[1]) + (b[2] + b[3]));
                            ssq += ((a[0] * a[0] + a[1] * a[1]) + (a[2] * a[2] + a[3] * a[3])) + ((b[0] * b[0] + b[1] * b[1]) + (b[2] * b[2] + b[3] * b[3])); }
                        else if (act == 3) { a = sig4(a); b = sig4(b); }
                        *(u32x4*)(base + (size_t)row * 1024 + bj * 128) = pack8(a, b);
                    }
                    if (act == 2) {
                        ssum += __shfl_xor(ssum, 16); ssum += __shfl_xor(ssum, 32); ssq += __shfl_xor(ssq, 16); ssq += __shfl_xor(ssq, 32);
                        if (fq == 0) *(f32x2*)(svs + (size_t)row * 32 + tl * 8 + wc * 2) = (f32x2){ssum, ssq};
                    }
                }
        }
    }
};
struct Epi6 {
    static constexpr bool PERM = true;
    const bf16_t* MR; const bf16_t* MS; bf16_t* O;
    __device__ __forceinline__ bool keep(const Unit& u) const { return u.part == 0; }
    __device__ __forceinline__ void operator()(AccT& acc, const Unit& u, int wr, int wc, int fr, int fq) const {
        const int row0 = u.pm * 256 + wr * 64 + fr, col0 = u.pn * 256 + wc * 32 + 8 * fq;
        u32x4 sb[4][2], rb[4][2];
#define E6_LD(g) do { _Pragma("unroll") for (int bj = 0; bj < 2; ++bj) { const size_t off_ = (size_t)(row0 + ((g) >> 2) * 128 + ((g) & 3) * 16) * 1024 + col0 + bj * 128; \
            sb[(g) & 3][bj] = *(const u32x4*)(MS + off_); if (u.part == 0) rb[(g) & 3][bj] = *(const u32x4*)(MR + off_); } } while (0)
        E6_LD(0); E6_LD(1); E6_LD(2);
#pragma unroll
        for (int g = 0; g < 8; ++g) {
            if (g + 3 < 8) E6_LD(g + 3);
            const int ai = g >> 2, m = g & 3;
#pragma unroll
            for (int bj = 0; bj < 2; ++bj) {
                const size_t off = (size_t)(row0 + ai * 128 + m * 16) * 1024 + col0 + bj * 128;
                f32x4 sa, sbv; unpack8(sb[g & 3][bj], sa, sbv);
                if (u.part == 0) {
                    f32x4 ra, rbv; unpack8(rb[g & 3][bj], ra, rbv);
#pragma unroll
                    for (int j = 0; j < 4; ++j) { acc[ai][bj][m][0][j] *= ra[j] * __builtin_amdgcn_rcpf(fmaxf(sa[j], 1e-30f)); acc[ai][bj][m][1][j] *= rbv[j] * __builtin_amdgcn_rcpf(fmaxf(sbv[j], 1e-30f)); }
                } else {
                    *(u32x4*)(O + off) = pack8(acc[ai][bj][m][0] * sa, acc[ai][bj][m][1] * sbv);
                }
            }
        }
#undef E6_LD
    }
};
struct EpiStore {
    static constexpr bool PERM = true;
    bf16_t* O;
    __device__ __forceinline__ bool keep(const Unit&) const { return false; }
    __device__ __forceinline__ void operator()(AccT& acc, const Unit& u, int wr, int wc, int fr, int fq) const {
        const int row0 = u.pm * 256 + wr * 64 + fr, col0 = u.pn * 256 + wc * 32 + 8 * fq;
#pragma unroll
        for (int ai = 0; ai < 2; ++ai)
#pragma unroll
            for (int m = 0; m < 4; ++m)
#pragma unroll
                for (int bj = 0; bj < 2; ++bj)
                    *(u32x4*)(O + (size_t)(row0 + ai * 128 + m * 16) * 1024 + col0 + bj * 128) = pack8(acc[ai][bj][m][0], acc[ai][bj][m][1]);
    }
};
struct Epi7 {
    static constexpr bool PERM = false;
    const float* x; bf16_t* X1B; float* rsq; int tok0;
    __device__ __forceinline__ bool keep(const Unit&) const { return false; }
    __device__ __forceinline__ void operator()(AccT& acc, const Unit& u, int wr, int wc, int fr, int fq) const {
        const int row0 = u.pm * 256 + wr * 64 + fr, col0 = u.pn * 256 + wc * 32 + 4 * fq;
        f32x4 xb[4][2][2];
#define E7_LD(g) do { _Pragma("unroll") for (int bj = 0; bj < 2; ++bj) _Pragma("unroll") for (int n = 0; n < 2; ++n) \
            xb[(g) & 3][bj][n] = *(const f32x4*)(x + ((size_t)tok0 + row0 + ((g) >> 2) * 128 + ((g) & 3) * 16) * 1024 + col0 + bj * 128 + n * 16); } while (0)
        E7_LD(0); E7_LD(1); E7_LD(2);
#pragma unroll
        for (int g = 0; g < 8; ++g) {
            if (g + 3 < 8) E7_LD(g + 3);
            const int ai = g >> 2, m = g & 3, row = row0 + ai * 128 + m * 16; const size_t tok = (size_t)tok0 + row; float ss = 0.f;
#pragma unroll
            for (int bj = 0; bj < 2; ++bj)
#pragma unroll
                for (int n = 0; n < 2; ++n) {
                    const int col = col0 + bj * 128 + n * 16;
                    const f32x4 o = xb[g & 3][bj][n] + acc[ai][bj][m][n];
                    *(u32x2*)(X1B + (size_t)row * 1024 + col) = pack4(o);
                    ss += (o[0] * o[0] + o[1] * o[1]) + (o[2] * o[2] + o[3] * o[3]);
                }
            ss += __shfl_xor(ss, 16); ss += __shfl_xor(ss, 32);
            if (fq == 0) rsq[tok * 16 + u.pn * 4 + wc] = ss;
        }
#undef E7_LD
    }
};
struct Epi8 {
    static constexpr bool PERM = false;
    const bf16_t* X1B; bf16_t* X2B; const bf16_t* PP; const float* rsq1; float* rsq2; int tok0;
    __device__ __forceinline__ bool keep(const Unit&) const { return false; }
    __device__ __forceinline__ void operator()(AccT& acc, const Unit& u, int wr, int wc, int fr, int fq) const {
        const int row0 = u.pm * 256 + wr * 64 + fr, col0 = u.pn * 256 + wc * 32 + 4 * fq;
        float rs[8];
        {   f32x4 sl[8];
#pragma unroll
            for (int r = 0; r < 8; ++r) sl[r] = *(const f32x4*)(rsq1 + ((size_t)tok0 + row0 + (r >> 2) * 128 + (r & 3) * 16) * 16 + 4 * fq);
#pragma unroll
            for (int r = 0; r < 8; ++r) { float t = (sl[r][0] + sl[r][1]) + (sl[r][2] + sl[r][3]); t += __shfl_xor(t, 16); t += __shfl_xor(t, 32); rs[r] = t; } }
        u32x2 pb[4][2][2], xb[4][2][2];
#define E8_LD(g) do { _Pragma("unroll") for (int bj = 0; bj < 2; ++bj) _Pragma("unroll") for (int n = 0; n < 2; ++n) { \
            const size_t off_ = (size_t)(row0 + ((g) >> 2) * 128 + ((g) & 3) * 16) * 1024 + col0 + bj * 128 + n * 16; \
            pb[(g) & 3][bj][n] = *(const u32x2*)(PP + off_); xb[(g) & 3][bj][n] = *(const u32x2*)(X1B + off_); } } while (0)
        E8_LD(0); E8_LD(1); E8_LD(2);
#pragma unroll
        for (int g = 0; g < 8; ++g) {
            if (g + 3 < 8) E8_LD(g + 3);
            const int ai = g >> 2, m = g & 3, row = row0 + ai * 128 + m * 16; const size_t tok = (size_t)tok0 + row; float ss = 0.f;
            const float rstd = rsqrtf(rs[g] * (1.0f / 1024.0f) + 1e-6f);
#pragma unroll
            for (int bj = 0; bj < 2; ++bj)
#pragma unroll
                for (int n = 0; n < 2; ++n) {
                    const size_t off = (size_t)row * 1024 + col0 + bj * 128 + n * 16;
                    const f32x4 gt = sig4(acc[ai][bj][m][n] * rstd);
                    const f32x4 o = unpack4(xb[g & 3][bj][n]) + gt * unpack4(pb[g & 3][bj][n]);
                    *(u32x2*)(X2B + off) = pack4(o);
                    ss += (o[0] * o[0] + o[1] * o[1]) + (o[2] * o[2] + o[3] * o[3]);
                }
            ss += __shfl_xor(ss, 16); ss += __shfl_xor(ss, 32);
            if (fq == 0) rsq2[tok * 16 + u.pn * 4 + wc] = ss;
        }
#undef E8_LD
    }
};

__device__ __forceinline__ int srccol_win(int np) {
    const int pn = np >> 8, L = np & 255;
    if (pn < 4) { const int isk = pn >> 1, t = pn & 1, half = L >> 7, i = L & 127, head = 2 * t + (i >> 6), dim = (i & 63) + 64 * half; return isk * 512 + head * 128 + dim; }
    if (pn < 8) return 1024 + (pn - 4) * 256 + L;
    if (pn < 12) return 2048 + (pn - 8) * 256 + L;
    if (pn < 20) { const int t = pn - 12; return L < 128 ? 3072 + 128 * t + L : 5120 + 128 * t + (L - 128); }
    if (pn < 24) return 4096 + (pn - 20) * 256 + L;
    if (pn < 28) return 6144 + (pn - 24) * 256 + L;
    return 7168 + (pn - 28) * 256 + L;
}
__device__ __forceinline__ void p0_transpose(LAS float* tile, const float* src, int ldsrc, int k0, int c0, bf16_t* dst, int ldk, int n0, const float* kscale, int tid) {
#pragma unroll
    for (int p = 0; p < 2; ++p) {
        const int r = (tid >> 4) + 32 * p, c4 = (tid & 15) * 4;
        const f32x4 v = *(const f32x4*)(src + (size_t)(k0 + r) * ldsrc + c0 + c4);
        const float s = kscale ? kscale[k0 + r] : 1.0f;
        tile[r * 65 + c4 + 0] = v[0] * s; tile[r * 65 + c4 + 1] = v[1] * s; tile[r * 65 + c4 + 2] = v[2] * s; tile[r * 65 + c4 + 3] = v[3] * s;
    }
    __syncthreads();
    {
        const int n = tid >> 3, kc = (tid & 7) * 8;
        u32x4 w;
        w.x = cvt_pk_bf16(tile[(kc + 0) * 65 + n], tile[(kc + 1) * 65 + n]); w.y = cvt_pk_bf16(tile[(kc + 2) * 65 + n], tile[(kc + 3) * 65 + n]);
        w.z = cvt_pk_bf16(tile[(kc + 4) * 65 + n], tile[(kc + 5) * 65 + n]); w.w = cvt_pk_bf16(tile[(kc + 6) * 65 + n], tile[(kc + 7) * 65 + n]);
        *(u32x4*)(dst + (size_t)(n0 + n) * ldk + k0 + kc) = w;
    }
    __syncthreads();
}

struct Params { const float *x, *p, *w_in, *w_ret, *w_sgu, *w_out, *sws, *sbs, *wpg, *wpp, *gm, *gp, *gf; float* out; unsigned char* ws; };

__device__ __forceinline__ void phase0(const Params& P, LAS unsigned char* lds, int tid, int wid, int lane) {
    unsigned char* ws = P.ws;
    const int G = gridDim.x, bx = blockIdx.x;
    LAS float* tile = (LAS float*)lds;
    for (int idx = bx; idx < 3136; idx += G) {
        if (idx < 2048) { const int kt = idx & 15, ntl = idx >> 4; p0_transpose(tile, P.w_in, 8192, kt * 64, srccol_win(ntl * 64), (bf16_t*)(ws + WS_WIN), 1024, ntl * 64, nullptr, tid); }
        else if (idx < 3072) { const int w = (idx - 2048) >> 8, r = (idx - 2048) & 255, kt = r & 15, ntl = r >> 4;
            const float* src = w == 0 ? P.w_ret : w == 1 ? P.w_sgu : w == 2 ? P.w_out : P.wpg;
            bf16_t* dst = (bf16_t*)(ws + (w == 0 ? WS_WR : w == 1 ? WS_WS : w == 2 ? WS_WO : WS_WG));
            p0_transpose(tile, src, 1024, kt * 64, ntl * 64, dst, 1024, ntl * 64, w == 3 ? P.gp : nullptr, tid); }
        else { const int r = idx - 3072, kt = r & 3, ntl = r >> 2; p0_transpose(tile, P.wpp, 1024, kt * 64, ntl * 64, (bf16_t*)(ws + WS_WPP), 256, ntl * 64, nullptr, tid); }
    }
    const int gt = bx * NTHR + tid, gn = G * NTHR;
    for (int i = gt; i < 4 * 128 * 128; i += gn) { const int r = (i >> 7) & 127, c = i & 127; const float v = c <= r ? P.sws[i] : 0.0f; ((bf16_t*)(ws + WS_WC))[i] = (bf16_t)(cvt_pk_bf16(v, 0.f) & 0xffffu); }
    for (int i = gt; i < 4096 * 64; i += gn) {
        const int pos = i >> 6, j = i & 63;
        const float inv = exp2f(-(float)j * (13.287712379549449f / 64.0f));
        const float ang = (float)pos * inv;
        const double a = (double)ang; const double nrev = rint(a * 0.15915494309189535); const float r = (float)(a - nrev * 6.283185307179586);
        ((float*)(ws + WS_COS))[i] = cosf(r); ((float*)(ws + WS_SIN))[i] = sinf(r);
    }
    for (size_t i = (size_t)gt * 8; i < (size_t)T_ALL * 256; i += (size_t)gn * 8) {
        const f32x4 a = *(const f32x4*)(P.p + i), b = *(const f32x4*)(P.p + i + 4);
        *(u32x4*)((bf16_t*)(ws + WS_PB) + i) = pack8(a, b);
    }
    {
        f32x4 gv[4];
#pragma unroll
        for (int i = 0; i < 4; ++i) gv[i] = *(const f32x4*)(P.gm + lane * 4 + 256 * i);
        for (int row = bx * 8 + wid; row < T_ALL; row += G * 8) {
            const float* xr = P.x + (size_t)row * 1024; f32x4 v[4]; float ss = 0.f;
#pragma unroll
            for (int i = 0; i < 4; ++i) { v[i] = *(const f32x4*)(xr + lane * 4 + 256 * i); ss += (v[i][0] * v[i][0] + v[i][1] * v[i][1]) + (v[i][2] * v[i][2] + v[i][3] * v[i][3]); }
            ss = wave_sum(ss);
            const float rstd = rsqrtf(ss * (1.0f / 1024.0f) + 1e-6f);
            bf16_t* hr = (bf16_t*)(ws + WS_H) + (size_t)row * 1024;
#pragma unroll
            for (int i = 0; i < 4; ++i) *(u32x2*)(hr + lane * 4 + 256 * i) = pack4(v[i] * rstd * gv[i]);
        }
    }
}

template <int ROWS, int COLS> struct TileRegs { u32x4 v[ROWS * (COLS / 8) / NTHR]; };
template <int ROWS, int COLS>
__device__ __forceinline__ void tile_load(TileRegs<ROWS, COLS>& t, const bf16_t* src, size_t gp, int tid) {
    constexpr int CPR = COLS / 8, IT = ROWS * CPR / NTHR;
#pragma unroll
    for (int i = 0; i < IT; ++i) { const int c = tid + i * NTHR, r = c / CPR, ch = c % CPR; t.v[i] = *(const u32x4*)(src + (size_t)r * gp + ch * 8); }
}
template <int ROWS, int COLS>
__device__ __forceinline__ void tile_store_b128(const TileRegs<ROWS, COLS>& t, LAS unsigned char* dst, int lp, int tid) {
    constexpr int CPR = COLS / 8, IT = ROWS * CPR / NTHR;
#pragma unroll
    for (int i = 0; i < IT; ++i) { const int c = tid + i * NTHR, r = c / CPR, ch = c % CPR; *(LAS u32x4*)(dst + r * lp + ch * 16) = t.v[i]; }
}
template <int ROWS, int COLS>
__device__ __forceinline__ void tile_store_b32(const TileRegs<ROWS, COLS>& t, LAS unsigned char* dst, int lp, int tid) {
    constexpr int CPR = COLS / 8, IT = ROWS * CPR / NTHR;
#pragma unroll
    for (int i = 0; i < IT; ++i) { const int c = tid + i * NTHR, r = c / CPR, ch = c % CPR; LAS unsigned* d = (LAS unsigned*)(dst + r * lp + ch * 16); d[0] = t.v[i].x; d[1] = t.v[i].y; d[2] = t.v[i].z; d[3] = t.v[i].w; }
}
__device__ __forceinline__ void gather8(const LAS unsigned char* base, int pitch, int r0, int col, unsigned short (&o)[8]) {
    const LAS unsigned char* p = base + r0 * pitch + col * 2;
#pragma unroll
    for (int j = 0; j < 8; ++j) o[j] = *(const LAS unsigned short*)(p + j * pitch);
}
__device__ __forceinline__ bf16x8 mk8(const unsigned short (&o)[8]) { bf16x8 r;
#pragma unroll
    for (int j = 0; j < 8; ++j) r[j] = (short)o[j];
    return r; }

__device__ __forceinline__ void p2_unit(LAS unsigned char* lds, const bf16_t* QK, const bf16_t* V, bf16_t* KV, int unit, int tid, int wid, int lane) {
    const int fr = lane & 15, fq = lane >> 4, h = unit & 3; const size_t tok0 = (size_t)(unit >> 2) * 128; const float lg = lgam(h);
    LAS unsigned char* sK = lds; LAS unsigned char* sV = lds + 33280;
    TileRegs<128, 128> tk; TileRegs<256, 128> tv;
    asm volatile("" : "+v"(tid));
    tile_load(tk, QK + tok0 * 1024 + 512 + h * 128, 1024, tid);
    tile_load(tv, V + (size_t)unit * 32768, 128, tid);
    __syncthreads();
    tile_store_b32(tk, sK, 260, tid);
    tile_store_b128(tv, sV, 272, tid);
    __syncthreads();
    f32x4 acc[2][8];
#pragma unroll
    for (int a = 0; a < 2; ++a)
#pragma unroll
        for (int b = 0; b < 8; ++b) acc[a][b] = (f32x4){0.f, 0.f, 0.f, 0.f};
#pragma unroll
    for (int ks = 0; ks < 4; ++ks) {
        const int j0 = 32 * ks + 8 * fq;
        bf16x8 vf[2];
#pragma unroll
        for (int e2 = 0; e2 < 2; ++e2) {
            const u32x4 vr = *(const LAS u32x4*)(sV + (16 * (2 * wid + e2) + fr) * 272 + j0 * 2);
            u32x4 w;
            w.x = cvt_pk_bf16(bf_lo(vr.x) * fexp(lg * (float)(127 - j0 - 0)), bf_hi(vr.x) * fexp(lg * (float)(127 - j0 - 1)));
            w.y = cvt_pk_bf16(bf_lo(vr.y) * fexp(lg * (float)(127 - j0 - 2)), bf_hi(vr.y) * fexp(lg * (float)(127 - j0 - 3)));
            w.z = cvt_pk_bf16(bf_lo(vr.z) * fexp(lg * (float)(127 - j0 - 4)), bf_hi(vr.z) * fexp(lg * (float)(127 - j0 - 5)));
            w.w = cvt_pk_bf16(bf_lo(vr.w) * fexp(lg * (float)(127 - j0 - 6)), bf_hi(vr.w) * fexp(lg * (float)(127 - j0 - 7)));
            vf[e2] = __builtin_bit_cast(bf16x8, w);
        }
#pragma unroll
        for (int db = 0; db < 8; ++db) {
            unsigned short o[8]; gather8(sK, 260, j0, 16 * db + fr, o);
            const bf16x8 kf = mk8(o);
#pragma unroll
            for (int e2 = 0; e2 < 2; ++e2) acc[e2][db] = __builtin_amdgcn_mfma_f32_16x16x32_bf16(kf, vf[e2], acc[e2][db], 0, 0, 0);
        }
    }
    bf16_t* dst = KV + (size_t)unit * 32768;
#pragma unroll
    for (int e2 = 0; e2 < 2; ++e2)
#pragma unroll
        for (int db = 0; db < 8; ++db) *(u32x2*)(dst + (16 * (2 * wid + e2) + fr) * 128 + 16 * db + 4 * fq) = pack4(acc[e2][db]);
}

__device__ __forceinline__ void p4_unit(LAS unsigned char* lds, const bf16_t* QK, const bf16_t* V, const bf16_t* PREV, const bf16_t* RG, bf16_t* RO, int unit, int tid, int wid, int lane) {
    const int fr = lane & 15, fq = lane >> 4, h = unit & 3; const size_t tok0 = (size_t)(unit >> 2) * 128; const float lg = lgam(h);
    LAS unsigned char* sK = lds; LAS unsigned char* sP = lds + 34816;
    TileRegs<128, 128> tk; TileRegs<256, 128> tp; TileRegs<256, 128> tv;
    asm volatile("" : "+v"(tid));
    tile_load(tk, QK + tok0 * 1024 + 512 + h * 128, 1024, tid);
    tile_load(tp, PREV + (size_t)unit * 32768, 128, tid);
    bf16x8 qf[4];
    { const bf16_t* qrow = QK + (tok0 + 16 * wid + fr) * 1024 + h * 128 + 8 * fq;
#pragma unroll
      for (int ks = 0; ks < 4; ++ks) qf[ks] = *(const bf16x8*)(qrow + 32 * ks); }
    __syncthreads();
    tile_store_b128(tk, sK, 272, tid);
    tile_store_b128(tp, sP, 272, tid);
    asm volatile("" : "+v"(tid));
    tile_load(tv, V + (size_t)unit * 32768, 128, tid);
    __syncthreads();
    f32x4 sacc[8];
#pragma unroll
    for (int jb = 0; jb < 8; ++jb) {
        sacc[jb] = (f32x4){0.f, 0.f, 0.f, 0.f};
        if (jb <= wid) {
#pragma unroll
            for (int ks = 0; ks < 4; ++ks) { const bf16x8 kf = *(const LAS bf16x8*)(sK + (16 * jb + fr) * 272 + (32 * ks + 8 * fq) * 2); sacc[jb] = __builtin_amdgcn_mfma_f32_16x16x32_bf16(kf, qf[ks], sacc[jb], 0, 0, 0); }
        }
    }
    f32x4 acc[16];
    const int i = 16 * wid + fr; const float xi = fexp(lg * (float)(i + 1));
#pragma unroll
    for (int eb = 0; eb < 16; ++eb) {
        f32x4 a = (f32x4){0.f, 0.f, 0.f, 0.f};
#pragma unroll
        for (int ks = 0; ks < 4; ++ks) { const bf16x8 pf = *(const LAS bf16x8*)(sP + (16 * eb + fr) * 272 + (32 * ks + 8 * fq) * 2); a = __builtin_amdgcn_mfma_f32_16x16x32_bf16(pf, qf[ks], a, 0, 0, 0); }
        acc[eb] = a * xi;
    }
    bf16x8 pfr[4];
#pragma unroll
    for (int ks = 0; ks < 4; ++ks) {
        float pv[8];
#pragma unroll
        for (int hf = 0; hf < 2; ++hf)
#pragma unroll
            for (int r = 0; r < 4; ++r) { const int jb = 2 * ks + hf, j = 16 * jb + 4 * fq + r; pv[4 * hf + r] = (j <= i) ? sacc[jb][r] * fexp(lg * (float)(i - j)) : 0.0f; }
        u32x4 w; w.x = cvt_pk_bf16(pv[0], pv[1]); w.y = cvt_pk_bf16(pv[2], pv[3]); w.z = cvt_pk_bf16(pv[4], pv[5]); w.w = cvt_pk_bf16(pv[6], pv[7]);
        pfr[ks] = __builtin_bit_cast(bf16x8, w);
    }
    __syncthreads();
    asm volatile("" : "+v"(tid));
    tile_store_b128(tv, lds, 272, tid);
    __syncthreads();
#pragma unroll
    for (int ks = 0; ks < 4; ++ks) {
        if (2 * ks <= wid) {
#pragma unroll
            for (int eb = 0; eb < 16; ++eb) {
                const LAS unsigned char* p = lds + (16 * eb + fr) * 272 + (32 * ks + 4 * fq) * 2;
                const u32x2 lo = *(const LAS u32x2*)p, hi = *(const LAS u32x2*)(p + 32);
                const u32x4 w = (u32x4){lo.x, lo.y, hi.x, hi.y};
                acc[eb] = __builtin_amdgcn_mfma_f32_16x16x32_bf16(__builtin_bit_cast(bf16x8, w), pfr[ks], acc[eb], 0, 0, 0);
            }
        }
    }
    float s = 0.f;
#pragma unroll
    for (int eb = 0; eb < 16; ++eb) s += (acc[eb][0] + acc[eb][1]) + (acc[eb][2] + acc[eb][3]);
    s += __shfl_xor(s, 16); s += __shfl_xor(s, 32);
    const float mu = s * (1.0f / 256.0f); float q = 0.f;
#pragma unroll
    for (int eb = 0; eb < 16; ++eb) { const f32x4 d = acc[eb] - mu; q += (d[0] * d[0] + d[1] * d[1]) + (d[2] * d[2] + d[3] * d[3]); }
    q += __shfl_xor(q, 16); q += __shfl_xor(q, 32);
    const float rstd = rsqrtf(q * (1.0f / 256.0f) + 1e-5f);
    const bf16_t* rgrow = RG + (tok0 + i) * 1024 + h * 256 + 4 * fq; bf16_t* rorow = RO + (tok0 + i) * 1024 + h * 256 + 4 * fq;
    u32x2 gl[16];
#pragma unroll
    for (int eb = 0; eb < 16; ++eb) gl[eb] = *(const u32x2*)(rgrow + 16 * eb);
#pragma unroll
    for (int eb = 0; eb < 16; ++eb) *(u32x2*)(rorow + 16 * eb) = pack4((acc[eb] - mu) * rstd * unpack4(gl[eb]));
}

__device__ __forceinline__ void p5_unit(LAS unsigned char* lds, const bf16_t* SV, const float* SVS, bf16_t* UO, const bf16_t* WC, const float* bias, int chunk, int tid, int wid, int lane) {
    const int fr = lane & 15, fq = lane >> 4; const size_t tok0 = (size_t)chunk * 128;
    LAS unsigned char* sW = lds; LAS unsigned char* sV = lds + 34816; LAS float* st = (LAS float*)(lds + 34816 + 66048);
    __syncthreads();
    {
        const int r = 16 * wid + (lane >> 2);
        const float* sp = SVS + (tok0 + r) * 32 + (lane & 3) * 8;
        const f32x4 p0 = *(const f32x4*)sp, p1 = *(const f32x4*)(sp + 4);
        float sm = (p0[0] + p0[2]) + (p1[0] + p1[2]), sq = (p0[1] + p0[3]) + (p1[1] + p1[3]);
        sm += __shfl_xor(sm, 1); sm += __shfl_xor(sm, 2); sq += __shfl_xor(sq, 1); sq += __shfl_xor(sq, 2);
        const float mu = sm * (1.0f / 1024.0f), var = fmaxf(sq * (1.0f / 1024.0f) - mu * mu, 0.0f);
        if ((lane & 3) == 0) { st[2 * r] = mu; st[2 * r + 1] = rsqrtf(var + 1e-5f); }
    }
    TileRegs<128, 128> tw; TileRegs<128, 256> tv;
    { int tg = tid; asm volatile("" : "+v"(tg)); tile_load(tw, WC, 128, tg); tile_load(tv, SV + tok0 * 1024, 1024, tg); }
    for (int g = 0; g < 4; ++g) {
        __syncthreads();
        tile_store_b128(tw, sW, 272, tid);
#pragma unroll
        for (int i = 0; i < 8; ++i) {
            const int c = tid + i * NTHR, r = c >> 5, ch = c & 31;
            f32x4 a, b; unpack8(tv.v[i], a, b);
            const float mu = st[2 * r], rs = st[2 * r + 1];
            const u32x4 w = pack8((a - mu) * rs, (b - mu) * rs);
            LAS unsigned* d = (LAS unsigned*)(sV + r * 516 + ch * 16); d[0] = w.x; d[1] = w.y; d[2] = w.z; d[3] = w.w;
        }
        __syncthreads();
        int tg = tid; asm volatile("" : "+v"(tg));
        if (g < 3) { tile_load(tw, WC + (g + 1) * 16384, 128, tg); tile_load(tv, SV + tok0 * 1024 + (g + 1) * 256, 1024, tg); }
        u32x2 ul[8][2]; float bvl[8];
        {   const int lfr = tg & 15, lfq = (tg & 63) >> 4;
#pragma unroll
            for (int ib = 0; ib < 8; ++ib) { bvl[ib] = bias[g * 128 + 16 * ib + lfr];
#pragma unroll
                for (int c2 = 0; c2 < 2; ++c2) ul[ib][c2] = *(const u32x2*)(UO + (tok0 + 16 * ib + lfr) * 1024 + g * 256 + 16 * (2 * wid + c2) + 4 * lfq); } }
        f32x4 acc[8][2];
#pragma unroll
        for (int a = 0; a < 8; ++a)
#pragma unroll
            for (int b = 0; b < 2; ++b) acc[a][b] = (f32x4){0.f, 0.f, 0.f, 0.f};
#pragma unroll
        for (int ks = 0; ks < 4; ++ks) {
            bf16x8 vf[2];
#pragma unroll
            for (int c2 = 0; c2 < 2; ++c2) { unsigned short o[8]; gather8(sV, 516, 32 * ks + 8 * fq, 16 * (2 * wid + c2) + fr, o); vf[c2] = mk8(o); }
#pragma unroll
            for (int ib = 0; ib < 8; ++ib) {
                if (ib >= 2 * ks) {
                    const bf16x8 wf = *(const LAS bf16x8*)(sW + (16 * ib + fr) * 272 + (32 * ks + 8 * fq) * 2);
#pragma unroll
                    for (int c2 = 0; c2 < 2; ++c2) acc[ib][c2] = __builtin_amdgcn_mfma_f32_16x16x32_bf16(vf[c2], wf, acc[ib][c2], 0, 0, 0);
                }
            }
        }
#pragma unroll
        for (int ib = 0; ib < 8; ++ib)
#pragma unroll
            for (int c2 = 0; c2 < 2; ++c2)
                *(u32x2*)(UO + (tok0 + 16 * ib + fr) * 1024 + g * 256 + 16 * (2 * wid + c2) + 4 * fq) = pack4((acc[ib][c2] + bvl[ib]) * unpack4(ul[ib][c2]));
    }
}

#define XB_TMO      128
#define XB_XCNT(j)  (256  + 64 * (j))
#define XB_XSUB(j)  (1280 + 64 * (j))
#define XB_XGEN(j)  (2304 + 64 * (j))
#define XB_TOP      3328
#define XB_TOPGEN   3392
#define XCD_BAR_WORDS 3456
#define XB_SPIN_CAP (1u << 22)
__device__ __forceinline__ unsigned xb_ld(unsigned* p)              { return __hip_atomic_load(p, __ATOMIC_RELAXED, __HIP_MEMORY_SCOPE_AGENT); }
__device__ __forceinline__ unsigned xb_add(unsigned* p, unsigned v) { return __hip_atomic_fetch_add(p, v, __ATOMIC_RELAXED, __HIP_MEMORY_SCOPE_AGENT); }
__device__ __forceinline__ unsigned xb_xcc_id() { return (unsigned)__builtin_amdgcn_s_getreg((3 << 11) | 20) & 0xFu; }
#define XB_SPIN(cond, bar) do { unsigned _sp = 0; while (cond) { __builtin_amdgcn_s_sleep(1); \
    if ((++_sp & 255u) == 0u) { if (xb_ld(&(bar)[XB_TMO])) break; if (_sp > XB_SPIN_CAP) { atomicAdd(&(bar)[XB_TMO], 1u); break; } } } } while (0)
struct XcdBarrier { unsigned* bar; unsigned x; volatile LAS unsigned* st; };
__device__ __forceinline__ XcdBarrier xcd_barrier_post(unsigned* bar, volatile LAS unsigned* st) {
    XcdBarrier b; b.bar = bar; b.x = xb_xcc_id(); b.st = st;
    if (threadIdx.x == 0) (void)xb_add(&bar[XB_XCNT(b.x)], 1u);
    return b;
}
__device__ __forceinline__ void xcd_barrier_complete(unsigned* bar, unsigned x, unsigned& nloc, unsigned& nx) {
    const unsigned G = gridDim.x * gridDim.y * gridDim.z;
    unsigned sum, cnt, mine, sp = 0u;
    for (;;) {
        sum = 0u; cnt = 0u; mine = 0u;
#pragma nounroll
        for (unsigned j = 0; j < 16; ++j) { const unsigned c = xb_ld(&bar[XB_XCNT(j)]); sum += c; cnt += (c > 0u) ? 1u : 0u; mine = (j == x) ? c : mine; }
        if (sum == G) break;
        __builtin_amdgcn_s_sleep(1);
        if ((++sp & 255u) == 0u) { if (xb_ld(&bar[XB_TMO])) break; if (sp > XB_SPIN_CAP) { atomicAdd(&bar[XB_TMO], 1u); break; } }
    }
    nloc = mine > 0u ? mine : 1u; nx = cnt > 0u ? cnt : 1u;
}
__device__ __forceinline__ void xcd_barrier(const XcdBarrier& b) {
    asm volatile("s_waitcnt vmcnt(0)" ::: "memory");
    __syncthreads();
    if (threadIdx.x == 0) {
        unsigned* bar = b.bar;
        __builtin_amdgcn_s_waitcnt(0);
        unsigned nloc = b.st[0], nx = b.st[1];
        if (nloc == 0u) { xcd_barrier_complete(bar, b.x, nloc, nx); b.st[0] = nloc; b.st[1] = nx; }
        const unsigned old = xb_add(&bar[XB_XSUB(b.x)], 1u);
        const unsigned gen = old / nloc;
        if (old + 1u == (gen + 1u) * nloc) {
            __builtin_amdgcn_fence(__ATOMIC_RELEASE, "agent");
            asm volatile("s_waitcnt vmcnt(0)" ::: "memory");
            const unsigned og = xb_add(&bar[XB_TOP], 1u);
            const unsigned tg = og / nx;
            if (og + 1u == (tg + 1u) * nx) xb_add(&bar[XB_TOPGEN], 1u);
            else XB_SPIN(xb_ld(&bar[XB_TOPGEN]) == tg, bar);
            __builtin_amdgcn_fence(__ATOMIC_ACQUIRE, "agent");
            xb_add(&bar[XB_XGEN(b.x)], 1u);
            asm volatile("s_waitcnt vmcnt(0)" ::: "memory");
        } else {
            XB_SPIN(xb_ld(&bar[XB_XGEN(b.x)]) == gen, bar);
            __builtin_amdgcn_fence(__ATOMIC_ACQUIRE, "agent");
            asm volatile("s_waitcnt vmcnt(0)" ::: "memory");
        }
    }
    __syncthreads();
}

#if defined(EXPM) && (EXPM & 64)
#define GSYNC() do { xcd_barrier(xbar); xcd_barrier(xbar); } while (0)
#else
#define GSYNC() xcd_barrier(xbar)
#endif
#define FRESH_IDS int tid_ = threadIdx.x; asm volatile("" : "+v"(tid_)); const int tid = tid_, wid = __builtin_amdgcn_readfirstlane(tid >> 6), lane = tid & 63; (void)wid; (void)lane;
__global__ void __launch_bounds__(NTHR, 2) mega(Params P) {
    extern __shared__ __attribute__((aligned(16))) unsigned char lds_raw[];
    LAS unsigned char* lds = (LAS unsigned char*)lds_raw;
    cg::grid_group grid = cg::this_grid();
    const int G = gridDim.x, bx = blockIdx.x;
    unsigned char* ws = P.ws;
    bf16_t* const WIN = (bf16_t*)(ws + WS_WIN); bf16_t* const WR = (bf16_t*)(ws + WS_WR); bf16_t* const WSG = (bf16_t*)(ws + WS_WS); bf16_t* const WO = (bf16_t*)(ws + WS_WO);
    bf16_t* const WG = (bf16_t*)(ws + WS_WG); bf16_t* const WPP = (bf16_t*)(ws + WS_WPP); bf16_t* const WC = (bf16_t*)(ws + WS_WC);
    float* const RSQ1 = (float*)(ws + WS_SV); float* const RSQ2 = (float*)(ws + WS_SV + 8 * MiB);
    bf16_t* const H = (bf16_t*)(ws + WS_H); bf16_t* const PB = (bf16_t*)(ws + WS_PB);
    bf16_t* const QK = (bf16_t*)(ws + WS_QK); bf16_t* const V = (bf16_t*)(ws + WS_V); bf16_t* const SV = (bf16_t*)(ws + WS_SV);
    bf16_t* const RG2 = (bf16_t*)(ws + WS_RG2); bf16_t* const UG2 = (bf16_t*)(ws + WS_UG2); bf16_t* const MR2 = (bf16_t*)(ws + WS_MR2); bf16_t* const MS2 = (bf16_t*)(ws + WS_MS2);
    bf16_t* const PREV = (bf16_t*)P.out;
    bf16_t* const MERGED = H; bf16_t* const X1B = QK; bf16_t* const PP = (bf16_t*)(ws + WS_PP);
    volatile LAS unsigned* xst = (volatile LAS unsigned*)(lds + LDS_STAGE);
    if (threadIdx.x < 4) xst[threadIdx.x] = 0u;
    __syncthreads();
    const XcdBarrier xbar = xcd_barrier_post((unsigned*)(ws + WS_BAR), xst);

    { FRESH_IDS phase0(P, lds, tid, wid, lane); }
    if (P.ws == nullptr) grid.sync();

    for (int sl = 0; sl < NSL; ++sl) {
        const int tokb = sl * TS;
        bf16_t* const RG = RG2 + (size_t)tokb * 1024; bf16_t* const UG = UG2 + (size_t)tokb * 1024;
        GSYNC();
        {
            pg8::Src1V g{H + (size_t)tokb * 1024, WIN, 1024}; pg8::StaticOrder S; S.init(TS, 8192, G, bx);
            Epi1 E{QK, UG, (const float*)(ws + WS_COS), (const float*)(ws + WS_SIN), sl, (float*)((unsigned char*)P.out + 64 * MiB)};
            pg8::gemm_phase(lds, g, 1024, S, E);
        }
        GSYNC();
        { FRESH_IDS for (int u = bx; u < BSL * 32 * 4; u += G) p2_unit(lds, QK, V, PREV, u, tid, wid, lane); }
        { FRESH_IDS for (int c = bx; c < BSL * 32; c += G) p5_unit(lds, SV, (const float*)((unsigned char*)P.out + 64 * MiB), UG, WC, P.sbs, c, tid, wid, lane); }
        GSYNC();
        { FRESH_IDS
        for (int it = bx * NTHR + tid; it < BSL * 4 * 256 * 32; it += G * NTHR) {
            const int d4 = it & 31, e = (it >> 5) & 255, h = (it >> 13) & 3, bl = it >> 15;
            const float cd = fexp(128.0f * lgam(h));
            f32x4 run = (f32x4){0.f, 0.f, 0.f, 0.f};
            const size_t base = ((size_t)(bl * 32) * 4 + h) * 32768 + e * 128 + d4 * 4;
#pragma unroll 8
            for (int n = 0; n < 32; ++n) {
                const size_t o = base + (size_t)n * 4 * 32768;
                const f32x4 kv = unpack4(*(const u32x2*)(PREV + o));
                *(u32x2*)(PREV + o) = pack4(run);
                run = kv + run * cd;
            }
        } }
        GSYNC();
        { FRESH_IDS for (int u = bx; u < BSL * 32 * 4; u += G) p4_unit(lds, QK, V, PREV, RG, RG, u, tid, wid, lane); }
    }
    GSYNC();
    {
        pg8::Src2 g{RG2, WR, (long)((const char*)UG2 - (const char*)RG2), (long)((const char*)WSG - (const char*)WR), 1024}; pg8::DualOrder S; S.init(T_ALL, 1024, G, bx);
        Epi6 E{MR2, MS2, MERGED};
        pg8::gemm_phase(lds, g, 1024, S, E);
    }
    GSYNC();
    {
        pg8::Src1 g{MERGED, WO, 1024}; pg8::StaticOrder S; S.init(T_ALL, 1024, G, bx);
        Epi7 E{P.x, X1B, RSQ1, 0};
        pg8::gemm_phase(lds, g, 1024, S, E);
        pg8::Src1 g2{PB, WPP, 256};
        EpiStore E2{PP};
        pg8::gemm_phase(lds, g2, 256, S, E2);
    }
    GSYNC();
    {
        pg8::Src1 g{X1B, WG, 1024}; pg8::StaticOrder S; S.init(T_ALL, 1024, G, bx);
        Epi8 E{X1B, MERGED, PP, RSQ1, RSQ2, 0};
        pg8::gemm_phase(lds, g, 1024, S, E);
    }
    GSYNC();
    {
        FRESH_IDS
        f32x4 gv[4];
#pragma unroll
        for (int i = 0; i < 2; ++i) { gv[2 * i] = *(const f32x4*)(P.gf + lane * 8 + 512 * i); gv[2 * i + 1] = *(const f32x4*)(P.gf + lane * 8 + 512 * i + 4); }
        for (int row = bx * 8 + wid; row < T_ALL; row += G * 8) {
            float sq = RSQ2[(size_t)row * 16 + (lane & 15)]; sq += __shfl_xor(sq, 1); sq += __shfl_xor(sq, 2); sq += __shfl_xor(sq, 4); sq += __shfl_xor(sq, 8);
            const float rstd = rsqrtf(sq * (1.0f / 1024.0f) + 1e-6f); float* o = P.out + (size_t)row * 1024; const bf16_t* xr = MERGED + (size_t)row * 1024;
#pragma unroll
            for (int i = 0; i < 2; ++i) { f32x4 a, b; unpack8(*(const u32x4*)(xr + lane * 8 + 512 * i), a, b);
                *(f32x4*)(o + lane * 8 + 512 * i) = a * rstd * gv[2 * i]; *(f32x4*)(o + lane * 8 + 512 * i + 4) = b * rstd * gv[2 * i + 1]; }
        }
    }
}

extern "C" void kernel_launch(void* const* d_in, const int* in_sizes, int n_in, void* d_out, int out_size, void* d_ws, size_t ws_size, hipStream_t stream) {
    static int grid_blocks = 0;
    if (grid_blocks == 0) {
        int dev = 0, cus = 0, per_cu = 0;
        hipGetDevice(&dev);
        hipDeviceGetAttribute(&cus, hipDeviceAttributeMultiprocessorCount, dev);
        if (hipFuncSetAttribute((const void*)mega, hipFuncAttributeMaxDynamicSharedMemorySize, LDS_BYTES) != hipSuccess) fprintf(stderr, "hipFuncSetAttribute failed\n");
        if (hipOccupancyMaxActiveBlocksPerMultiprocessor(&per_cu, (const void*)mega, NTHR, LDS_BYTES) != hipSuccess || per_cu < 1) { per_cu = 1; (void)hipGetLastError(); }
        grid_blocks = cus * (per_cu > 1 ? 1 : per_cu);
        if (ws_size < WS_END) fprintf(stderr, "workspace too small: %zu < %zu\n", ws_size, (size_t)WS_END);
    }
    Params p{};
    p.x = (const float*)d_in[0]; p.p = (const float*)d_in[1]; p.w_in = (const float*)d_in[2]; p.w_ret = (const float*)d_in[3]; p.w_sgu = (const float*)d_in[4];
    p.w_out = (const float*)d_in[5]; p.sws = (const float*)d_in[6]; p.sbs = (const float*)d_in[7]; p.wpg = (const float*)d_in[8]; p.wpp = (const float*)d_in[9];
    p.gm = (const float*)d_in[10]; p.gp = (const float*)d_in[11]; p.gf = (const float*)d_in[12];
    p.out = (float*)d_out; p.ws = (unsigned char*)d_ws;
    (void)hipMemsetAsync((char*)d_ws + WS_BAR, 0, XCD_BAR_WORDS * 4, stream);
    void* args[] = {&p};
    hipError_t e = hipLaunchCooperativeKernel((const void*)mega, dim3(grid_blocks), dim3(NTHR), args, LDS_BYTES, stream);
    if (e != hipSuccess) fprintf(stderr, "cooperative launch failed: %s (grid %d)\n", hipGetErrorString(e), grid_blocks);
}
```

```cpp
#include <hip/hip_runtime.h>
#include <hip/hip_cooperative_groups.h>
#include <cstdio>
namespace cg = cooperative_groups;

#define LAS __attribute__((address_space(3)))
typedef unsigned short bf16_t;
typedef short bf16x8 __attribute__((ext_vector_type(8)));
typedef float f32x4 __attribute__((ext_vector_type(4)));
typedef float f32x2 __attribute__((ext_vector_type(2)));
typedef unsigned u32x4 __attribute__((ext_vector_type(4)));
typedef unsigned u32x2 __attribute__((ext_vector_type(2)));

constexpr int T_ALL = 65536, DM = 1024, NSL = 2, TS = T_ALL / NSL, BSL = 16 / NSL;
constexpr int NTHR = 512;
constexpr int LDS_STAGE = 131072, LDS_BYTES = LDS_STAGE + 16;
constexpr size_t MiB = 1ull << 20;
constexpr size_t UB = (size_t)TS * 1024 * 2;
constexpr size_t WS_WIN = 0, WS_WR = 16 * MiB, WS_WS = 18 * MiB, WS_WO = 20 * MiB, WS_WG = 22 * MiB, WS_WPP = 24 * MiB, WS_WC = 24 * MiB + 512 * 1024,
                 WS_COS = 25 * MiB, WS_SIN = 26 * MiB, WS_RSQ1 = 27 * MiB, WS_RSQ2 = 27 * MiB + 256 * 1024, WS_BAR = 28 * MiB,
                 WS_H = 32 * MiB, WS_PB = 160 * MiB, WS_SL = 192 * MiB;
constexpr size_t WS_QK = WS_SL, WS_V = WS_SL + UB, WS_SV = WS_SL + 2 * UB, WS_RG2 = WS_SL + 3 * UB, WS_UG2 = WS_SL + 5 * UB, WS_MR2 = WS_SL + 7 * UB, WS_MS2 = WS_SL + 9 * UB,
                 WS_PP = WS_SL + 11 * UB, WS_END = WS_SL + 13 * UB;
static_assert(WS_END == 1024 * MiB, "workspace map");

__device__ __forceinline__ unsigned cvt_pk_bf16(float lo, float hi) { unsigned r; asm volatile("v_cvt_pk_bf16_f32 %0, %1, %2" : "=v"(r) : "v"(lo), "v"(hi)); return r; }
__device__ __forceinline__ float bf_lo(unsigned w) { return __uint_as_float(w << 16); }
__device__ __forceinline__ float bf_hi(unsigned w) { return __uint_as_float(w & 0xffff0000u); }
__device__ __forceinline__ float bf2f(unsigned short b) { return __uint_as_float(((unsigned)b) << 16); }
__device__ __forceinline__ float wave_sum(float v) {
#pragma unroll
    for (int o = 32; o >= 1; o >>= 1) v += __shfl_xor(v, o);
    return v;
}
__device__ __forceinline__ float sigmoidf_(float x) { return __builtin_amdgcn_rcpf(1.0f + __builtin_amdgcn_exp2f(-1.4426950408889634f * x)); }
__device__ __forceinline__ float fexp(float x) { return __builtin_amdgcn_exp2f(1.4426950408889634f * x); }
__device__ __forceinline__ f32x2 gelu_pk(f32x2 v) {
    const f32x2 av = __builtin_elementwise_abs(v), d = av * 0.2316418882f + 1.0f;
    f32x2 t; t.x = __builtin_amdgcn_rcpf(d.x); t.y = __builtin_amdgcn_rcpf(d.y);
    f32x2 q = t * 0.5307027145f + (-0.7265760135f); q = q * t + 0.7107068705f; q = q * t + (-0.142248368f); q = q * t + 0.127414796f; q = q * t;
    const f32x2 s = (v * v) * (-0.72134752044f);
    f32x2 e; e.x = __builtin_amdgcn_exp2f(s.x); e.y = __builtin_amdgcn_exp2f(s.y);
    const f32x2 m = v * (q * e), r = v - m;
    f32x2 o; o.x = v.x < 0.f ? m.x : r.x; o.y = v.y < 0.f ? m.y : r.y; return o;
}
__device__ __forceinline__ f32x4 gelu4(f32x4 v) { f32x2 a = gelu_pk((f32x2){v[0], v[1]}), b = gelu_pk((f32x2){v[2], v[3]}); return (f32x4){a.x, a.y, b.x, b.y}; }
__device__ __forceinline__ f32x4 sig4(f32x4 v) { return (f32x4){sigmoidf_(v[0]), sigmoidf_(v[1]), sigmoidf_(v[2]), sigmoidf_(v[3])}; }
__device__ __forceinline__ float lgam(int h) { return h == 0 ? -0.03174869831458027f : h == 1 ? -0.01574835696813892f : h == 2 ? -0.007843177461025892f : -0.003913899321136329f; }

namespace pg8 {
constexpr int BM = 256, BK = 64, HALF = 128, HTB = HALF * BK * 2, STAGE_BYTES = 8 * HTB, NXCD = 8, WGM = 8;
__host__ __device__ __forceinline__ int lds_byte(int r, int c) { const int st = (r >> 4) * 2 + (c >> 5), rr = r & 15, cc = c & 31, ob = rr * 64 + cc * 2; return st * 1024 + (ob ^ (((ob >> 9) & 1) << 5)); }
__host__ __device__ __forceinline__ void stage_rc(int b, int& R, int& C) { const int st = b / 1024, sb = b % 1024, swz = sb ^ (((sb >> 9) & 1) << 5); R = (st >> 1) * 16 + swz / 64; C = (st & 1) * 32 + (swz % 64) / 2; }
__host__ __device__ __forceinline__ int perm32(int rho) { const int n = rho >> 4, i = rho & 15; return 8 * (i >> 2) + 4 * n + (i & 3); }

struct Unit { int pm, pn, part; };
struct StaticOrder {
    int nM, nN, nwg, G, c;
    __device__ void init(int M, int N, int G_, int c_) { nM = M / BM; nN = N / BM; nwg = nM * nN; G = G_; c = c_; }
    __device__ bool next(int i, Unit& u) const {
        const long L = (long)i * G + c; if (L >= nwg) return false;
        int wgid = (int)L; { const int q = nwg / NXCD, r = nwg % NXCD, xcd = wgid % NXCD, off = wgid / NXCD; wgid = (xcd < r ? xcd * (q + 1) : r * (q + 1) + (xcd - r) * q) + off; }
        const int nig = WGM * nN, gid = wgid / nig, fm = gid * WGM, gsz = (nM - fm) < WGM ? (nM - fm) : WGM;
        u.pm = fm + ((wgid % nig) % gsz); u.pn = (wgid % nig) / gsz; u.part = 0; return true;
    }
};
struct DualOrder : StaticOrder {
    __device__ bool next(int i, Unit& u) const { if (!StaticOrder::next(i >> 1, u)) return false; u.part = i & 1; return true; }
};
struct Src1 { const bf16_t* A; const bf16_t* Bt; int K;
    __device__ __forceinline__ const char* a(const Unit& u) const { return (const char*)A + (size_t)u.pm * BM * K * 2; }
    __device__ __forceinline__ const char* b(const Unit& u) const { return (const char*)Bt + (size_t)u.pn * BM * K * 2; } };
struct Src1V { const bf16_t* A; const bf16_t* Bt; int K;
    __device__ __forceinline__ const char* a(const Unit& u) const { const char* pa = (const char*)A + (size_t)u.pm * BM * K * 2; const char* pb = (const char*)Bt + (size_t)u.pn * BM * K * 2; const long sw = (u.pn >= 4 && u.pn < 8) ? 1 : 0; return pa + sw * (long)(pb - pa); }
    __device__ __forceinline__ const char* b(const Unit& u) const { const char* pa = (const char*)A + (size_t)u.pm * BM * K * 2; const char* pb = (const char*)Bt + (size_t)u.pn * BM * K * 2; const long sw = (u.pn >= 4 && u.pn < 8) ? 1 : 0; return pb - sw * (long)(pb - pa); } };
struct Src2 { const bf16_t* A0; const bf16_t* B0; long dA, dB; int K;
    __device__ __forceinline__ const char* a(const Unit& u) const { return (const char*)A0 + (long)u.part * dA + (size_t)u.pm * BM * K * 2; }
    __device__ __forceinline__ const char* b(const Unit& u) const { return (const char*)B0 + (long)u.part * dB + (size_t)u.pn * BM * K * 2; } };

template <class Epi, class Sched, class Src>
__device__ __forceinline__ void gemm_phase(LAS unsigned char* lds, const Src& g, const int K, const Sched& S, const Epi& E) {
    int tid_ = threadIdx.x; asm volatile("" : "+v"(tid_));
    const int tid = tid_, wid = __builtin_amdgcn_readfirstlane(tid >> 6), lane = tid & 63, wr = wid >> 2, wc = wid & 3, fr = lane & 15, fq = lane >> 4;
    const int nt = K / BK;
    unsigned voffA[2], voffB[2];
#pragma unroll
    for (int i = 0; i < 2; ++i) { int R, C; stage_rc(tid * 16 + i * 8192, R, C); const int Rb = Epi::PERM ? ((R & ~31) + perm32(R & 31)) : R;
        voffA[i] = (unsigned)(R * K + C) * 2u; voffB[i] = (unsigned)(Rb * K + C) * 2u; }
    const size_t kstep = (size_t)(BK * 2);
    const size_t hstep = (size_t)HALF * K * 2;
    const unsigned ldsw = (unsigned)wid * 1024u;
    const int aoff = lds_byte(wr * 64 + fr, fq * 8), boff = lds_byte(wc * 32 + fr, fq * 8);
#define PG8_SA(b, h) (((b) * 2 + (h)) * HTB)
#define PG8_SB(b, h) ((4 + (b) * 2 + (h)) * HTB)
#define PG8_STAGE(bufoff, gbase, voff) do { _Pragma("unroll") for (int _i = 0; _i < 2; ++_i) \
        __builtin_amdgcn_global_load_lds((const unsigned*)((const char*)(gbase) + (voff)[_i]), (LAS unsigned*)(lds + (bufoff) + ldsw + _i * 8192), 16, 0, 0); } while (0)
#define PG8_LDA(dst, b, h) do { _Pragma("unroll") for (int m = 0; m < 4; ++m) _Pragma("unroll") for (int k = 0; k < 2; ++k) dst[m][k] = *(const LAS bf16x8*)(lds + PG8_SA(b, h) + aoff + m * 2048 + k * 1024); } while (0)
#define PG8_LDB(dst, b, h) do { _Pragma("unroll") for (int n = 0; n < 2; ++n) _Pragma("unroll") for (int k = 0; k < 2; ++k) dst[n][k] = *(const LAS bf16x8*)(lds + PG8_SB(b, h) + boff + n * 2048 + k * 1024); } while (0)
#define PG8_MMA(ai, bj, At, Bt) do { __builtin_amdgcn_s_setprio(1); _Pragma("unroll") for (int m = 0; m < 4; ++m) _Pragma("unroll") for (int n = 0; n < 2; ++n) _Pragma("unroll") for (int k = 0; k < 2; ++k) \
        acc[ai][bj][m][n] = __builtin_amdgcn_mfma_f32_16x16x32_bf16(Bt[n][k], At[m][k], acc[ai][bj][m][n], 0, 0, 0); __builtin_amdgcn_s_setprio(0); } while (0)
#define PG8_WAIT_V(n) asm volatile("s_waitcnt vmcnt(" #n ")" ::: "memory")
#define PG8_WAIT_L(n) asm volatile("s_waitcnt lgkmcnt(" #n ")" ::: "memory")
#define PG8_BAR __builtin_amdgcn_s_barrier()
#define PG8_SCHED __builtin_amdgcn_sched_barrier(0)
    Unit cur, nxt; int ui = 0;
    if (!S.next(0, cur)) return;
    f32x4 acc[2][2][4][2];
#pragma unroll
    for (int a = 0; a < 2; ++a)
#pragma unroll
        for (int b = 0; b < 2; ++b)
#pragma unroll
            for (int m = 0; m < 4; ++m)
#pragma unroll
                for (int n = 0; n < 2; ++n) acc[a][b][m][n] = (f32x4){0.f, 0.f, 0.f, 0.f};
    bf16x8 At[4][2], B0[2][2], B1[2][2];
    const char* cA = g.a(cur); const char* cB = g.b(cur);
    PG8_STAGE(PG8_SB(0, 0), cB, voffB); PG8_STAGE(PG8_SA(0, 0), cA, voffA); PG8_STAGE(PG8_SB(0, 1), cB + hstep, voffB); PG8_STAGE(PG8_SA(0, 1), cA + hstep, voffA);
    if (wr == 1) PG8_BAR;
    PG8_WAIT_V(4); PG8_BAR;
    PG8_STAGE(PG8_SB(1, 0), cB + kstep, voffB); PG8_STAGE(PG8_SA(1, 0), cA + kstep, voffA); PG8_STAGE(PG8_SB(1, 1), cB + hstep + kstep, voffB);
    PG8_WAIT_V(6); PG8_BAR;
    for (;;) {
        const bool has_next = S.next(ui + 1, nxt);
        const char* nA = has_next ? g.a(nxt) : cA; const char* nB = has_next ? g.b(nxt) : cB;
        for (int t = 0; t < nt; t += 2) {
            const bool last = (t == nt - 2);
            const char* a1 = cA + (size_t)(t + 1) * kstep;
            const char* a2 = last ? nA : cA + (size_t)(t + 2) * kstep; const char* b2 = last ? nB : cB + (size_t)(t + 2) * kstep;
            const char* a3 = a2 + kstep; const char* b3 = b2 + kstep;
            PG8_LDB(B0, 0, 0); PG8_SCHED; PG8_LDA(At, 0, 0); PG8_STAGE(PG8_SA(1, 1), a1 + hstep, voffA);
            PG8_WAIT_L(8); PG8_BAR; PG8_WAIT_L(0); PG8_MMA(0, 0, At, B0); PG8_BAR; PG8_SCHED;
            PG8_LDB(B1, 0, 1); PG8_STAGE(PG8_SB(0, 0), b2, voffB);
            PG8_BAR; PG8_WAIT_L(0); PG8_MMA(0, 1, At, B1); PG8_BAR;
            PG8_LDA(At, 0, 1); PG8_STAGE(PG8_SA(0, 0), a2, voffA);
            PG8_BAR; PG8_WAIT_L(0); PG8_MMA(1, 0, At, B0); PG8_BAR; PG8_SCHED;
            PG8_STAGE(PG8_SB(0, 1), b2 + hstep, voffB);
            PG8_WAIT_V(6); PG8_BAR; PG8_MMA(1, 1, At, B1); PG8_BAR;
            PG8_LDB(B0, 1, 0); PG8_SCHED; PG8_LDA(At, 1, 0); PG8_STAGE(PG8_SA(0, 1), a2 + hstep, voffA);
            PG8_WAIT_L(8); PG8_BAR; PG8_WAIT_L(0); PG8_MMA(0, 0, At, B0); PG8_BAR; PG8_SCHED;
            PG8_LDB(B1, 1, 1); PG8_STAGE(PG8_SB(1, 0), b3, voffB);
            PG8_BAR; PG8_WAIT_L(0); PG8_MMA(0, 1, At, B1); PG8_BAR;
            PG8_LDA(At, 1, 1); PG8_STAGE(PG8_SA(1, 0), a3, voffA);
            PG8_BAR; PG8_WAIT_L(0); PG8_MMA(1, 0, At, B0); PG8_BAR; PG8_SCHED;
            PG8_STAGE(PG8_SB(1, 1), b3 + hstep, voffB);
            PG8_WAIT_V(6); PG8_BAR; PG8_MMA(1, 1, At, B1); PG8_BAR;
        }
        {
            int epm = cur.pm, epn = cur.pn, efr = fr, efq = fq; asm volatile("" : "+s"(epm), "+s"(epn), "+v"(efr), "+v"(efq));
            const Unit eu{epm, epn, cur.part};
            E(acc, eu, wr, wc, efr, efq);
        }
        if (!has_next) break;
        if (!E.keep(cur)) {
#pragma unroll
            for (int a = 0; a < 2; ++a)
#pragma unroll
                for (int b = 0; b < 2; ++b)
#pragma unroll
                    for (int m = 0; m < 4; ++m)
#pragma unroll
                        for (int n = 0; n < 2; ++n) acc[a][b][m][n] = (f32x4){0.f, 0.f, 0.f, 0.f};
        }
        cur = nxt; cA = nA; cB = nB; ++ui;
    }
    PG8_WAIT_V(0);
    if (wr == 0) PG8_BAR;
    PG8_BAR;
#undef PG8_SA
#undef PG8_SB
#undef PG8_STAGE
#undef PG8_LDA
#undef PG8_LDB
#undef PG8_MMA
#undef PG8_WAIT_V
#undef PG8_WAIT_L
#undef PG8_BAR
#undef PG8_SCHED
}
}
using pg8::Unit;
typedef f32x4 AccT[2][2][4][2];

__device__ __forceinline__ u32x4 pack8(f32x4 a, f32x4 b) { u32x4 w; w.x = cvt_pk_bf16(a[0], a[1]); w.y = cvt_pk_bf16(a[2], a[3]); w.z = cvt_pk_bf16(b[0], b[1]); w.w = cvt_pk_bf16(b[2], b[3]); return w; }
__device__ __forceinline__ u32x2 pack4(f32x4 a) { u32x2 w; w.x = cvt_pk_bf16(a[0], a[1]); w.y = cvt_pk_bf16(a[2], a[3]); return w; }
__device__ __forceinline__ void unpack8(u32x4 w, f32x4& a, f32x4& b) { a = (f32x4){bf_lo(w.x), bf_hi(w.x), bf_lo(w.y), bf_hi(w.y)}; b = (f32x4){bf_lo(w.z), bf_hi(w.z), bf_lo(w.w), bf_hi(w.w)}; }
__device__ __forceinline__ f32x4 unpack4(u32x2 w) { return (f32x4){bf_lo(w.x), bf_hi(w.x), bf_lo(w.y), bf_hi(w.y)}; }

struct Epi1 {
    static constexpr bool PERM = true;
    bf16_t *QK, *UG; const float* cs; const float* sn; int sl;
    __device__ __forceinline__ bool keep(const Unit&) const { return false; }
    __device__ __forceinline__ void operator()(AccT& acc, const Unit& u, int wr, int wc, int fr, int fq) const {
        const int pn = u.pn, cl = wc * 32 + 8 * fq, row0 = u.pm * 256 + wr * 64 + fr;
        if (pn < 4) {
            const int isk = pn >> 1, t = pn & 1, head = 2 * t + (cl >> 6), dim0 = cl & 63;
            const float sc = isk ? 1.0f : 0.08838834764831845f;
            bf16_t* base = QK + isk * 512 + head * 128 + dim0;
            f32x4 tb[2][2][4];
#define ROT_LD(b, buf) do { _Pragma("unroll") for (int mm = 0; mm < 2; ++mm) { const int pos_ = (row0 + ((b) >> 1) * 128 + (((b) & 1) * 2 + mm) * 16) & 4095; \
                tb[buf][mm][0] = *(const f32x4*)(cs + pos_ * 64 + dim0); tb[buf][mm][1] = *(const f32x4*)(cs + pos_ * 64 + dim0 + 4); \
                tb[buf][mm][2] = *(const f32x4*)(sn + pos_ * 64 + dim0); tb[buf][mm][3] = *(const f32x4*)(sn + pos_ * 64 + dim0 + 4); } } while (0)
            ROT_LD(0, 0);
#pragma unroll
            for (int b = 0; b < 4; ++b) {
                if (b + 1 < 4) ROT_LD(b + 1, (b + 1) & 1);
#pragma unroll
                for (int mm = 0; mm < 2; ++mm) {
                    const int ai = b >> 1, m = (b & 1) * 2 + mm, row = row0 + ai * 128 + m * 16;
                    const f32x4 c0 = tb[b & 1][mm][0], c1 = tb[b & 1][mm][1], s0 = tb[b & 1][mm][2], s1 = tb[b & 1][mm][3];
                    const f32x4 x1a = acc[ai][0][m][0], x1b = acc[ai][0][m][1], x2a = acc[ai][1][m][0], x2b = acc[ai][1][m][1];
                    const f32x4 o1a = (x1a * c0 - x2a * s0) * sc, o1b = (x1b * c1 - x2b * s1) * sc, o2a = (x2a * c0 + x1a * s0) * sc, o2b = (x2b * c1 + x1b * s1) * sc;
                    *(u32x4*)(base + (size_t)row * 1024) = pack8(o1a, o1b);
                    *(u32x4*)(base + (size_t)row * 1024 + 64) = pack8(o2a, o2b);
                }
            }
#undef ROT_LD
        } else if (pn >= 12 && pn < 20) {
            bf16_t* base = UG + 128 * (pn - 12) + cl;
#pragma unroll
            for (int ai = 0; ai < 2; ++ai)
#pragma unroll
                for (int m = 0; m < 4; ++m) {
                    const int row = row0 + ai * 128 + m * 16;
                    const f32x4 ua = gelu4(acc[ai][0][m][0]), ub = gelu4(acc[ai][0][m][1]);
                    const f32x4 ga = acc[ai][1][m][0], gb = acc[ai][1][m][1];
                    *(u32x4*)(base + (size_t)row * 1024) = pack8(ua * ga * sig4(ga), ub * gb * sig4(gb));
                }
        } else if (pn >= 24) {
            bf16_t* rbase = QK + (size_t)(3 + 2 * NSL + sl) * ((size_t)TS * 1024) + 128 * (pn - 24) + cl;
            bf16_t* sbase = QK + (size_t)(3 + 3 * NSL + sl) * ((size_t)TS * 1024) + 128 * (pn - 24) + cl;
#pragma unroll
            for (int ai = 0; ai < 2; ++ai)
#pragma unroll
                for (int m = 0; m < 4; ++m) {
                    const int row = row0 + ai * 128 + m * 16;
                    f32x4 r[2], sg[2];
#pragma unroll
                    for (int n = 0; n < 2; ++n) {
                        const f32x4 b = acc[ai][1][m][n];
                        const f32x4 one = (f32x4){1.0f + __builtin_amdgcn_exp2f(-1.4426950408889634f * b[0]), 1.0f + __builtin_amdgcn_exp2f(-1.4426950408889634f * b[1]),
                                                  1.0f + __builtin_amdgcn_exp2f(-1.4426950408889634f * b[2]), 1.0f + __builtin_amdgcn_exp2f(-1.4426950408889634f * b[3])};
                        sg[n] = (f32x4){__builtin_amdgcn_rcpf(one[0]), __builtin_amdgcn_rcpf(one[1]), __builtin_amdgcn_rcpf(one[2]), __builtin_amdgcn_rcpf(one[3])};
                        r[n] = sig4(acc[ai][0][m][n]) * one;
                    }
                    *(u32x4*)(rbase + (size_t)row * 1024) = pack8(r[0], r[1]);
                    *(u32x4*)(sbase + (size_t)row * 1024) = pack8(sg[0], sg[1]);
                    asm volatile("" ::: "memory");
                }
        } else if (pn < 8) {
            bf16_t* vt = QK + (size_t)TS * 1024;
#pragma unroll
            for (int ai = 0; ai < 2; ++ai)
#pragma unroll
                for (int m = 0; m < 4; ++m) {
                    const int e = ai * 128 + wr * 64 + m * 16 + fr;
#pragma unroll
                    for (int bj = 0; bj < 2; ++bj)
                        *(u32x4*)(vt + (((size_t)(u.pm * 2 + bj) * 4 + (pn - 4)) * 256 + e) * 128 + cl) = pack8(acc[ai][bj][m][0], acc[ai][bj][m][1]);
                }
        } else {
            const int act = pn < 8 ? 0 : pn < 12 ? 1 : pn < 24 ? 2 : 3;
            const int bidx = pn < 8 ? 1 : pn < 12 ? 3 + sl : pn < 24 ? 2 : pn < 28 ? 7 + sl : 9 + sl;
            const int tl = pn < 8 ? pn - 4 : pn < 12 ? pn - 8 : pn < 24 ? pn - 20 : pn < 28 ? pn - 24 : pn - 28;
            bf16_t* base = QK + (size_t)bidx * ((size_t)TS * 1024) + tl * 256 + cl;
#pragma unroll
            for (int ai = 0; ai < 2; ++ai)
#pragma unroll
                for (int m = 0; m < 4; ++m) {
                    const int row = row0 + ai * 128 + m * 16;
#pragma unroll
                    for (int bj = 0; bj < 2; ++bj) {
                        f32x4 a = acc[ai][bj][m][0], b = acc[ai][bj][m][1];
                        if (act == 1) { a = a * sig4(a); b = b * sig4(b); }
                        else if (act == 2) { a = gelu4(a); b = gelu4(b); }
                        else if (act == 3) { a = sig4(a); b = sig4(b); }
                        *(u32x4*)(base + (size_t)row * 1024 + bj * 128) = pack8(a, b);
                    }
                }
        }
    }
};
struct Epi6 {
    static constexpr bool PERM = true;
    const bf16_t* MR; const bf16_t* MS; bf16_t* O;
    __device__ __forceinline__ bool keep(const Unit& u) const { return u.part == 0; }
    __device__ __forceinline__ void operator()(AccT& acc, const Unit& u, int wr, int wc, int fr, int fq) const {
        const int row0 = u.pm * 256 + wr * 64 + fr, col0 = u.pn * 256 + wc * 32 + 8 * fq;
        u32x4 sb[4][2];
#define E6_LD(g) do { _Pragma("unroll") for (int bj = 0; bj < 2; ++bj) { const size_t off_ = (size_t)(row0 + ((g) >> 2) * 128 + ((g) & 3) * 16) * 1024 + col0 + bj * 128; \
            if (u.part == 0) sb[(g) & 3][bj] = *(const u32x4*)(MR + off_); else sb[(g) & 3][bj] = *(const u32x4*)(MS + off_); } } while (0)
        E6_LD(0); E6_LD(1); E6_LD(2);
#pragma unroll
        for (int g = 0; g < 8; ++g) {
            if (g + 3 < 8) E6_LD(g + 3);
            const int ai = g >> 2, m = g & 3;
#pragma unroll
            for (int bj = 0; bj < 2; ++bj) {
                const size_t off = (size_t)(row0 + ai * 128 + m * 16) * 1024 + col0 + bj * 128;
                f32x4 sa, sbv; unpack8(sb[g & 3][bj], sa, sbv);
                if (u.part == 0) {
#pragma unroll
                    for (int j = 0; j < 4; ++j) { acc[ai][bj][m][0][j] *= sa[j]; acc[ai][bj][m][1][j] *= sbv[j]; }
                } else {
                    *(u32x4*)(O + off) = pack8(acc[ai][bj][m][0] * sa, acc[ai][bj][m][1] * sbv);
                }
            }
        }
#undef E6_LD
    }
};
struct EpiStore {
    static constexpr bool PERM = true;
    bf16_t* O;
    __device__ __forceinline__ bool keep(const Unit&) const { return false; }
    __device__ __forceinline__ void operator()(AccT& acc, const Unit& u, int wr, int wc, int fr, int fq) const {
        const int row0 = u.pm * 256 + wr * 64 + fr, col0 = u.pn * 256 + wc * 32 + 8 * fq;
#pragma unroll
        for (int ai = 0; ai < 2; ++ai)
#pragma unroll
            for (int m = 0; m < 4; ++m)
#pragma unroll
                for (int bj = 0; bj < 2; ++bj)
                    *(u32x4*)(O + (size_t)(row0 + ai * 128 + m * 16) * 1024 + col0 + bj * 128) = pack8(acc[ai][bj][m][0], acc[ai][bj][m][1]);
    }
};
struct Epi7 {
    static constexpr bool PERM = false;
    const float* x; bf16_t* X1B; float* rsq; int tok0;
    __device__ __forceinline__ bool keep(const Unit&) const { return false; }
    __device__ __forceinline__ void operator()(AccT& acc, const Unit& u, int wr, int wc, int fr, int fq) const {
        const int row0 = u.pm * 256 + wr * 64 + fr, col0 = u.pn * 256 + wc * 32 + 4 * fq;
        f32x4 xb[4][2][2];
#define E7_LD(g) do { _Pragma("unroll") for (int bj = 0; bj < 2; ++bj) _Pragma("unroll") for (int n = 0; n < 2; ++n) \
            xb[(g) & 3][bj][n] = *(const f32x4*)(x + ((size_t)tok0 + row0 + ((g) >> 2) * 128 + ((g) & 3) * 16) * 1024 + col0 + bj * 128 + n * 16); } while (0)
        E7_LD(0); E7_LD(1); E7_LD(2);
#pragma unroll
        for (int g = 0; g < 8; ++g) {
            if (g + 3 < 8) E7_LD(g + 3);
            const int ai = g >> 2, m = g & 3, row = row0 + ai * 128 + m * 16; const size_t tok = (size_t)tok0 + row; float ss = 0.f;
#pragma unroll
            for (int bj = 0; bj < 2; ++bj)
#pragma unroll
                for (int n = 0; n < 2; ++n) {
                    const int col = col0 + bj * 128 + n * 16;
                    const f32x4 o = xb[g & 3][bj][n] + acc[ai][bj][m][n];
                    *(u32x2*)(X1B + (size_t)row * 1024 + col) = pack4(o);
                    ss += (o[0] * o[0] + o[1] * o[1]) + (o[2] * o[2] + o[3] * o[3]);
                }
            ss += __shfl_xor(ss, 16); ss += __shfl_xor(ss, 32);
            if (fq == 0) rsq[tok * 16 + u.pn * 4 + wc] = ss;
        }
#undef E7_LD
    }
};
struct Epi8 {
    static constexpr bool PERM = false;
    const bf16_t* X1B; bf16_t* X2B; const bf16_t* PP; const float* rsq1; float* rsq2; int tok0;
    __device__ __forceinline__ bool keep(const Unit&) const { return false; }
    __device__ __forceinline__ void operator()(AccT& acc, const Unit& u, int wr, int wc, int fr, int fq) const {
        const int row0 = u.pm * 256 + wr * 64 + fr, col0 = u.pn * 256 + wc * 32 + 4 * fq;
        float rs[8];
        {   f32x4 sl[8];
#pragma unroll
            for (int r = 0; r < 8; ++r) sl[r] = *(const f32x4*)(rsq1 + ((size_t)tok0 + row0 + (r >> 2) * 128 + (r & 3) * 16) * 16 + 4 * fq);
#pragma unroll
            for (int r = 0; r < 8; ++r) { float t = (sl[r][0] + sl[r][1]) + (sl[r][2] + sl[r][3]); t += __shfl_xor(t, 16); t += __shfl_xor(t, 32); rs[r] = t; } }
        u32x2 pb[4][2][2], xb[4][2][2];
#define E8_LD(g) do { _Pragma("unroll") for (int bj = 0; bj < 2; ++bj) _Pragma("unroll") for (int n = 0; n < 2; ++n) { \
            const size_t off_ = (size_t)(row0 + ((g) >> 2) * 128 + ((g) & 3) * 16) * 1024 + col0 + bj * 128 + n * 16; \
            pb[(g) & 3][bj][n] = *(const u32x2*)(PP + off_); xb[(g) & 3][bj][n] = *(const u32x2*)(X1B + off_); } } while (0)
        E8_LD(0); E8_LD(1); E8_LD(2);
#pragma unroll
        for (int g = 0; g < 8; ++g) {
            if (g + 3 < 8) E8_LD(g + 3);
            const int ai = g >> 2, m = g & 3, row = row0 + ai * 128 + m * 16; const size_t tok = (size_t)tok0 + row; float ss = 0.f;
            const float rstd = rsqrtf(rs[g] * (1.0f / 1024.0f) + 1e-6f);
#pragma unroll
            for (int bj = 0; bj < 2; ++bj)
#pragma unroll
                for (int n = 0; n < 2; ++n) {
                    const size_t off = (size_t)row * 1024 + col0 + bj * 128 + n * 16;
                    const f32x4 gt = sig4(acc[ai][bj][m][n] * rstd);
                    const f32x4 o = unpack4(xb[g & 3][bj][n]) + gt * unpack4(pb[g & 3][bj][n]);
                    *(u32x2*)(X2B + off) = pack4(o);
                    ss += (o[0] * o[0] + o[1] * o[1]) + (o[2] * o[2] + o[3] * o[3]);
                }
            ss += __shfl_xor(ss, 16); ss += __shfl_xor(ss, 32);
            if (fq == 0) rsq2[tok * 16 + u.pn * 4 + wc] = ss;
        }
#undef E8_LD
    }
};

__device__ __forceinline__ int srccol_win(int np) {
    const int pn = np >> 8, L = np & 255;
    if (pn < 4) { const int isk = pn >> 1, t = pn & 1, half = L >> 7, i = L & 127, head = 2 * t + (i >> 6), dim = (i & 63) + 64 * half; return isk * 512 + head * 128 + dim; }
    if (pn < 8) return 1024 + (pn - 4) * 256 + L;
    if (pn < 12) return 2048 + (pn - 8) * 256 + L;
    if (pn < 20) { const int t = pn - 12; return L < 128 ? 3072 + 128 * t + L : 5120 + 128 * t + (L - 128); }
    if (pn < 24) return 4096 + (pn - 20) * 256 + L;
    { const int t = pn - 24; return L < 128 ? 6144 + 128 * t + L : 7168 + 128 * t + (L - 128); }
}
__device__ __forceinline__ void p0_transpose(LAS float* tile, const float* src, int ldsrc, int k0, int c0, bf16_t* dst, int ldk, int n0, const float* kscale, int tid) {
#pragma unroll
    for (int p = 0; p < 2; ++p) {
        const int r = (tid >> 4) + 32 * p, c4 = (tid & 15) * 4;
        const f32x4 v = *(const f32x4*)(src + (size_t)(k0 + r) * ldsrc + c0 + c4);
        const float s = kscale ? kscale[k0 + r] : 1.0f;
        tile[r * 65 + c4 + 0] = v[0] * s; tile[r * 65 + c4 + 1] = v[1] * s; tile[r * 65 + c4 + 2] = v[2] * s; tile[r * 65 + c4 + 3] = v[3] * s;
    }
    __syncthreads();
    {
        const int n = tid >> 3, kc = (tid & 7) * 8;
        u32x4 w;
        w.x = cvt_pk_bf16(tile[(kc + 0) * 65 + n], tile[(kc + 1) * 65 + n]); w.y = cvt_pk_bf16(tile[(kc + 2) * 65 + n], tile[(kc + 3) * 65 + n]);
        w.z = cvt_pk_bf16(tile[(kc + 4) * 65 + n], tile[(kc + 5) * 65 + n]); w.w = cvt_pk_bf16(tile[(kc + 6) * 65 + n], tile[(kc + 7) * 65 + n]);
        *(u32x4*)(dst + (size_t)(n0 + n) * ldk + k0 + kc) = w;
    }
    __syncthreads();
}

struct Params { const float *x, *p, *w_in, *w_ret, *w_sgu, *w_out, *sws, *sbs, *wpg, *wpp, *gm, *gp, *gf; float* out; unsigned char* ws; };

__device__ __forceinline__ void phase0(const Params& P, LAS unsigned char* lds, int tid, int wid, int lane) {
    unsigned char* ws = P.ws;
    const int G = gridDim.x, bx = blockIdx.x;
    LAS float* tile = (LAS float*)lds;
    for (int idx = bx; idx < 3136; idx += G) {
        if (idx < 2048) { const int kt = idx & 15, ntl = idx >> 4; p0_transpose(tile, P.w_in, 8192, kt * 64, srccol_win(ntl * 64), (bf16_t*)(ws + WS_WIN), 1024, ntl * 64, nullptr, tid); }
        else if (idx < 3072) { const int w = (idx - 2048) >> 8, r = (idx - 2048) & 255, kt = r & 15, ntl = r >> 4;
            const float* src = w == 0 ? P.w_ret : w == 1 ? P.w_sgu : w == 2 ? P.w_out : P.wpg;
            bf16_t* dst = (bf16_t*)(ws + (w == 0 ? WS_WR : w == 1 ? WS_WS : w == 2 ? WS_WO : WS_WG));
            p0_transpose(tile, src, 1024, kt * 64, ntl * 64, dst, 1024, ntl * 64, w == 3 ? P.gp : nullptr, tid); }
        else { const int r = idx - 3072, kt = r & 3, ntl = r >> 2; p0_transpose(tile, P.wpp, 1024, kt * 64, ntl * 64, (bf16_t*)(ws + WS_WPP), 256, ntl * 64, nullptr, tid); }
    }
    const int gt = bx * NTHR + tid, gn = G * NTHR;
    for (int i = gt; i < 4 * 128 * 128; i += gn) { const int r = (i >> 7) & 127, c = i & 127; const float v = c <= r ? P.sws[i] : 0.0f; ((bf16_t*)(ws + WS_WC))[i] = (bf16_t)(cvt_pk_bf16(v, 0.f) & 0xffffu); }
    for (int i = gt; i < 4096 * 64; i += gn) {
        const int pos = i >> 6, j = i & 63;
        const float inv = exp2f(-(float)j * (13.287712379549449f / 64.0f));
        const float ang = (float)pos * inv;
        const double a = (double)ang; const double nrev = rint(a * 0.15915494309189535); const float r = (float)(a - nrev * 6.283185307179586);
        ((float*)(ws + WS_COS))[i] = cosf(r); ((float*)(ws + WS_SIN))[i] = sinf(r);
    }
    for (size_t i = (size_t)gt * 8; i < (size_t)T_ALL * 256; i += (size_t)gn * 8) {
        const f32x4 a = *(const f32x4*)(P.p + i), b = *(const f32x4*)(P.p + i + 4);
        *(u32x4*)((bf16_t*)(ws + WS_PB) + i) = pack8(a, b);
    }
    {
        f32x4 gv[4];
#pragma unroll
        for (int i = 0; i < 4; ++i) gv[i] = *(const f32x4*)(P.gm + lane * 4 + 256 * i);
        for (int row = bx * 8 + wid; row < T_ALL; row += G * 8) {
            const float* xr = P.x + (size_t)row * 1024; f32x4 v[4]; float ss = 0.f;
#pragma unroll
            for (int i = 0; i < 4; ++i) { v[i] = *(const f32x4*)(xr + lane * 4 + 256 * i); ss += (v[i][0] * v[i][0] + v[i][1] * v[i][1]) + (v[i][2] * v[i][2] + v[i][3] * v[i][3]); }
            ss = wave_sum(ss);
            const float rstd = rsqrtf(ss * (1.0f / 1024.0f) + 1e-6f);
            bf16_t* hr = (bf16_t*)(ws + WS_H) + (size_t)row * 1024;
#pragma unroll
            for (int i = 0; i < 4; ++i) *(u32x2*)(hr + lane * 4 + 256 * i) = pack4(v[i] * rstd * gv[i]);
        }
    }
}

template <int ROWS, int COLS> struct TileRegs { u32x4 v[ROWS * (COLS / 8) / NTHR]; };
template <int ROWS, int COLS>
__device__ __forceinline__ void tile_load(TileRegs<ROWS, COLS>& t, const bf16_t* src, size_t gp, int tid) {
    constexpr int CPR = COLS / 8, IT = ROWS * CPR / NTHR;
#pragma unroll
    for (int i = 0; i < IT; ++i) { const int c = tid + i * NTHR, r = c / CPR, ch = c % CPR; t.v[i] = *(const u32x4*)(src + (size_t)r * gp + ch * 8); }
}
template <int ROWS, int COLS>
__device__ __forceinline__ void tile_store_b128(const TileRegs<ROWS, COLS>& t, LAS unsigned char* dst, int lp, int tid) {
    constexpr int CPR = COLS / 8, IT = ROWS * CPR / NTHR;
#pragma unroll
    for (int i = 0; i < IT; ++i) { const int c = tid + i * NTHR, r = c / CPR, ch = c % CPR; *(LAS u32x4*)(dst + r * lp + ch * 16) = t.v[i]; }
}
template <int ROWS, int COLS>
__device__ __forceinline__ void tile_store_b32(const TileRegs<ROWS, COLS>& t, LAS unsigned char* dst, int lp, int tid) {
    constexpr int CPR = COLS / 8, IT = ROWS * CPR / NTHR;
#pragma unroll
    for (int i = 0; i < IT; ++i) { const int c = tid + i * NTHR, r = c / CPR, ch = c % CPR; LAS unsigned* d = (LAS unsigned*)(dst + r * lp + ch * 16); d[0] = t.v[i].x; d[1] = t.v[i].y; d[2] = t.v[i].z; d[3] = t.v[i].w; }
}
__device__ __forceinline__ void gather8(const LAS unsigned char* base, int pitch, int r0, int col, unsigned short (&o)[8]) {
    const LAS unsigned char* p = base + r0 * pitch + col * 2;
#pragma unroll
    for (int j = 0; j < 8; ++j) o[j] = *(const LAS unsigned short*)(p + j * pitch);
}
__device__ __forceinline__ bf16x8 mk8(const unsigned short (&o)[8]) { bf16x8 r;
#pragma unroll
    for (int j = 0; j < 8; ++j) r[j] = (short)o[j];
    return r; }

__device__ __forceinline__ void p2_unit(LAS unsigned char* lds, const bf16_t* QK, const bf16_t* V, bf16_t* KV, int unit, int tid, int wid, int lane) {
    const int fr = lane & 15, fq = lane >> 4, h = unit & 3; const size_t tok0 = (size_t)(unit >> 2) * 128; const float lg = lgam(h);
    LAS unsigned char* sK = lds; LAS unsigned char* sV = lds + 33280;
    TileRegs<128, 128> tk; TileRegs<256, 128> tv;
    asm volatile("" : "+v"(tid));
    tile_load(tk, QK + tok0 * 1024 + 512 + h * 128, 1024, tid);
    tile_load(tv, V + (size_t)unit * 32768, 128, tid);
    __syncthreads();
    tile_store_b32(tk, sK, 260, tid);
    tile_store_b128(tv, sV, 272, tid);
    __syncthreads();
    f32x4 acc[2][8];
#pragma unroll
    for (int a = 0; a < 2; ++a)
#pragma unroll
        for (int b = 0; b < 8; ++b) acc[a][b] = (f32x4){0.f, 0.f, 0.f, 0.f};
#pragma unroll
    for (int ks = 0; ks < 4; ++ks) {
        const int j0 = 32 * ks + 8 * fq;
        bf16x8 vf[2];
#pragma unroll
        for (int e2 = 0; e2 < 2; ++e2) {
            const u32x4 vr = *(const LAS u32x4*)(sV + (16 * (2 * wid + e2) + fr) * 272 + j0 * 2);
            u32x4 w;
            w.x = cvt_pk_bf16(bf_lo(vr.x) * fexp(lg * (float)(127 - j0 - 0)), bf_hi(vr.x) * fexp(lg * (float)(127 - j0 - 1)));
            w.y = cvt_pk_bf16(bf_lo(vr.y) * fexp(lg * (float)(127 - j0 - 2)), bf_hi(vr.y) * fexp(lg * (float)(127 - j0 - 3)));
            w.z = cvt_pk_bf16(bf_lo(vr.z) * fexp(lg * (float)(127 - j0 - 4)), bf_hi(vr.z) * fexp(lg * (float)(127 - j0 - 5)));
            w.w = cvt_pk_bf16(bf_lo(vr.w) * fexp(lg * (float)(127 - j0 - 6)), bf_hi(vr.w) * fexp(lg * (float)(127 - j0 - 7)));
            vf[e2] = __builtin_bit_cast(bf16x8, w);
        }
#pragma unroll
        for (int db = 0; db < 8; ++db) {
            unsigned short o[8]; gather8(sK, 260, j0, 16 * db + fr, o);
            const bf16x8 kf = mk8(o);
#pragma unroll
            for (int e2 = 0; e2 < 2; ++e2) acc[e2][db] = __builtin_amdgcn_mfma_f32_16x16x32_bf16(kf, vf[e2], acc[e2][db], 0, 0, 0);
        }
    }
    bf16_t* dst = KV + (size_t)unit * 32768;
#pragma unroll
    for (int e2 = 0; e2 < 2; ++e2)
#pragma unroll
        for (int db = 0; db < 8; ++db) *(u32x2*)(dst + (16 * (2 * wid + e2) + fr) * 128 + 16 * db + 4 * fq) = pack4(acc[e2][db]);
}

__device__ __forceinline__ void p4_unit(LAS unsigned char* lds, const bf16_t* QK, const bf16_t* V, const bf16_t* PREV, const bf16_t* RG, bf16_t* RO, int unit, int tid, int wid, int lane) {
    const int fr = lane & 15, fq = lane >> 4, h = unit & 3; const size_t tok0 = (size_t)(unit >> 2) * 128; const float lg = lgam(h);
    LAS unsigned char* sK = lds; LAS unsigned char* sP = lds + 34816;
    TileRegs<128, 128> tk; TileRegs<256, 128> tp; TileRegs<256, 128> tv;
    asm volatile("" : "+v"(tid));
    tile_load(tk, QK + tok0 * 1024 + 512 + h * 128, 1024, tid);
    tile_load(tp, PREV + (size_t)unit * 32768, 128, tid);
    bf16x8 qf[4];
    { const bf16_t* qrow = QK + (tok0 + 16 * wid + fr) * 1024 + h * 128 + 8 * fq;
#pragma unroll
      for (int ks = 0; ks < 4; ++ks) qf[ks] = *(const bf16x8*)(qrow + 32 * ks); }
    __syncthreads();
    tile_store_b128(tk, sK, 272, tid);
    tile_store_b128(tp, sP, 272, tid);
    asm volatile("" : "+v"(tid));
    tile_load(tv, V + (size_t)unit * 32768, 128, tid);
    __syncthreads();
    f32x4 sacc[8];
#pragma unroll
    for (int jb = 0; jb < 8; ++jb) {
        sacc[jb] = (f32x4){0.f, 0.f, 0.f, 0.f};
        if (jb <= wid) {
#pragma unroll
            for (int ks = 0; ks < 4; ++ks) { const bf16x8 kf = *(const LAS bf16x8*)(sK + (16 * jb + fr) * 272 + (32 * ks + 8 * fq) * 2); sacc[jb] = __builtin_amdgcn_mfma_f32_16x16x32_bf16(kf, qf[ks], sacc[jb], 0, 0, 0); }
        }
    }
    f32x4 acc[16];
    const int i = 16 * wid + fr; const float xi = fexp(lg * (float)(i + 1));
#pragma unroll
    for (int eb = 0; eb < 16; ++eb) {
        f32x4 a = (f32x4){0.f, 0.f, 0.f, 0.f};
#pragma unroll
        for (int ks = 0; ks < 4; ++ks) { const bf16x8 pf = *(const LAS bf16x8*)(sP + (16 * eb + fr) * 272 + (32 * ks + 8 * fq) * 2); a = __builtin_amdgcn_mfma_f32_16x16x32_bf16(pf, qf[ks], a, 0, 0, 0); }
        acc[eb] = a * xi;
    }
    bf16x8 pfr[4];
#pragma unroll
    for (int ks = 0; ks < 4; ++ks) {
        float pv[8];
#pragma unroll
        for (int hf = 0; hf < 2; ++hf)
#pragma unroll
            for (int r = 0; r < 4; ++r) { const int jb = 2 * ks + hf, j = 16 * jb + 4 * fq + r; pv[4 * hf + r] = (j <= i) ? sacc[jb][r] * fexp(lg * (float)(i - j)) : 0.0f; }
        u32x4 w; w.x = cvt_pk_bf16(pv[0], pv[1]); w.y = cvt_pk_bf16(pv[2], pv[3]); w.z = cvt_pk_bf16(pv[4], pv[5]); w.w = cvt_pk_bf16(pv[6], pv[7]);
        pfr[ks] = __builtin_bit_cast(bf16x8, w);
    }
    __syncthreads();
    asm volatile("" : "+v"(tid));
    tile_store_b128(tv, lds, 272, tid);
    __syncthreads();
#pragma unroll
    for (int ks = 0; ks < 4; ++ks) {
        if (2 * ks <= wid) {
#pragma unroll
            for (int eb = 0; eb < 16; ++eb) {
                const LAS unsigned char* p = lds + (16 * eb + fr) * 272 + (32 * ks + 4 * fq) * 2;
                const u32x2 lo = *(const LAS u32x2*)p, hi = *(const LAS u32x2*)(p + 32);
                const u32x4 w = (u32x4){lo.x, lo.y, hi.x, hi.y};
                acc[eb] = __builtin_amdgcn_mfma_f32_16x16x32_bf16(__builtin_bit_cast(bf16x8, w), pfr[ks], acc[eb], 0, 0, 0);
            }
        }
    }
    float s = 0.f;
#pragma unroll
    for (int eb = 0; eb < 16; ++eb) s += (acc[eb][0] + acc[eb][1]) + (acc[eb][2] + acc[eb][3]);
    s += __shfl_xor(s, 16); s += __shfl_xor(s, 32);
    const float mu = s * (1.0f / 256.0f); float q = 0.f;
#pragma unroll
    for (int eb = 0; eb < 16; ++eb) { const f32x4 d = acc[eb] - mu; q += (d[0] * d[0] + d[1] * d[1]) + (d[2] * d[2] + d[3] * d[3]); }
    q += __shfl_xor(q, 16); q += __shfl_xor(q, 32);
    const float rstd = rsqrtf(q * (1.0f / 256.0f) + 1e-5f);
    const bf16_t* rgrow = RG + (tok0 + i) * 1024 + h * 256 + 4 * fq; bf16_t* rorow = RO + (tok0 + i) * 1024 + h * 256 + 4 * fq;
    u32x2 gl[16];
#pragma unroll
    for (int eb = 0; eb < 16; ++eb) gl[eb] = *(const u32x2*)(rgrow + 16 * eb);
#pragma unroll
    for (int eb = 0; eb < 16; ++eb) *(u32x2*)(rorow + 16 * eb) = pack4((acc[eb] - mu) * rstd * unpack4(gl[eb]));
}

__device__ __forceinline__ void p5_unit(LAS unsigned char* lds, const bf16_t* SV, const bf16_t* UG, bf16_t* UO, const bf16_t* WC, const float* bias, int chunk, int tid, int wid, int lane) {
    const int fr = lane & 15, fq = lane >> 4; const size_t tok0 = (size_t)chunk * 128;
    LAS unsigned char* sW = lds; LAS unsigned char* sV = lds + 34816; LAS float* st = (LAS float*)(lds + 34816 + 66048);
    __syncthreads();
    for (int r4 = 0; r4 < 16; r4 += 4) {
        u32x4 ra[4], rb[4];
#pragma unroll
        for (int k = 0; k < 4; ++k) { const bf16_t* row = SV + (tok0 + 16 * wid + r4 + k) * 1024; ra[k] = *(const u32x4*)(row + lane * 8); rb[k] = *(const u32x4*)(row + 512 + lane * 8); }
        float sv4[4], qv4[4];
#pragma unroll
        for (int k = 0; k < 4; ++k) {
            f32x4 a, b, c, d; unpack8(ra[k], a, b); unpack8(rb[k], c, d);
            sv4[k] = ((a[0] + a[1]) + (a[2] + a[3])) + ((b[0] + b[1]) + (b[2] + b[3])) + ((c[0] + c[1]) + (c[2] + c[3])) + ((d[0] + d[1]) + (d[2] + d[3]));
            qv4[k] = ((a[0] * a[0] + a[1] * a[1]) + (a[2] * a[2] + a[3] * a[3])) + ((b[0] * b[0] + b[1] * b[1]) + (b[2] * b[2] + b[3] * b[3]))
                   + ((c[0] * c[0] + c[1] * c[1]) + (c[2] * c[2] + c[3] * c[3])) + ((d[0] * d[0] + d[1] * d[1]) + (d[2] * d[2] + d[3] * d[3]));
        }
#pragma unroll
        for (int o = 32; o >= 1; o >>= 1) {
#pragma unroll
            for (int k = 0; k < 4; ++k) { sv4[k] += __shfl_xor(sv4[k], o); qv4[k] += __shfl_xor(qv4[k], o); }
        }
#pragma unroll
        for (int k = 0; k < 4; ++k) {
            const float mu = sv4[k] * (1.0f / 1024.0f), var = fmaxf(qv4[k] * (1.0f / 1024.0f) - mu * mu, 0.0f);
            if (lane == 0) { st[2 * (16 * wid + r4 + k)] = mu; st[2 * (16 * wid + r4 + k) + 1] = rsqrtf(var + 1e-5f); }
        }
    }
    TileRegs<128, 128> tw; TileRegs<128, 256> tv;
    { int tg = tid; asm volatile("" : "+v"(tg)); tile_load(tw, WC, 128, tg); tile_load(tv, SV + tok0 * 1024, 1024, tg); }
    for (int g = 0; g < 4; ++g) {
        __syncthreads();
        tile_store_b128(tw, sW, 272, tid);
#pragma unroll
        for (int i = 0; i < 8; ++i) {
            const int c = tid + i * NTHR, r = c >> 5, ch = c & 31;
            f32x4 a, b; unpack8(tv.v[i], a, b);
            const float mu = st[2 * r], rs = st[2 * r + 1];
            const u32x4 w = pack8((a - mu) * rs, (b - mu) * rs);
            LAS unsigned* d = (LAS unsigned*)(sV + r * 516 + ch * 16); d[0] = w.x; d[1] = w.y; d[2] = w.z; d[3] = w.w;
        }
        __syncthreads();
        int tg = tid; asm volatile("" : "+v"(tg));
        if (g < 3) { tile_load(tw, WC + (g + 1) * 16384, 128, tg); tile_load(tv, SV + tok0 * 1024 + (g + 1) * 256, 1024, tg); }
        u32x2 ul[8][2]; float bvl[8];
        {   const int lfr = tg & 15, lfq = (tg & 63) >> 4;
#pragma unroll
            for (int ib = 0; ib < 8; ++ib) { bvl[ib] = bias[g * 128 + 16 * ib + lfr];
#pragma unroll
                for (int c2 = 0; c2 < 2; ++c2) ul[ib][c2] = *(const u32x2*)(UO + (tok0 + 16 * ib + lfr) * 1024 + g * 256 + 16 * (2 * wid + c2) + 4 * lfq); } }
        f32x4 acc[8][2];
#pragma unroll
        for (int a = 0; a < 8; ++a)
#pragma unroll
            for (int b = 0; b < 2; ++b) acc[a][b] = (f32x4){0.f, 0.f, 0.f, 0.f};
#pragma unroll
        for (int ks = 0; ks < 4; ++ks) {
            bf16x8 vf[2];
#pragma unroll
            for (int c2 = 0; c2 < 2; ++c2) { unsigned short o[8]; gather8(sV, 516, 32 * ks + 8 * fq, 16 * (2 * wid + c2) + fr, o); vf[c2] = mk8(o); }
#pragma unroll
            for (int ib = 0; ib < 8; ++ib) {
                if (ib >= 2 * ks) {
                    const bf16x8 wf = *(const LAS bf16x8*)(sW + (16 * ib + fr) * 272 + (32 * ks + 8 * fq) * 2);
#pragma unroll
                    for (int c2 = 0; c2 < 2; ++c2) acc[ib][c2] = __builtin_amdgcn_mfma_f32_16x16x32_bf16(vf[c2], wf, acc[ib][c2], 0, 0, 0);
                }
            }
        }
#pragma unroll
        for (int ib = 0; ib < 8; ++ib)
#pragma unroll
            for (int c2 = 0; c2 < 2; ++c2)
                *(u32x2*)(UO + (tok0 + 16 * ib + fr) * 1024 + g * 256 + 16 * (2 * wid + c2) + 4 * fq) = pack4((acc[ib][c2] + bvl[ib]) * unpack4(ul[ib][c2]));
    }
}

#define XB_TMO      128
#define XB_XCNT(j)  (256  + 64 * (j))
#define XB_XSUB(j)  (1280 + 64 * (j))
#define XB_XGEN(j)  (2304 + 64 * (j))
#define XB_TOP      3328
#define XB_TOPGEN   3392
#define XCD_BAR_WORDS 3456
#define XB_SPIN_CAP (1u << 22)
__device__ __forceinline__ unsigned xb_ld(unsigned* p)              { return __hip_atomic_load(p, __ATOMIC_RELAXED, __HIP_MEMORY_SCOPE_AGENT); }
__device__ __forceinline__ unsigned xb_add(unsigned* p, unsigned v) { return __hip_atomic_fetch_add(p, v, __ATOMIC_RELAXED, __HIP_MEMORY_SCOPE_AGENT); }
__device__ __forceinline__ unsigned xb_xcc_id() { return (unsigned)__builtin_amdgcn_s_getreg((3 << 11) | 20) & 0xFu; }
#define XB_SPIN(cond, bar) do { unsigned _sp = 0; while (cond) { __builtin_amdgcn_s_sleep(1); \
    if ((++_sp & 255u) == 0u) { if (xb_ld(&(bar)[XB_TMO])) break; if (_sp > XB_SPIN_CAP) { atomicAdd(&(bar)[XB_TMO], 1u); break; } } } } while (0)
struct XcdBarrier { unsigned* bar; unsigned x; volatile LAS unsigned* st; };
__device__ __forceinline__ XcdBarrier xcd_barrier_post(unsigned* bar, volatile LAS unsigned* st) {
    XcdBarrier b; b.bar = bar; b.x = xb_xcc_id(); b.st = st;
    if (threadIdx.x == 0) (void)xb_add(&bar[XB_XCNT(b.x)], 1u);
    return b;
}
__device__ __forceinline__ void xcd_barrier_complete(unsigned* bar, unsigned x, unsigned& nloc, unsigned& nx) {
    const unsigned G = gridDim.x * gridDim.y * gridDim.z;
    unsigned sum, cnt, mine, sp = 0u;
    for (;;) {
        sum = 0u; cnt = 0u; mine = 0u;
#pragma nounroll
        for (unsigned j = 0; j < 16; ++j) { const unsigned c = xb_ld(&bar[XB_XCNT(j)]); sum += c; cnt += (c > 0u) ? 1u : 0u; mine = (j == x) ? c : mine; }
        if (sum == G) break;
        __builtin_amdgcn_s_sleep(1);
        if ((++sp & 255u) == 0u) { if (xb_ld(&bar[XB_TMO])) break; if (sp > XB_SPIN_CAP) { atomicAdd(&bar[XB_TMO], 1u); break; } }
    }
    nloc = mine > 0u ? mine : 1u; nx = cnt > 0u ? cnt : 1u;
}
__device__ __forceinline__ void xcd_barrier(const XcdBarrier& b) {
    asm volatile("s_waitcnt vmcnt(0)" ::: "memory");
    __syncthreads();
    if (threadIdx.x == 0) {
        unsigned* bar = b.bar;
        __builtin_amdgcn_s_waitcnt(0);
        unsigned nloc = b.st[0], nx = b.st[1];
        if (nloc == 0u) { xcd_barrier_complete(bar, b.x, nloc, nx); b.st[0] = nloc; b.st[1] = nx; }
        const unsigned old = xb_add(&bar[XB_XSUB(b.x)], 1u);
        const unsigned gen = old / nloc;
        if (old + 1u == (gen + 1u) * nloc) {
            __builtin_amdgcn_fence(__ATOMIC_RELEASE, "agent");
            asm volatile("s_waitcnt vmcnt(0)" ::: "memory");
            const unsigned og = xb_add(&bar[XB_TOP], 1u);
            const unsigned tg = og / nx;
            if (og + 1u == (tg + 1u) * nx) xb_add(&bar[XB_TOPGEN], 1u);
            else XB_SPIN(xb_ld(&bar[XB_TOPGEN]) == tg, bar);
            __builtin_amdgcn_fence(__ATOMIC_ACQUIRE, "agent");
            xb_add(&bar[XB_XGEN(b.x)], 1u);
            asm volatile("s_waitcnt vmcnt(0)" ::: "memory");
        } else {
            XB_SPIN(xb_ld(&bar[XB_XGEN(b.x)]) == gen, bar);
            __builtin_amdgcn_fence(__ATOMIC_ACQUIRE, "agent");
            asm volatile("s_waitcnt vmcnt(0)" ::: "memory");
        }
    }
    __syncthreads();
}

#if defined(EXPM) && (EXPM & 64)
#define GSYNC() do { xcd_barrier(xbar); xcd_barrier(xbar); } while (0)
#else
#define GSYNC() xcd_barrier(xbar)
#endif
#define FRESH_IDS int tid_ = threadIdx.x; asm volatile("" : "+v"(tid_)); const int tid = tid_, wid = __builtin_amdgcn_readfirstlane(tid >> 6), lane = tid & 63; (void)wid; (void)lane;
__global__ void __launch_bounds__(NTHR, 2) mega(Params P) {
    extern __shared__ __attribute__((aligned(16))) unsigned char lds_raw[];
    LAS unsigned char* lds = (LAS unsigned char*)lds_raw;
    cg::grid_group grid = cg::this_grid();
    const int G = gridDim.x, bx = blockIdx.x;
    unsigned char* ws = P.ws;
    bf16_t* const WIN = (bf16_t*)(ws + WS_WIN); bf16_t* const WR = (bf16_t*)(ws + WS_WR); bf16_t* const WSG = (bf16_t*)(ws + WS_WS); bf16_t* const WO = (bf16_t*)(ws + WS_WO);
    bf16_t* const WG = (bf16_t*)(ws + WS_WG); bf16_t* const WPP = (bf16_t*)(ws + WS_WPP); bf16_t* const WC = (bf16_t*)(ws + WS_WC);
    float* const RSQ1 = (float*)(ws + WS_SV); float* const RSQ2 = (float*)(ws + WS_SV + 8 * MiB);
    bf16_t* const H = (bf16_t*)(ws + WS_H); bf16_t* const PB = (bf16_t*)(ws + WS_PB);
    bf16_t* const QK = (bf16_t*)(ws + WS_QK); bf16_t* const V = (bf16_t*)(ws + WS_V); bf16_t* const SV = (bf16_t*)(ws + WS_SV);
    bf16_t* const RG2 = (bf16_t*)(ws + WS_RG2); bf16_t* const UG2 = (bf16_t*)(ws + WS_UG2); bf16_t* const MR2 = (bf16_t*)(ws + WS_MR2); bf16_t* const MS2 = (bf16_t*)(ws + WS_MS2);
    bf16_t* const PREV = (bf16_t*)P.out;
    bf16_t* const MERGED = H; bf16_t* const X1B = QK; bf16_t* const PP = (bf16_t*)(ws + WS_PP);
    volatile LAS unsigned* xst = (volatile LAS unsigned*)(lds + LDS_STAGE);
    if (threadIdx.x < 4) xst[threadIdx.x] = 0u;
    __syncthreads();
    const XcdBarrier xbar = xcd_barrier_post((unsigned*)(ws + WS_BAR), xst);

    { FRESH_IDS phase0(P, lds, tid, wid, lane); }
    if (P.ws == nullptr) grid.sync();

    for (int sl = 0; sl < NSL; ++sl) {
        const int tokb = sl * TS;
        bf16_t* const RG = RG2 + (size_t)tokb * 1024; bf16_t* const UG = UG2 + (size_t)tokb * 1024;
        GSYNC();
        {
            pg8::Src1V g{H + (size_t)tokb * 1024, WIN, 1024}; pg8::StaticOrder S; S.init(TS, 8192, G, bx);
            Epi1 E{QK, UG, (const float*)(ws + WS_COS), (const float*)(ws + WS_SIN), sl};
            pg8::gemm_phase(lds, g, 1024, S, E);
        }
        GSYNC();
        { FRESH_IDS for (int u = bx; u < BSL * 32 * 4; u += G) p2_unit(lds, QK, V, PREV, u, tid, wid, lane); }
        { FRESH_IDS for (int c = bx; c < BSL * 32; c += G) p5_unit(lds, SV, UG, UG, WC, P.sbs, c, tid, wid, lane); }
        GSYNC();
        { FRESH_IDS
        for (int it = bx * NTHR + tid; it < BSL * 4 * 256 * 32; it += G * NTHR) {
            const int d4 = it & 31, e = (it >> 5) & 255, h = (it >> 13) & 3, bl = it >> 15;
            const float cd = fexp(128.0f * lgam(h));
            f32x4 run = (f32x4){0.f, 0.f, 0.f, 0.f};
            const size_t base = ((size_t)(bl * 32) * 4 + h) * 32768 + e * 128 + d4 * 4;
#pragma unroll 8
            for (int n = 0; n < 32; ++n) {
                const size_t o = base + (size_t)n * 4 * 32768;
                const f32x4 kv = unpack4(*(const u32x2*)(PREV + o));
                *(u32x2*)(PREV + o) = pack4(run);
                run = kv + run * cd;
            }
        } }
        GSYNC();
        { FRESH_IDS for (int u = bx; u < BSL * 32 * 4; u += G) p4_unit(lds, QK, V, PREV, RG, RG, u, tid, wid, lane); }
    }
    GSYNC();
    {
        pg8::Src2 g{RG2, WR, (long)((const char*)UG2 - (const char*)RG2), (long)((const char*)WSG - (const char*)WR), 1024}; pg8::DualOrder S; S.init(T_ALL, 1024, G, bx);
        Epi6 E{MR2, MS2, MERGED};
        pg8::gemm_phase(lds, g, 1024, S, E);
    }
    GSYNC();
    {
        pg8::Src1 g{MERGED, WO, 1024}; pg8::StaticOrder S; S.init(T_ALL, 1024, G, bx);
        Epi7 E{P.x, X1B, RSQ1, 0};
        pg8::gemm_phase(lds, g, 1024, S, E);
        pg8::Src1 g2{PB, WPP, 256};
        EpiStore E2{PP};
        pg8::gemm_phase(lds, g2, 256, S, E2);
    }
    GSYNC();
    {
        pg8::Src1 g{X1B, WG, 1024}; pg8::StaticOrder S; S.init(T_ALL, 1024, G, bx);
        Epi8 E{X1B, MERGED, PP, RSQ1, RSQ2, 0};
        pg8::gemm_phase(lds, g, 1024, S, E);
    }
    GSYNC();
    {
        FRESH_IDS
        f32x4 gv[4];
#pragma unroll
        for (int i = 0; i < 2; ++i) { gv[2 * i] = *(const f32x4*)(P.gf + lane * 8 + 512 * i); gv[2 * i + 1] = *(const f32x4*)(P.gf + lane * 8 + 512 * i + 4); }
        for (int row = bx * 8 + wid; row < T_ALL; row += G * 8) {
            float sq = RSQ2[(size_t)row * 16 + (lane & 15)]; sq += __shfl_xor(sq, 1); sq += __shfl_xor(sq, 2); sq += __shfl_xor(sq, 4); sq += __shfl_xor(sq, 8);
            const float rstd = rsqrtf(sq * (1.0f / 1024.0f) + 1e-6f); float* o = P.out + (size_t)row * 1024; const bf16_t* xr = MERGED + (size_t)row * 1024;
#pragma unroll
            for (int i = 0; i < 2; ++i) { f32x4 a, b; unpack8(*(const u32x4*)(xr + lane * 8 + 512 * i), a, b);
                *(f32x4*)(o + lane * 8 + 512 * i) = a * rstd * gv[2 * i]; *(f32x4*)(o + lane * 8 + 512 * i + 4) = b * rstd * gv[2 * i + 1]; }
        }
    }
}

extern "C" void kernel_launch(void* const* d_in, const int* in_sizes, int n_in, void* d_out, int out_size, void* d_ws, size_t ws_size, hipStream_t stream) {
    static int grid_blocks = 0;
    if (grid_blocks == 0) {
        int dev = 0, cus = 0, per_cu = 0;
        hipGetDevice(&dev);
        hipDeviceGetAttribute(&cus, hipDeviceAttributeMultiprocessorCount, dev);
        if (hipFuncSetAttribute((const void*)mega, hipFuncAttributeMaxDynamicSharedMemorySize, LDS_BYTES) != hipSuccess) fprintf(stderr, "hipFuncSetAttribute failed\n");
        if (hipOccupancyMaxActiveBlocksPerMultiprocessor(&per_cu, (const void*)mega, NTHR, LDS_BYTES) != hipSuccess || per_cu < 1) { per_cu = 1; (void)hipGetLastError(); }
        grid_blocks = cus * (per_cu > 1 ? 1 : per_cu);
        if (ws_size < WS_END) fprintf(stderr, "workspace too small: %zu < %zu\n", ws_size, (size_t)WS_END);
    }
    Params p{};
    p.x = (const float*)d_in[0]; p.p = (const float*)d_in[1]; p.w_in = (const float*)d_in[2]; p.w_ret = (const float*)d_in[3]; p.w_sgu = (const float*)d_in[4];
    p.w_out = (const float*)d_in[5]; p.sws = (const float*)d_in[6]; p.sbs = (const float*)d_in[7]; p.wpg = (const float*)d_in[8]; p.wpp = (const float*)d_in[9];
    p.gm = (const float*)d_in[10]; p.gp = (const float*)d_in[11]; p.gf = (const float*)d_in[12];
    p.out = (float*)d_out; p.ws = (unsigned char*)d_ws;
    (void)hipMemsetAsync((char*)d_ws + WS_BAR, 0, XCD_BAR_WORDS * 4, stream);
    void* args[] = {&p};
    hipError_t e = hipLaunchCooperativeKernel((const void*)mega, dim3(grid_blocks), dim3(NTHR), args, LDS_BYTES, stream);
    if (e != hipSuccess) fprintf(stderr, "cooperative launch failed: %s (grid %d)\n", hipGetErrorString(e), grid_blocks);
}
```

```cpp
#include <hip/hip_runtime.h>
#include <hip/hip_cooperative_groups.h>
#include <cstdio>
namespace cg = cooperative_groups;

#define LAS __attribute__((address_space(3)))
typedef unsigned short bf16_t;
typedef short bf16x8 __attribute__((ext_vector_type(8)));
typedef float f32x4 __attribute__((ext_vector_type(4)));
typedef float f32x2 __attribute__((ext_vector_type(2)));
typedef unsigned u32x4 __attribute__((ext_vector_type(4)));
typedef unsigned u32x2 __attribute__((ext_vector_type(2)));

constexpr int T_ALL = 65536, DM = 1024, NSL = 2, TS = T_ALL / NSL, BSL = 16 / NSL;
constexpr int NTHR = 512;
constexpr int LDS_STAGE = 131072, LDS_BYTES = LDS_STAGE + 16;
constexpr size_t MiB = 1ull << 20;
constexpr size_t UB = (size_t)TS * 1024 * 2;
constexpr size_t WS_WIN = 0, WS_WR = 16 * MiB, WS_WS = 18 * MiB, WS_WO = 20 * MiB, WS_WG = 22 * MiB, WS_WPP = 24 * MiB, WS_WC = 24 * MiB + 512 * 1024,
                 WS_COS = 25 * MiB, WS_SIN = 26 * MiB, WS_RSQ1 = 27 * MiB, WS_RSQ2 = 27 * MiB + 256 * 1024, WS_BAR = 28 * MiB,
                 WS_H = 32 * MiB, WS_PB = 160 * MiB, WS_SL = 192 * MiB;
constexpr size_t WS_QK = WS_SL, WS_V = WS_SL + UB, WS_SV = WS_SL + 2 * UB, WS_RG2 = WS_SL + 3 * UB, WS_UG2 = WS_SL + 5 * UB, WS_MR2 = WS_SL + 7 * UB, WS_MS2 = WS_SL + 9 * UB,
                 WS_PP = WS_SL + 11 * UB, WS_END = WS_SL + 13 * UB;
static_assert(WS_END == 1024 * MiB, "workspace map");

__device__ __forceinline__ unsigned cvt_pk_bf16(float lo, float hi) { unsigned r; asm volatile("v_cvt_pk_bf16_f32 %0, %1, %2" : "=v"(r) : "v"(lo), "v"(hi)); return r; }
__device__ __forceinline__ float bf_lo(unsigned w) { return __uint_as_float(w << 16); }
__device__ __forceinline__ float bf_hi(unsigned w) { return __uint_as_float(w & 0xffff0000u); }
__device__ __forceinline__ float bf2f(unsigned short b) { return __uint_as_float(((unsigned)b) << 16); }
__device__ __forceinline__ float wave_sum(float v) {
#pragma unroll
    for (int o = 32; o >= 1; o >>= 1) v += __shfl_xor(v, o);
    return v;
}
__device__ __forceinline__ float sigmoidf_(float x) { return __builtin_amdgcn_rcpf(1.0f + __builtin_amdgcn_exp2f(-1.4426950408889634f * x)); }
__device__ __forceinline__ float fexp(float x) { return __builtin_amdgcn_exp2f(1.4426950408889634f * x); }
__device__ __forceinline__ f32x2 gelu_pk(f32x2 v) {
    const f32x2 av = __builtin_elementwise_abs(v), d = av * 0.2316418882f + 1.0f;
    f32x2 t; t.x = __builtin_amdgcn_rcpf(d.x); t.y = __builtin_amdgcn_rcpf(d.y);
    f32x2 q = t * 0.5307027145f + (-0.7265760135f); q = q * t + 0.7107068705f; q = q * t + (-0.142248368f); q = q * t + 0.127414796f; q = q * t;
    const f32x2 s = (v * v) * (-0.72134752044f);
    f32x2 e; e.x = __builtin_amdgcn_exp2f(s.x); e.y = __builtin_amdgcn_exp2f(s.y);
    const f32x2 m = v * (q * e), r = v - m;
    f32x2 o; o.x = v.x < 0.f ? m.x : r.x; o.y = v.y < 0.f ? m.y : r.y; return o;
}
__device__ __forceinline__ f32x4 gelu4(f32x4 v) { f32x2 a = gelu_pk((f32x2){v[0], v[1]}), b = gelu_pk((f32x2){v[2], v[3]}); return (f32x4){a.x, a.y, b.x, b.y}; }
__device__ __forceinline__ f32x4 sig4(f32x4 v) { return (f32x4){sigmoidf_(v[0]), sigmoidf_(v[1]), sigmoidf_(v[2]), sigmoidf_(v[3])}; }
__device__ __forceinline__ float lgam(int h) { return h == 0 ? -0.03174869831458027f : h == 1 ? -0.01574835696813892f : h == 2 ? -0.007843177461025892f : -0.003913899321136329f; }

namespace pg8 {
constexpr int BM = 256, BK = 64, HALF = 128, HTB = HALF * BK * 2, STAGE_BYTES = 8 * HTB, NXCD = 8, WGM = 8;
__host__ __device__ __forceinline__ int lds_byte(int r, int c) { const int st = (r >> 4) * 2 + (c >> 5), rr = r & 15, cc = c & 31, ob = rr * 64 + cc * 2; return st * 1024 + (ob ^ (((ob >> 9) & 1) << 5)); }
__host__ __device__ __forceinline__ void stage_rc(int b, int& R, int& C) { const int st = b / 1024, sb = b % 1024, swz = sb ^ (((sb >> 9) & 1) << 5); R = (st >> 1) * 16 + swz / 64; C = (st & 1) * 32 + (swz % 64) / 2; }
__host__ __device__ __forceinline__ int perm32(int rho) { const int n = rho >> 4, i = rho & 15; return 8 * (i >> 2) + 4 * n + (i & 3); }

struct Unit { int pm, pn, part; };
struct StaticOrder {
    int nM, nN, nwg, G, c;
    __device__ void init(int M, int N, int G_, int c_) { nM = M / BM; nN = N / BM; nwg = nM * nN; G = G_; c = c_; }
    __device__ bool next(int i, Unit& u) const {
        const long L = (long)i * G + c; if (L >= nwg) return false;
        int wgid = (int)L; { const int q = nwg / NXCD, r = nwg % NXCD, xcd = wgid % NXCD, off = wgid / NXCD; wgid = (xcd < r ? xcd * (q + 1) : r * (q + 1) + (xcd - r) * q) + off; }
        const int nig = WGM * nN, gid = wgid / nig, fm = gid * WGM, gsz = (nM - fm) < WGM ? (nM - fm) : WGM;
        u.pm = fm + ((wgid % nig) % gsz); u.pn = (wgid % nig) / gsz; u.part = 0; return true;
    }
};
struct DualOrder : StaticOrder {
    __device__ bool next(int i, Unit& u) const { if (!StaticOrder::next(i >> 1, u)) return false; u.part = i & 1; return true; }
};
struct Src1 { const bf16_t* A; const bf16_t* Bt; int K;
    __device__ __forceinline__ const char* a(const Unit& u) const { return (const char*)A + (size_t)u.pm * BM * K * 2; }
    __device__ __forceinline__ const char* b(const Unit& u) const { return (const char*)Bt + (size_t)u.pn * BM * K * 2; } };
struct Src1V { const bf16_t* A; const bf16_t* Bt; int K;
    __device__ __forceinline__ const char* a(const Unit& u) const { const char* pa = (const char*)A + (size_t)u.pm * BM * K * 2; const char* pb = (const char*)Bt + (size_t)u.pn * BM * K * 2; const long sw = (u.pn >= 4 && u.pn < 8) ? 1 : 0; return pa + sw * (long)(pb - pa); }
    __device__ __forceinline__ const char* b(const Unit& u) const { const char* pa = (const char*)A + (size_t)u.pm * BM * K * 2; const char* pb = (const char*)Bt + (size_t)u.pn * BM * K * 2; const long sw = (u.pn >= 4 && u.pn < 8) ? 1 : 0; return pb - sw * (long)(pb - pa); } };
struct Src2 { const bf16_t* A0; const bf16_t* B0; long dA, dB; int K;
    __device__ __forceinline__ const char* a(const Unit& u) const { return (const char*)A0 + (long)u.part * dA + (size_t)u.pm * BM * K * 2; }
    __device__ __forceinline__ const char* b(const Unit& u) const { return (const char*)B0 + (long)u.part * dB + (size_t)u.pn * BM * K * 2; } };

template <class Epi, class Sched, class Src>
__device__ __forceinline__ void gemm_phase(LAS unsigned char* lds, const Src& g, const int K, const Sched& S, const Epi& E) {
    int tid_ = threadIdx.x; asm volatile("" : "+v"(tid_));
    const int tid = tid_, wid = __builtin_amdgcn_readfirstlane(tid >> 6), lane = tid & 63, wr = wid >> 2, wc = wid & 3, fr = lane & 15, fq = lane >> 4;
    const int nt = K / BK;
    unsigned voffA[2], voffB[2];
#pragma unroll
    for (int i = 0; i < 2; ++i) { int R, C; stage_rc(tid * 16 + i * 8192, R, C); const int Rb = Epi::PERM ? ((R & ~31) + perm32(R & 31)) : R;
        voffA[i] = (unsigned)(R * K + C) * 2u; voffB[i] = (unsigned)(Rb * K + C) * 2u; }
    const size_t kstep = (size_t)(BK * 2);
    const size_t hstep = (size_t)HALF * K * 2;
    const unsigned ldsw = (unsigned)wid * 1024u;
    const int aoff = lds_byte(wr * 64 + fr, fq * 8), boff = lds_byte(wc * 32 + fr, fq * 8);
#define PG8_SA(b, h) (((b) * 2 + (h)) * HTB)
#define PG8_SB(b, h) ((4 + (b) * 2 + (h)) * HTB)
#define PG8_STAGE(bufoff, gbase, voff) do { _Pragma("unroll") for (int _i = 0; _i < 2; ++_i) \
        __builtin_amdgcn_global_load_lds((const unsigned*)((const char*)(gbase) + (voff)[_i]), (LAS unsigned*)(lds + (bufoff) + ldsw + _i * 8192), 16, 0, 0); } while (0)
#define PG8_LDA(dst, b, h) do { _Pragma("unroll") for (int m = 0; m < 4; ++m) _Pragma("unroll") for (int k = 0; k < 2; ++k) dst[m][k] = *(const LAS bf16x8*)(lds + PG8_SA(b, h) + aoff + m * 2048 + k * 1024); } while (0)
#define PG8_LDB(dst, b, h) do { _Pragma("unroll") for (int n = 0; n < 2; ++n) _Pragma("unroll") for (int k = 0; k < 2; ++k) dst[n][k] = *(const LAS bf16x8*)(lds + PG8_SB(b, h) + boff + n * 2048 + k * 1024); } while (0)
#define PG8_MMA(ai, bj, At, Bt) do { __builtin_amdgcn_s_setprio(1); _Pragma("unroll") for (int m = 0; m < 4; ++m) _Pragma("unroll") for (int n = 0; n < 2; ++n) _Pragma("unroll") for (int k = 0; k < 2; ++k) \
        acc[ai][bj][m][n] = __builtin_amdgcn_mfma_f32_16x16x32_bf16(Bt[n][k], At[m][k], acc[ai][bj][m][n], 0, 0, 0); __builtin_amdgcn_s_setprio(0); } while (0)
#define PG8_WAIT_V(n) asm volatile("s_waitcnt vmcnt(" #n ")" ::: "memory")
#define PG8_WAIT_L(n) asm volatile("s_waitcnt lgkmcnt(" #n ")" ::: "memory")
#define PG8_BAR __builtin_amdgcn_s_barrier()
#define PG8_SCHED __builtin_amdgcn_sched_barrier(0)
    Unit cur, nxt; int ui = 0;
    if (!S.next(0, cur)) return;
    f32x4 acc[2][2][4][2];
#pragma unroll
    for (int a = 0; a < 2; ++a)
#pragma unroll
        for (int b = 0; b < 2; ++b)
#pragma unroll
            for (int m = 0; m < 4; ++m)
#pragma unroll
                for (int n = 0; n < 2; ++n) acc[a][b][m][n] = (f32x4){0.f, 0.f, 0.f, 0.f};
    bf16x8 At[4][2], B0[2][2], B1[2][2];
    const char* cA = g.a(cur); const char* cB = g.b(cur);
    PG8_STAGE(PG8_SB(0, 0), cB, voffB); PG8_STAGE(PG8_SA(0, 0), cA, voffA); PG8_STAGE(PG8_SB(0, 1), cB + hstep, voffB); PG8_STAGE(PG8_SA(0, 1), cA + hstep, voffA);
    if (wr == 1) PG8_BAR;
    PG8_WAIT_V(4); PG8_BAR;
    PG8_STAGE(PG8_SB(1, 0), cB + kstep, voffB); PG8_STAGE(PG8_SA(1, 0), cA + kstep, voffA); PG8_STAGE(PG8_SB(1, 1), cB + hstep + kstep, voffB);
    PG8_WAIT_V(6); PG8_BAR;
    for (;;) {
        const bool has_next = S.next(ui + 1, nxt);
        const char* nA = has_next ? g.a(nxt) : cA; const char* nB = has_next ? g.b(nxt) : cB;
        for (int t = 0; t < nt; t += 2) {
            const bool last = (t == nt - 2);
            const char* a1 = cA + (size_t)(t + 1) * kstep;
            const char* a2 = last ? nA : cA + (size_t)(t + 2) * kstep; const char* b2 = last ? nB : cB + (size_t)(t + 2) * kstep;
            const char* a3 = a2 + kstep; const char* b3 = b2 + kstep;
            PG8_LDB(B0, 0, 0); PG8_SCHED; PG8_LDA(At, 0, 0); PG8_STAGE(PG8_SA(1, 1), a1 + hstep, voffA);
            PG8_WAIT_L(8); PG8_BAR; PG8_WAIT_L(0); PG8_MMA(0, 0, At, B0); PG8_BAR; PG8_SCHED;
            PG8_LDB(B1, 0, 1); PG8_STAGE(PG8_SB(0, 0), b2, voffB);
            PG8_BAR; PG8_WAIT_L(0); PG8_MMA(0, 1, At, B1); PG8_BAR;
            PG8_LDA(At, 0, 1); PG8_STAGE(PG8_SA(0, 0), a2, voffA);
            PG8_BAR; PG8_WAIT_L(0); PG8_MMA(1, 0, At, B0); PG8_BAR; PG8_SCHED;
            PG8_STAGE(PG8_SB(0, 1), b2 + hstep, voffB);
            PG8_WAIT_V(6); PG8_BAR; PG8_MMA(1, 1, At, B1); PG8_BAR;
            PG8_LDB(B0, 1, 0); PG8_SCHED; PG8_LDA(At, 1, 0); PG8_STAGE(PG8_SA(0, 1), a2 + hstep, voffA);
            PG8_WAIT_L(8); PG8_BAR; PG8_WAIT_L(0); PG8_MMA(0, 0, At, B0); PG8_BAR; PG8_SCHED;
            PG8_LDB(B1, 1, 1); PG8_STAGE(PG8_SB(1, 0), b3, voffB);
            PG8_BAR; PG8_WAIT_L(0); PG8_MMA(0, 1, At, B1); PG8_BAR;
            PG8_LDA(At, 1, 1); PG8_STAGE(PG8_SA(1, 0), a3, voffA);
            PG8_BAR; PG8_WAIT_L(0); PG8_MMA(1, 0, At, B0); PG8_BAR; PG8_SCHED;
            PG8_STAGE(PG8_SB(1, 1), b3 + hstep, voffB);
            PG8_WAIT_V(6); PG8_BAR; PG8_MMA(1, 1, At, B1); PG8_BAR;
        }
        {
            int epm = cur.pm, epn = cur.pn, efr = fr, efq = fq; asm volatile("" : "+s"(epm), "+s"(epn), "+v"(efr), "+v"(efq));
            const Unit eu{epm, epn, cur.part};
            E(acc, eu, wr, wc, efr, efq);
        }
        if (!has_next) break;
        if (!E.keep(cur)) {
#pragma unroll
            for (int a = 0; a < 2; ++a)
#pragma unroll
                for (int b = 0; b < 2; ++b)
#pragma unroll
                    for (int m = 0; m < 4; ++m)
#pragma unroll
                        for (int n = 0; n < 2; ++n) acc[a][b][m][n] = (f32x4){0.f, 0.f, 0.f, 0.f};
        }
        cur = nxt; cA = nA; cB = nB; ++ui;
    }
    PG8_WAIT_V(0);
    if (wr == 0) PG8_BAR;
    PG8_BAR;
#undef PG8_SA
#undef PG8_SB
#undef PG8_STAGE
#undef PG8_LDA
#undef PG8_LDB
#undef PG8_MMA
#undef PG8_WAIT_V
#undef PG8_WAIT_L
#undef PG8_BAR
#undef PG8_SCHED
}
}
using pg8::Unit;
typedef f32x4 AccT[2][2][4][2];

__device__ __forceinline__ u32x4 pack8(f32x4 a, f32x4 b) { u32x4 w; w.x = cvt_pk_bf16(a[0], a[1]); w.y = cvt_pk_bf16(a[2], a[3]); w.z = cvt_pk_bf16(b[0], b[1]); w.w = cvt_pk_bf16(b[2], b[3]); return w; }
__device__ __forceinline__ u32x2 pack4(f32x4 a) { u32x2 w; w.x = cvt_pk_bf16(a[0], a[1]); w.y = cvt_pk_bf16(a[2], a[3]); return w; }
__device__ __forceinline__ void unpack8(u32x4 w, f32x4& a, f32x4& b) { a = (f32x4){bf_lo(w.x), bf_hi(w.x), bf_lo(w.y), bf_hi(w.y)}; b = (f32x4){bf_lo(w.z), bf_hi(w.z), bf_lo(w.w), bf_hi(w.w)}; }
__device__ __forceinline__ f32x4 unpack4(u32x2 w) { return (f32x4){bf_lo(w.x), bf_hi(w.x), bf_lo(w.y), bf_hi(w.y)}; }

struct Epi1 {
    static constexpr bool PERM = true;
    bf16_t *QK, *UG; const float* cs; const float* sn; int sl; float* svs;
    __device__ __forceinline__ bool keep(const Unit&) const { return false; }
    __device__ __forceinline__ void operator()(AccT& acc, const Unit& u, int wr, int wc, int fr, int fq) const {
        const int pn = u.pn, cl = wc * 32 + 8 * fq, row0 = u.pm * 256 + wr * 64 + fr;
        if (pn < 4) {
            const int isk = pn >> 1, t = pn & 1, head = 2 * t + (cl >> 6), dim0 = cl & 63;
            const float sc = isk ? 1.0f : 0.08838834764831845f;
            bf16_t* base = QK + isk * 512 + head * 128 + dim0;
            f32x4 tb[2][2][4];
#define ROT_LD(b, buf) do { _Pragma("unroll") for (int mm = 0; mm < 2; ++mm) { const int pos_ = (row0 + ((b) >> 1) * 128 + (((b) & 1) * 2 + mm) * 16) & 4095; \
                tb[buf][mm][0] = *(const f32x4*)(cs + pos_ * 64 + dim0); tb[buf][mm][1] = *(const f32x4*)(cs + pos_ * 64 + dim0 + 4); \
                tb[buf][mm][2] = *(const f32x4*)(sn + pos_ * 64 + dim0); tb[buf][mm][3] = *(const f32x4*)(sn + pos_ * 64 + dim0 + 4); } } while (0)
            ROT_LD(0, 0);
#pragma unroll
            for (int b = 0; b < 4; ++b) {
                if (b + 1 < 4) ROT_LD(b + 1, (b + 1) & 1);
#pragma unroll
                for (int mm = 0; mm < 2; ++mm) {
                    const int ai = b >> 1, m = (b & 1) * 2 + mm, row = row0 + ai * 128 + m * 16;
                    const f32x4 c0 = tb[b & 1][mm][0], c1 = tb[b & 1][mm][1], s0 = tb[b & 1][mm][2], s1 = tb[b & 1][mm][3];
                    const f32x4 x1a = acc[ai][0][m][0], x1b = acc[ai][0][m][1], x2a = acc[ai][1][m][0], x2b = acc[ai][1][m][1];
                    const f32x4 o1a = (x1a * c0 - x2a * s0) * sc, o1b = (x1b * c1 - x2b * s1) * sc, o2a = (x2a * c0 + x1a * s0) * sc, o2b = (x2b * c1 + x1b * s1) * sc;
                    *(u32x4*)(base + (size_t)row * 1024) = pack8(o1a, o1b);
                    *(u32x4*)(base + (size_t)row * 1024 + 64) = pack8(o2a, o2b);
                }
            }
#undef ROT_LD
        } else if (pn >= 12 && pn < 20) {
            bf16_t* base = UG + 128 * (pn - 12) + cl;
#pragma unroll
            for (int ai = 0; ai < 2; ++ai)
#pragma unroll
                for (int m = 0; m < 4; ++m) {
                    const int row = row0 + ai * 128 + m * 16;
                    const f32x4 ua = gelu4(acc[ai][0][m][0]), ub = gelu4(acc[ai][0][m][1]);
                    const f32x4 ga = acc[ai][1][m][0], gb = acc[ai][1][m][1];
                    *(u32x4*)(base + (size_t)row * 1024) = pack8(ua * ga * sig4(ga), ub * gb * sig4(gb));
                }
        } else if (pn >= 24) {
            bf16_t* rbase = QK + (size_t)(3 + 2 * NSL + sl) * ((size_t)TS * 1024) + 128 * (pn - 24) + cl;
            bf16_t* sbase = QK + (size_t)(3 + 3 * NSL + sl) * ((size_t)TS * 1024) + 128 * (pn - 24) + cl;
#pragma unroll
            for (int ai = 0; ai < 2; ++ai)
#pragma unroll
                for (int m = 0; m < 4; ++m) {
                    const int row = row0 + ai * 128 + m * 16;
                    f32x4 r[2], sg[2];
#pragma unroll
                    for (int n = 0; n < 2; ++n) {
                        const f32x4 b = acc[ai][1][m][n];
                        const f32x4 one = (f32x4){1.0f + __builtin_amdgcn_exp2f(-1.4426950408889634f * b[0]), 1.0f + __builtin_amdgcn_exp2f(-1.4426950408889634f * b[1]),
                                                  1.0f + __builtin_amdgcn_exp2f(-1.4426950408889634f * b[2]), 1.0f + __builtin_amdgcn_exp2f(-1.4426950408889634f * b[3])};
                        sg[n] = (f32x4){__builtin_amdgcn_rcpf(one[0]), __builtin_amdgcn_rcpf(one[1]), __builtin_amdgcn_rcpf(one[2]), __builtin_amdgcn_rcpf(one[3])};
                        r[n] = sig4(acc[ai][0][m][n]) * one;
                    }
                    *(u32x4*)(rbase + (size_t)row * 1024) = pack8(r[0], r[1]);
                    *(u32x4*)(sbase + (size_t)row * 1024) = pack8(sg[0], sg[1]);
                    asm volatile("" ::: "memory");
                }
        } else if (pn < 8) {
            bf16_t* vt = QK + (size_t)TS * 1024;
#pragma unroll
            for (int ai = 0; ai < 2; ++ai)
#pragma unroll
                for (int m = 0; m < 4; ++m) {
                    const int e = ai * 128 + wr * 64 + m * 16 + fr;
#pragma unroll
                    for (int bj = 0; bj < 2; ++bj)
                        *(u32x4*)(vt + (((size_t)(u.pm * 2 + bj) * 4 + (pn - 4)) * 256 + e) * 128 + cl) = pack8(acc[ai][bj][m][0], acc[ai][bj][m][1]);
                }
        } else {
            const int act = pn < 8 ? 0 : pn < 12 ? 1 : pn < 24 ? 2 : 3;
            const int bidx = pn < 8 ? 1 : pn < 12 ? 3 + sl : pn < 24 ? 2 : pn < 28 ? 7 + sl : 9 + sl;
            const int tl = pn < 8 ? pn - 4 : pn < 12 ? pn - 8 : pn < 24 ? pn - 20 : pn < 28 ? pn - 24 : pn - 28;
            bf16_t* base = QK + (size_t)bidx * ((size_t)TS * 1024) + tl * 256 + cl;
#pragma unroll
            for (int ai = 0; ai < 2; ++ai)
#pragma unroll
                for (int m = 0; m < 4; ++m) {
                    const int row = row0 + ai * 128 + m * 16; float ssum = 0.f, ssq = 0.f;
#pragma unroll
                    for (int bj = 0; bj < 2; ++bj) {
                        f32x4 a = acc[ai][bj][m][0], b = acc[ai][bj][m][1];
                        if (act == 1) { a = a * sig4(a); b = b * sig4(b); }
                        else if (act == 2) { a = gelu4(a); b = gelu4(b);
                            ssum += ((a[0] + a[1]) + (a[2] + a[3])) + ((b[0] + b[1]) + (b[2] + b[3]));
                            ssq += ((a[0] * a[0] + a[1] * a[1]) + (a[2] * a[2] + a[3] * a[3])) + ((b[0] * b[0] + b[1] * b[1]) + (b[2] * b[2] + b[3] * b[3])); }
                        else if (act == 3) { a = sig4(a); b = sig4(b); }
                        *(u32x4*)(base + (size_t)row * 1024 + bj * 128) = pack8(a, b);
                    }
                    if (act == 2) {
                        ssum += __shfl_xor(ssum, 16); ssum += __shfl_xor(ssum, 32); ssq += __shfl_xor(ssq, 16); ssq += __shfl_xor(ssq, 32);
                        if (fq == 0) *(f32x2*)(svs + (size_t)row * 32 + tl * 8 + wc * 2) = (f32x2){ssum, ssq};
                    }
                }
        }
    }
};
struct Epi6 {
    static constexpr bool PERM = true;
    const bf16_t* MR; const bf16_t* MS; bf16_t* O;
    __device__ __forceinline__ bool keep(const Unit& u) const { return u.part == 0; }
    __device__ __forceinline__ void operator()(AccT& acc, const Unit& u, int wr, int wc, int fr, int fq) const {
        const int row0 = u.pm * 256 + wr * 64 + fr, col0 = u.pn * 256 + wc * 32 + 8 * fq;
        u32x4 sb[4][2];
#define E6_LD(g) do { _Pragma("unroll") for (int bj = 0; bj < 2; ++bj) { const size_t off_ = (size_t)(row0 + ((g) >> 2) * 128 + ((g) & 3) * 16) * 1024 + col0 + bj * 128; \
            if (u.part == 0) sb[(g) & 3][bj] = *(const u32x4*)(MR + off_); else sb[(g) & 3][bj] = *(const u32x4*)(MS + off_); } } while (0)
        E6_LD(0); E6_LD(1); E6_LD(2);
#pragma unroll
        for (int g = 0; g < 8; ++g) {
            if (g + 3 < 8) E6_LD(g + 3);
            const int ai = g >> 2, m = g & 3;
#pragma unroll
            for (int bj = 0; bj < 2; ++bj) {
                const size_t off = (size_t)(row0 + ai * 128 + m * 16) * 1024 + col0 + bj * 128;
                f32x4 sa, sbv; unpack8(sb[g & 3][bj], sa, sbv);
                if (u.part == 0) {
#pragma unroll
                    for (int j = 0; j < 4; ++j) { acc[ai][bj][m][0][j] *= sa[j]; acc[ai][bj][m][1][j] *= sbv[j]; }
                } else {
                    *(u32x4*)(O + off) = pack8(acc[ai][bj][m][0] * sa, acc[ai][bj][m][1] * sbv);
                }
            }
        }
#undef E6_LD
    }
};
struct EpiStore {
    static constexpr bool PERM = true;
    bf16_t* O;
    __device__ __forceinline__ bool keep(const Unit&) const { return false; }
    __device__ __forceinline__ void operator()(AccT& acc, const Unit& u, int wr, int wc, int fr, int fq) const {
        const int row0 = u.pm * 256 + wr * 64 + fr, col0 = u.pn * 256 + wc * 32 + 8 * fq;
#pragma unroll
        for (int ai = 0; ai < 2; ++ai)
#pragma unroll
            for (int m = 0; m < 4; ++m)
#pragma unroll
                for (int bj = 0; bj < 2; ++bj)
                    *(u32x4*)(O + (size_t)(row0 + ai * 128 + m * 16) * 1024 + col0 + bj * 128) = pack8(acc[ai][bj][m][0], acc[ai][bj][m][1]);
    }
};
struct Epi7 {
    static constexpr bool PERM = false;
    const float* x; bf16_t* X1B; float* rsq; int tok0;
    __device__ __forceinline__ bool keep(const Unit&) const { return false; }
    __device__ __forceinline__ void operator()(AccT& acc, const Unit& u, int wr, int wc, int fr, int fq) const {
        const int row0 = u.pm * 256 + wr * 64 + fr, col0 = u.pn * 256 + wc * 32 + 4 * fq;
        f32x4 xb[4][2][2];
#define E7_LD(g) do { _Pragma("unroll") for (int bj = 0; bj < 2; ++bj) _Pragma("unroll") for (int n = 0; n < 2; ++n) \
            xb[(g) & 3][bj][n] = *(const f32x4*)(x + ((size_t)tok0 + row0 + ((g) >> 2) * 128 + ((g) & 3) * 16) * 1024 + col0 + bj * 128 + n * 16); } while (0)
        E7_LD(0); E7_LD(1); E7_LD(2);
#pragma unroll
        for (int g = 0; g < 8; ++g) {
            if (g + 3 < 8) E7_LD(g + 3);
            const int ai = g >> 2, m = g & 3, row = row0 + ai * 128 + m * 16; const size_t tok = (size_t)tok0 + row; float ss = 0.f;
#pragma unroll
            for (int bj = 0; bj < 2; ++bj)
#pragma unroll
                for (int n = 0; n < 2; ++n) {
                    const int col = col0 + bj * 128 + n * 16;
                    const f32x4 o = xb[g & 3][bj][n] + acc[ai][bj][m][n];
                    *(u32x2*)(X1B + (size_t)row * 1024 + col) = pack4(o);
                    ss += (o[0] * o[0] + o[1] * o[1]) + (o[2] * o[2] + o[3] * o[3]);
                }
            ss += __shfl_xor(ss, 16); ss += __shfl_xor(ss, 32);
            if (fq == 0) rsq[tok * 16 + u.pn * 4 + wc] = ss;
        }
#undef E7_LD
    }
};
struct Epi8 {
    static constexpr bool PERM = false;
    const bf16_t* X1B; bf16_t* X2B; const bf16_t* PP; const float* rsq1; float* rsq2; int tok0;
    __device__ __forceinline__ bool keep(const Unit&) const { return false; }
    __device__ __forceinline__ void operator()(AccT& acc, const Unit& u, int wr, int wc, int fr, int fq) const {
        const int row0 = u.pm * 256 + wr * 64 + fr, col0 = u.pn * 256 + wc * 32 + 4 * fq;
        float rs[8];
        {   f32x4 sl[8];
#pragma unroll
            for (int r = 0; r < 8; ++r) sl[r] = *(const f32x4*)(rsq1 + ((size_t)tok0 + row0 + (r >> 2) * 128 + (r & 3) * 16) * 16 + 4 * fq);
#pragma unroll
            for (int r = 0; r < 8; ++r) { float t = (sl[r][0] + sl[r][1]) + (sl[r][2] + sl[r][3]); t += __shfl_xor(t, 16); t += __shfl_xor(t, 32); rs[r] = t; } }
        u32x2 pb[4][2][2], xb[4][2][2];
#define E8_LD(g) do { _Pragma("unroll") for (int bj = 0; bj < 2; ++bj) _Pragma("unroll") for (int n = 0; n < 2; ++n) { \
            const size_t off_ = (size_t)(row0 + ((g) >> 2) * 128 + ((g) & 3) * 16) * 1024 + col0 + bj * 128 + n * 16; \
            pb[(g) & 3][bj][n] = *(const u32x2*)(PP + off_); xb[(g) & 3][bj][n] = *(const u32x2*)(X1B + off_); } } while (0)
        E8_LD(0); E8_LD(1); E8_LD(2);
#pragma unroll
        for (int g = 0; g < 8; ++g) {
            if (g + 3 < 8) E8_LD(g + 3);
            const int ai = g >> 2, m = g & 3, row = row0 + ai * 128 + m * 16; const size_t tok = (size_t)tok0 + row; float ss = 0.f;
            const float rstd = rsqrtf(rs[g] * (1.0f / 1024.0f) + 1e-6f);
#pragma unroll
            for (int bj = 0; bj < 2; ++bj)
#pragma unroll
                for (int n = 0; n < 2; ++n) {
                    const size_t off = (size_t)row * 1024 + col0 + bj * 128 + n * 16;
                    const f32x4 gt = sig4(acc[ai][bj][m][n] * rstd);
                    const f32x4 o = unpack4(xb[g & 3][bj][n]) + gt * unpack4(pb[g & 3][bj][n]);
                    *(u32x2*)(X2B + off) = pack4(o);
                    ss += (o[0] * o[0] + o[1] * o[1]) + (o[2] * o[2] + o[3] * o[3]);
                }
            ss += __shfl_xor(ss, 16); ss += __shfl_xor(ss, 32);
            if (fq == 0) rsq2[tok * 16 + u.pn * 4 + wc] = ss;
        }
#undef E8_LD
    }
};

__device__ __forceinline__ int srccol_win(int np) {
    const int pn = np >> 8, L = np & 255;
    if (pn < 4) { const int isk = pn >> 1, t = pn & 1, half = L >> 7, i = L & 127, head = 2 * t + (i >> 6), dim = (i & 63) + 64 * half; return isk * 512 + head * 128 + dim; }
    if (pn < 8) return 1024 + (pn - 4) * 256 + L;
    if (pn < 12) return 2048 + (pn - 8) * 256 + L;
    if (pn < 20) { const int t = pn - 12; return L < 128 ? 3072 + 128 * t + L : 5120 + 128 * t + (L - 128); }
    if (pn < 24) return 4096 + (pn - 20) * 256 + L;
    { const int t = pn - 24; return L < 128 ? 6144 + 128 * t + L : 7168 + 128 * t + (L - 128); }
}
__device__ __forceinline__ void p0_transpose(LAS float* tile, const float* src, int ldsrc, int k0, int c0, bf16_t* dst, int ldk, int n0, const float* kscale, int tid) {
#pragma unroll
    for (int p = 0; p < 2; ++p) {
        const int r = (tid >> 4) + 32 * p, c4 = (tid & 15) * 4;
        const f32x4 v = *(const f32x4*)(src + (size_t)(k0 + r) * ldsrc + c0 + c4);
        const float s = kscale ? kscale[k0 + r] : 1.0f;
        tile[r * 65 + c4 + 0] = v[0] * s; tile[r * 65 + c4 + 1] = v[1] * s; tile[r * 65 + c4 + 2] = v[2] * s; tile[r * 65 + c4 + 3] = v[3] * s;
    }
    __syncthreads();
    {
        const int n = tid >> 3, kc = (tid & 7) * 8;
        u32x4 w;
        w.x = cvt_pk_bf16(tile[(kc + 0) * 65 + n], tile[(kc + 1) * 65 + n]); w.y = cvt_pk_bf16(tile[(kc + 2) * 65 + n], tile[(kc + 3) * 65 + n]);
        w.z = cvt_pk_bf16(tile[(kc + 4) * 65 + n], tile[(kc + 5) * 65 + n]); w.w = cvt_pk_bf16(tile[(kc + 6) * 65 + n], tile[(kc + 7) * 65 + n]);
        *(u32x4*)(dst + (size_t)(n0 + n) * ldk + k0 + kc) = w;
    }
    __syncthreads();
}

struct Params { const float *x, *p, *w_in, *w_ret, *w_sgu, *w_out, *sws, *sbs, *wpg, *wpp, *gm, *gp, *gf; float* out; unsigned char* ws; };

__device__ __forceinline__ void phase0(const Params& P, LAS unsigned char* lds, int tid, int wid, int lane) {
    unsigned char* ws = P.ws;
    const int G = gridDim.x, bx = blockIdx.x;
    LAS float* tile = (LAS float*)lds;
    for (int idx = bx; idx < 3136; idx += G) {
        if (idx < 2048) { const int kt = idx & 15, ntl = idx >> 4; p0_transpose(tile, P.w_in, 8192, kt * 64, srccol_win(ntl * 64), (bf16_t*)(ws + WS_WIN), 1024, ntl * 64, nullptr, tid); }
        else if (idx < 3072) { const int w = (idx - 2048) >> 8, r = (idx - 2048) & 255, kt = r & 15, ntl = r >> 4;
            const float* src = w == 0 ? P.w_ret : w == 1 ? P.w_sgu : w == 2 ? P.w_out : P.wpg;
            bf16_t* dst = (bf16_t*)(ws + (w == 0 ? WS_WR : w == 1 ? WS_WS : w == 2 ? WS_WO : WS_WG));
            p0_transpose(tile, src, 1024, kt * 64, ntl * 64, dst, 1024, ntl * 64, w == 3 ? P.gp : nullptr, tid); }
        else { const int r = idx - 3072, kt = r & 3, ntl = r >> 2; p0_transpose(tile, P.wpp, 1024, kt * 64, ntl * 64, (bf16_t*)(ws + WS_WPP), 256, ntl * 64, nullptr, tid); }
    }
    const int gt = bx * NTHR + tid, gn = G * NTHR;
    for (int i = gt; i < 4 * 128 * 128; i += gn) { const int r = (i >> 7) & 127, c = i & 127; const float v = c <= r ? P.sws[i] : 0.0f; ((bf16_t*)(ws + WS_WC))[i] = (bf16_t)(cvt_pk_bf16(v, 0.f) & 0xffffu); }
    for (int i = gt; i < 4096 * 64; i += gn) {
        const int pos = i >> 6, j = i & 63;
        const float inv = exp2f(-(float)j * (13.287712379549449f / 64.0f));
        const float ang = (float)pos * inv;
        const double a = (double)ang; const double nrev = rint(a * 0.15915494309189535); const float r = (float)(a - nrev * 6.283185307179586);
        ((float*)(ws + WS_COS))[i] = cosf(r); ((float*)(ws + WS_SIN))[i] = sinf(r);
    }
    for (size_t i = (size_t)gt * 8; i < (size_t)T_ALL * 256; i += (size_t)gn * 8) {
        const f32x4 a = *(const f32x4*)(P.p + i), b = *(const f32x4*)(P.p + i + 4);
        *(u32x4*)((bf16_t*)(ws + WS_PB) + i) = pack8(a, b);
    }
    {
        f32x4 gv[4];
#pragma unroll
        for (int i = 0; i < 4; ++i) gv[i] = *(const f32x4*)(P.gm + lane * 4 + 256 * i);
        for (int row = bx * 8 + wid; row < T_ALL; row += G * 8) {
            const float* xr = P.x + (size_t)row * 1024; f32x4 v[4]; float ss = 0.f;
#pragma unroll
            for (int i = 0; i < 4; ++i) { v[i] = *(const f32x4*)(xr + lane * 4 + 256 * i); ss += (v[i][0] * v[i][0] + v[i][1] * v[i][1]) + (v[i][2] * v[i][2] + v[i][3] * v[i][3]); }
            ss = wave_sum(ss);
            const float rstd = rsqrtf(ss * (1.0f / 1024.0f) + 1e-6f);
            bf16_t* hr = (bf16_t*)(ws + WS_H) + (size_t)row * 1024;
#pragma unroll
            for (int i = 0; i < 4; ++i) *(u32x2*)(hr + lane * 4 + 256 * i) = pack4(v[i] * rstd * gv[i]);
        }
    }
}

template <int ROWS, int COLS> struct TileRegs { u32x4 v[ROWS * (COLS / 8) / NTHR]; };
template <int ROWS, int COLS>
__device__ __forceinline__ void tile_load(TileRegs<ROWS, COLS>& t, const bf16_t* src, size_t gp, int tid) {
    constexpr int CPR = COLS / 8, IT = ROWS * CPR / NTHR;
#pragma unroll
    for (int i = 0; i < IT; ++i) { const int c = tid + i * NTHR, r = c / CPR, ch = c % CPR; t.v[i] = *(const u32x4*)(src + (size_t)r * gp + ch * 8); }
}
template <int ROWS, int COLS>
__device__ __forceinline__ void tile_store_b128(const TileRegs<ROWS, COLS>& t, LAS unsigned char* dst, int lp, int tid) {
    constexpr int CPR = COLS / 8, IT = ROWS * CPR / NTHR;
#pragma unroll
    for (int i = 0; i < IT; ++i) { const int c = tid + i * NTHR, r = c / CPR, ch = c % CPR; *(LAS u32x4*)(dst + r * lp + ch * 16) = t.v[i]; }
}
template <int ROWS, int COLS>
__device__ __forceinline__ void tile_store_b32(const TileRegs<ROWS, COLS>& t, LAS unsigned char* dst, int lp, int tid) {
    constexpr int CPR = COLS / 8, IT = ROWS * CPR / NTHR;
#pragma unroll
    for (int i = 0; i < IT; ++i) { const int c = tid + i * NTHR, r = c / CPR, ch = c % CPR; LAS unsigned* d = (LAS unsigned*)(dst + r * lp + ch * 16); d[0] = t.v[i].x; d[1] = t.v[i].y; d[2] = t.v[i].z; d[3] = t.v[i].w; }
}
__device__ __forceinline__ void gather8(const LAS unsigned char* base, int pitch, int r0, int col, unsigned short (&o)[8]) {
    const LAS unsigned char* p = base + r0 * pitch + col * 2;
#pragma unroll
    for (int j = 0; j < 8; ++j) o[j] = *(const LAS unsigned short*)(p + j * pitch);
}
__device__ __forceinline__ bf16x8 mk8(const unsigned short (&o)[8]) { bf16x8 r;
#pragma unroll
    for (int j = 0; j < 8; ++j) r[j] = (short)o[j];
    return r; }

__device__ __forceinline__ void p2_unit(LAS unsigned char* lds, const bf16_t* QK, const bf16_t* V, bf16_t* KV, int unit, int tid, int wid, int lane) {
    const int fr = lane & 15, fq = lane >> 4, h = unit & 3; const size_t tok0 = (size_t)(unit >> 2) * 128; const float lg = lgam(h);
    LAS unsigned char* sK = lds; LAS unsigned char* sV = lds + 33280;
    TileRegs<128, 128> tk; TileRegs<256, 128> tv;
    asm volatile("" : "+v"(tid));
    tile_load(tk, QK + tok0 * 1024 + 512 + h * 128, 1024, tid);
    tile_load(tv, V + (size_t)unit * 32768, 128, tid);
    __syncthreads();
    tile_store_b32(tk, sK, 260, tid);
    tile_store_b128(tv, sV, 272, tid);
    __syncthreads();
    f32x4 acc[2][8];
#pragma unroll
    for (int a = 0; a < 2; ++a)
#pragma unroll
        for (int b = 0; b < 8; ++b) acc[a][b] = (f32x4){0.f, 0.f, 0.f, 0.f};
#pragma unroll
    for (int ks = 0; ks < 4; ++ks) {
        const int j0 = 32 * ks + 8 * fq;
        bf16x8 vf[2];
#pragma unroll
        for (int e2 = 0; e2 < 2; ++e2) {
            const u32x4 vr = *(const LAS u32x4*)(sV + (16 * (2 * wid + e2) + fr) * 272 + j0 * 2);
            u32x4 w;
            w.x = cvt_pk_bf16(bf_lo(vr.x) * fexp(lg * (float)(127 - j0 - 0)), bf_hi(vr.x) * fexp(lg * (float)(127 - j0 - 1)));
            w.y = cvt_pk_bf16(bf_lo(vr.y) * fexp(lg * (float)(127 - j0 - 2)), bf_hi(vr.y) * fexp(lg * (float)(127 - j0 - 3)));
            w.z = cvt_pk_bf16(bf_lo(vr.z) * fexp(lg * (float)(127 - j0 - 4)), bf_hi(vr.z) * fexp(lg * (float)(127 - j0 - 5)));
            w.w = cvt_pk_bf16(bf_lo(vr.w) * fexp(lg * (float)(127 - j0 - 6)), bf_hi(vr.w) * fexp(lg * (float)(127 - j0 - 7)));
            vf[e2] = __builtin_bit_cast(bf16x8, w);
        }
#pragma unroll
        for (int db = 0; db < 8; ++db) {
            unsigned short o[8]; gather8(sK, 260, j0, 16 * db + fr, o);
            const bf16x8 kf = mk8(o);
#pragma unroll
            for (int e2 = 0; e2 < 2; ++e2) acc[e2][db] = __builtin_amdgcn_mfma_f32_16x16x32_bf16(kf, vf[e2], acc[e2][db], 0, 0, 0);
        }
    }
    bf16_t* dst = KV + (size_t)unit * 32768;
#pragma unroll
    for (int e2 = 0; e2 < 2; ++e2)
#pragma unroll
        for (int db = 0; db < 8; ++db) *(u32x2*)(dst + (16 * (2 * wid + e2) + fr) * 128 + 16 * db + 4 * fq) = pack4(acc[e2][db]);
}

__device__ __forceinline__ void p4_unit(LAS unsigned char* lds, const bf16_t* QK, const bf16_t* V, const bf16_t* PREV, const bf16_t* RG, bf16_t* RO, int unit, int tid, int wid, int lane) {
    const int fr = lane & 15, fq = lane >> 4, h = unit & 3; const size_t tok0 = (size_t)(unit >> 2) * 128; const float lg = lgam(h);
    LAS unsigned char* sK = lds; LAS unsigned char* sP = lds + 34816;
    TileRegs<128, 128> tk; TileRegs<256, 128> tp; TileRegs<256, 128> tv;
    asm volatile("" : "+v"(tid));
    tile_load(tk, QK + tok0 * 1024 + 512 + h * 128, 1024, tid);
    tile_load(tp, PREV + (size_t)unit * 32768, 128, tid);
    bf16x8 qf[4];
    { const bf16_t* qrow = QK + (tok0 + 16 * wid + fr) * 1024 + h * 128 + 8 * fq;
#pragma unroll
      for (int ks = 0; ks < 4; ++ks) qf[ks] = *(const bf16x8*)(qrow + 32 * ks); }
    __syncthreads();
    tile_store_b128(tk, sK, 272, tid);
    tile_store_b128(tp, sP, 272, tid);
    asm volatile("" : "+v"(tid));
    tile_load(tv, V + (size_t)unit * 32768, 128, tid);
    __syncthreads();
    f32x4 sacc[8];
#pragma unroll
    for (int jb = 0; jb < 8; ++jb) {
        sacc[jb] = (f32x4){0.f, 0.f, 0.f, 0.f};
        if (jb <= wid) {
#pragma unroll
            for (int ks = 0; ks < 4; ++ks) { const bf16x8 kf = *(const LAS bf16x8*)(sK + (16 * jb + fr) * 272 + (32 * ks + 8 * fq) * 2); sacc[jb] = __builtin_amdgcn_mfma_f32_16x16x32_bf16(kf, qf[ks], sacc[jb], 0, 0, 0); }
        }
    }
    f32x4 acc[16];
    const int i = 16 * wid + fr; const float xi = fexp(lg * (float)(i + 1));
#pragma unroll
    for (int eb = 0; eb < 16; ++eb) {
        f32x4 a = (f32x4){0.f, 0.f, 0.f, 0.f};
#pragma unroll
        for (int ks = 0; ks < 4; ++ks) { const bf16x8 pf = *(const LAS bf16x8*)(sP + (16 * eb + fr) * 272 + (32 * ks + 8 * fq) * 2); a = __builtin_amdgcn_mfma_f32_16x16x32_bf16(pf, qf[ks], a, 0, 0, 0); }
        acc[eb] = a * xi;
    }
    bf16x8 pfr[4];
#pragma unroll
    for (int ks = 0; ks < 4; ++ks) {
        float pv[8];
#pragma unroll
        for (int hf = 0; hf < 2; ++hf)
#pragma unroll
            for (int r = 0; r < 4; ++r) { const int jb = 2 * ks + hf, j = 16 * jb + 4 * fq + r; pv[4 * hf + r] = (j <= i) ? sacc[jb][r] * fexp(lg * (float)(i - j)) : 0.0f; }
        u32x4 w; w.x = cvt_pk_bf16(pv[0], pv[1]); w.y = cvt_pk_bf16(pv[2], pv[3]); w.z = cvt_pk_bf16(pv[4], pv[5]); w.w = cvt_pk_bf16(pv[6], pv[7]);
        pfr[ks] = __builtin_bit_cast(bf16x8, w);
    }
    __syncthreads();
    asm volatile("" : "+v"(tid));
    tile_store_b128(tv, lds, 272, tid);
    __syncthreads();
#pragma unroll
    for (int ks = 0; ks < 4; ++ks) {
        if (2 * ks <= wid) {
#pragma unroll
            for (int eb = 0; eb < 16; ++eb) {
                const LAS unsigned char* p = lds + (16 * eb + fr) * 272 + (32 * ks + 4 * fq) * 2;
                const u32x2 lo = *(const LAS u32x2*)p, hi = *(const LAS u32x2*)(p + 32);
                const u32x4 w = (u32x4){lo.x, lo.y, hi.x, hi.y};
                acc[eb] = __builtin_amdgcn_mfma_f32_16x16x32_bf16(__builtin_bit_cast(bf16x8, w), pfr[ks], acc[eb], 0, 0, 0);
            }
        }
    }
    float s = 0.f;
#pragma unroll
    for (int eb = 0; eb < 16; ++eb) s += (acc[eb][0] + acc[eb][1]) + (acc[eb][2] + acc[eb][3]);
    s += __shfl_xor(s, 16); s += __shfl_xor(s, 32);
    const float mu = s * (1.0f / 256.0f); float q = 0.f;
#pragma unroll
    for (int eb = 0; eb < 16; ++eb) { const f32x4 d = acc[eb] - mu; q += (d[0] * d[0] + d[1] * d[1]) + (d[2] * d[2] + d[3] * d[3]); }
    q += __shfl_xor(q, 16); q += __shfl_xor(q, 32);
    const float rstd = rsqrtf(q * (1.0f / 256.0f) + 1e-5f);
    const bf16_t* rgrow = RG + (tok0 + i) * 1024 + h * 256 + 4 * fq; bf16_t* rorow = RO + (tok0 + i) * 1024 + h * 256 + 4 * fq;
    u32x2 gl[16];
#pragma unroll
    for (int eb = 0; eb < 16; ++eb) gl[eb] = *(const u32x2*)(rgrow + 16 * eb);
#pragma unroll
    for (int eb = 0; eb < 16; ++eb) *(u32x2*)(rorow + 16 * eb) = pack4((acc[eb] - mu) * rstd * unpack4(gl[eb]));
}

__device__ __forceinline__ void p5_unit(LAS unsigned char* lds, const bf16_t* SV, const float* SVS, bf16_t* UO, const bf16_t* WC, const float* bias, int chunk, int tid, int wid, int lane) {
    const int fr = lane & 15, fq = lane >> 4; const size_t tok0 = (size_t)chunk * 128;
    LAS unsigned char* sW = lds; LAS unsigned char* sV = lds + 34816; LAS float* st = (LAS float*)(lds + 34816 + 66048);
    __syncthreads();
    {
        const int r = 16 * wid + (lane >> 2);
        const float* sp = SVS + (tok0 + r) * 32 + (lane & 3) * 8;
        const f32x4 p0 = *(const f32x4*)sp, p1 = *(const f32x4*)(sp + 4);
        float sm = (p0[0] + p0[2]) + (p1[0] + p1[2]), sq = (p0[1] + p0[3]) + (p1[1] + p1[3]);
        sm += __shfl_xor(sm, 1); sm += __shfl_xor(sm, 2); sq += __shfl_xor(sq, 1); sq += __shfl_xor(sq, 2);
        const float mu = sm * (1.0f / 1024.0f), var = fmaxf(sq * (1.0f / 1024.0f) - mu * mu, 0.0f);
        if ((lane & 3) == 0) { st[2 * r] = mu; st[2 * r + 1] = rsqrtf(var + 1e-5f); }
    }
    TileRegs<128, 128> tw; TileRegs<128, 256> tv;
    { int tg = tid; asm volatile("" : "+v"(tg)); tile_load(tw, WC, 128, tg); tile_load(tv, SV + tok0 * 1024, 1024, tg); }
    for (int g = 0; g < 4; ++g) {
        __syncthreads();
        tile_store_b128(tw, sW, 272, tid);
#pragma unroll
        for (int i = 0; i < 8; ++i) {
            const int c = tid + i * NTHR, r = c >> 5, ch = c & 31;
            f32x4 a, b; unpack8(tv.v[i], a, b);
            const float mu = st[2 * r], rs = st[2 * r + 1];
            const u32x4 w = pack8((a - mu) * rs, (b - mu) * rs);
            LAS unsigned* d = (LAS unsigned*)(sV + r * 516 + ch * 16); d[0] = w.x; d[1] = w.y; d[2] = w.z; d[3] = w.w;
        }
        __syncthreads();
        int tg = tid; asm volatile("" : "+v"(tg));
        if (g < 3) { tile_load(tw, WC + (g + 1) * 16384, 128, tg); tile_load(tv, SV + tok0 * 1024 + (g + 1) * 256, 1024, tg); }
        u32x2 ul[8][2]; float bvl[8];
        {   const int lfr = tg & 15, lfq = (tg & 63) >> 4;
#pragma unroll
            for (int ib = 0; ib < 8; ++ib) { bvl[ib] = bias[g * 128 + 16 * ib + lfr];
#pragma unroll
                for (int c2 = 0; c2 < 2; ++c2) ul[ib][c2] = *(const u32x2*)(UO + (tok0 + 16 * ib + lfr) * 1024 + g * 256 + 16 * (2 * wid + c2) + 4 * lfq); } }
        f32x4 acc[8][2];
#pragma unroll
        for (int a = 0; a < 8; ++a)
#pragma unroll
            for (int b = 0; b < 2; ++b) acc[a][b] = (f32x4){0.f, 0.f, 0.f, 0.f};
#pragma unroll
        for (int ks = 0; ks < 4; ++ks) {
            bf16x8 vf[2];
#pragma unroll
            for (int c2 = 0; c2 < 2; ++c2) { unsigned short o[8]; gather8(sV, 516, 32 * ks + 8 * fq, 16 * (2 * wid + c2) + fr, o); vf[c2] = mk8(o); }
#pragma unroll
            for (int ib = 0; ib < 8; ++ib) {
                if (ib >= 2 * ks) {
                    const bf16x8 wf = *(const LAS bf16x8*)(sW + (16 * ib + fr) * 272 + (32 * ks + 8 * fq) * 2);
#pragma unroll
                    for (int c2 = 0; c2 < 2; ++c2) acc[ib][c2] = __builtin_amdgcn_mfma_f32_16x16x32_bf16(vf[c2], wf, acc[ib][c2], 0, 0, 0);
                }
            }
        }
#pragma unroll
        for (int ib = 0; ib < 8; ++ib)
#pragma unroll
            for (int c2 = 0; c2 < 2; ++c2)
                *(u32x2*)(UO + (tok0 + 16 * ib + fr) * 1024 + g * 256 + 16 * (2 * wid + c2) + 4 * fq) = pack4((acc[ib][c2] + bvl[ib]) * unpack4(ul[ib][c2]));
    }
}

#define XB_TMO      128
#define XB_XCNT(j)  (256  + 64 * (j))
#define XB_XSUB(j)  (1280 + 64 * (j))
#define XB_XGEN(j)  (2304 + 64 * (j))
#define XB_TOP      3328
#define XB_TOPGEN   3392
#define XCD_BAR_WORDS 3456
#define XB_SPIN_CAP (1u << 22)
__device__ __forceinline__ unsigned xb_ld(unsigned* p)              { return __hip_atomic_load(p, __ATOMIC_RELAXED, __HIP_MEMORY_SCOPE_AGENT); }
__device__ __forceinline__ unsigned xb_add(unsigned* p, unsigned v) { return __hip_atomic_fetch_add(p, v, __ATOMIC_RELAXED, __HIP_MEMORY_SCOPE_AGENT); }
__device__ __forceinline__ unsigned xb_xcc_id() { return (unsigned)__builtin_amdgcn_s_getreg((3 << 11) | 20) & 0xFu; }
#define XB_SPIN(cond, bar) do { unsigned _sp = 0; while (cond) { __builtin_amdgcn_s_sleep(1); \
    if ((++_sp & 255u) == 0u) { if (xb_ld(&(bar)[XB_TMO])) break; if (_sp > XB_SPIN_CAP) { atomicAdd(&(bar)[XB_TMO], 1u); break; } } } } while (0)
struct XcdBarrier { unsigned* bar; unsigned x; volatile LAS unsigned* st; };
__device__ __forceinline__ XcdBarrier xcd_barrier_post(unsigned* bar, volatile LAS unsigned* st) {
    XcdBarrier b; b.bar = bar; b.x = xb_xcc_id(); b.st = st;
    if (threadIdx.x == 0) (void)xb_add(&bar[XB_XCNT(b.x)], 1u);
    return b;
}
__device__ __forceinline__ void xcd_barrier_complete(unsigned* bar, unsigned x, unsigned& nloc, unsigned& nx) {
    const unsigned G = gridDim.x * gridDim.y * gridDim.z;
    unsigned sum, cnt, mine, sp = 0u;
    for (;;) {
        sum = 0u; cnt = 0u; mine = 0u;
#pragma nounroll
        for (unsigned j = 0; j < 16; ++j) { const unsigned c = xb_ld(&bar[XB_XCNT(j)]); sum += c; cnt += (c > 0u) ? 1u : 0u; mine = (j == x) ? c : mine; }
        if (sum == G) break;
        __builtin_amdgcn_s_sleep(1);
        if ((++sp & 255u) == 0u) { if (xb_ld(&bar[XB_TMO])) break; if (sp > XB_SPIN_CAP) { atomicAdd(&bar[XB_TMO], 1u); break; } }
    }
    nloc = mine > 0u ? mine : 1u; nx = cnt > 0u ? cnt : 1u;
}
__device__ __forceinline__ void xcd_barrier(const XcdBarrier& b) {
    asm volatile("s_waitcnt vmcnt(0)" ::: "memory");
    __syncthreads();
    if (threadIdx.x == 0) {
        unsigned* bar = b.bar;
        __builtin_amdgcn_s_waitcnt(0);
        unsigned nloc = b.st[0], nx = b.st[1];
        if (nloc == 0u) { xcd_barrier_complete(bar, b.x, nloc, nx); b.st[0] = nloc; b.st[1] = nx; }
        const unsigned old = xb_add(&bar[XB_XSUB(b.x)], 1u);
        const unsigned gen = old / nloc;
        if (old + 1u == (gen + 1u) * nloc) {
            __builtin_amdgcn_fence(__ATOMIC_RELEASE, "agent");
            asm volatile("s_waitcnt vmcnt(0)" ::: "memory");
            const unsigned og = xb_add(&bar[XB_TOP], 1u);
            const unsigned tg = og / nx;
            if (og + 1u == (tg + 1u) * nx) xb_add(&bar[XB_TOPGEN], 1u);
            else XB_SPIN(xb_ld(&bar[XB_TOPGEN]) == tg, bar);
            __builtin_amdgcn_fence(__ATOMIC_ACQUIRE, "agent");
            xb_add(&bar[XB_XGEN(b.x)], 1u);
            asm volatile("s_waitcnt vmcnt(0)" ::: "memory");
        } else {
            XB_SPIN(xb_ld(&bar[XB_XGEN(b.x)]) == gen, bar);
            __builtin_amdgcn_fence(__ATOMIC_ACQUIRE, "agent");
            asm volatile("s_waitcnt vmcnt(0)" ::: "memory");
        }
    }
    __syncthreads();
}

#if defined(EXPM) && (EXPM & 64)
#define GSYNC() do { xcd_barrier(xbar); xcd_barrier(xbar); } while (0)
#else
#define GSYNC() xcd_barrier(xbar)
#endif
#define FRESH_IDS int tid_ = threadIdx.x; asm volatile("" : "+v"(tid_)); const int tid = tid_, wid = __builtin_amdgcn_readfirstlane(tid >> 6), lane = tid & 63; (void)wid; (void)lane;
__global__ void __launch_bounds__(NTHR, 2) mega(Params P) {
    extern __shared__ __attribute__((aligned(16))) unsigned char lds_raw[];
    LAS unsigned char* lds = (LAS unsigned char*)lds_raw;
    cg::grid_group grid = cg::this_grid();
    const int G = gridDim.x, bx = blockIdx.x;
    unsigned char* ws = P.ws;
    bf16_t* const WIN = (bf16_t*)(ws + WS_WIN); bf16_t* const WR = (bf16_t*)(ws + WS_WR); bf16_t* const WSG = (bf16_t*)(ws + WS_WS); bf16_t* const WO = (bf16_t*)(ws + WS_WO);
    bf16_t* const WG = (bf16_t*)(ws + WS_WG); bf16_t* const WPP = (bf16_t*)(ws + WS_WPP); bf16_t* const WC = (bf16_t*)(ws + WS_WC);
    float* const RSQ1 = (float*)(ws + WS_SV); float* const RSQ2 = (float*)(ws + WS_SV + 8 * MiB);
    bf16_t* const H = (bf16_t*)(ws + WS_H); bf16_t* const PB = (bf16_t*)(ws + WS_PB);
    bf16_t* const QK = (bf16_t*)(ws + WS_QK); bf16_t* const V = (bf16_t*)(ws + WS_V); bf16_t* const SV = (bf16_t*)(ws + WS_SV);
    bf16_t* const RG2 = (bf16_t*)(ws + WS_RG2); bf16_t* const UG2 = (bf16_t*)(ws + WS_UG2); bf16_t* const MR2 = (bf16_t*)(ws + WS_MR2); bf16_t* const MS2 = (bf16_t*)(ws + WS_MS2);
    bf16_t* const PREV = (bf16_t*)P.out;
    bf16_t* const MERGED = H; bf16_t* const X1B = QK; bf16_t* const PP = (bf16_t*)(ws + WS_PP);
    volatile LAS unsigned* xst = (volatile LAS unsigned*)(lds + LDS_STAGE);
    if (threadIdx.x < 4) xst[threadIdx.x] = 0u;
    __syncthreads();
    const XcdBarrier xbar = xcd_barrier_post((unsigned*)(ws + WS_BAR), xst);

    { FRESH_IDS phase0(P, lds, tid, wid, lane); }
    if (P.ws == nullptr) grid.sync();

    for (int sl = 0; sl < NSL; ++sl) {
        const int tokb = sl * TS;
        bf16_t* const RG = RG2 + (size_t)tokb * 1024; bf16_t* const UG = UG2 + (size_t)tokb * 1024;
        GSYNC();
        {
            pg8::Src1V g{H + (size_t)tokb * 1024, WIN, 1024}; pg8::StaticOrder S; S.init(TS, 8192, G, bx);
            Epi1 E{QK, UG, (const float*)(ws + WS_COS), (const float*)(ws + WS_SIN), sl, (float*)((unsigned char*)P.out + 64 * MiB)};
            pg8::gemm_phase(lds, g, 1024, S, E);
        }
        GSYNC();
        { FRESH_IDS for (int u = bx; u < BSL * 32 * 4; u += G) p2_unit(lds, QK, V, PREV, u, tid, wid, lane); }
        { FRESH_IDS for (int c = bx; c < BSL * 32; c += G) p5_unit(lds, SV, (const float*)((unsigned char*)P.out + 64 * MiB), UG, WC, P.sbs, c, tid, wid, lane); }
        GSYNC();
        { FRESH_IDS
        for (int it = bx * NTHR + tid; it < BSL * 4 * 256 * 32; it += G * NTHR) {
            const int d4 = it & 31, e = (it >> 5) & 255, h = (it >> 13) & 3, bl = it >> 15;
            const float cd = fexp(128.0f * lgam(h));
            f32x4 run = (f32x4){0.f, 0.f, 0.f, 0.f};
            const size_t base = ((size_t)(bl * 32) * 4 + h) * 32768 + e * 128 + d4 * 4;
#pragma unroll 8
            for (int n = 0; n < 32; ++n) {
                const size_t o = base + (size_t)n * 4 * 32768;
                const f32x4 kv = unpack4(*(const u32x2*)(PREV + o));
                *(u32x2*)(PREV + o) = pack4(run);
                run = kv + run * cd;
            }
        } }
        GSYNC();
        { FRESH_IDS for (int u = bx; u < BSL * 32 * 4; u += G) p4_unit(lds, QK, V, PREV, RG, RG, u, tid, wid, lane); }
    }
    GSYNC();
    {
        pg8::Src2 g{RG2, WR, (long)((const char*)UG2 - (const char*)RG2), (long)((const char*)WSG - (const char*)WR), 1024}; pg8::DualOrder S; S.init(T_ALL, 1024, G, bx);
        Epi6 E{MR2, MS2, MERGED};
        pg8::gemm_phase(lds, g, 1024, S, E);
    }
    GSYNC();
    {
        pg8::Src1 g{MERGED, WO, 1024}; pg8::StaticOrder S; S.init(T_ALL, 1024, G, bx);
        Epi7 E{P.x, X1B, RSQ1, 0};
        pg8::gemm_phase(lds, g, 1024, S, E);
        pg8::Src1 g2{PB, WPP, 256};
        EpiStore E2{PP};
        pg8::gemm_phase(lds, g2, 256, S, E2);
    }
    GSYNC();
    {
        pg8::Src1 g{X1B, WG, 1024}; pg8::StaticOrder S; S.init(T_ALL, 1024, G, bx);
        Epi8 E{X1B, MERGED, PP, RSQ1, RSQ2, 0};
        pg8::gemm_phase(lds, g, 1024, S, E);
    }
    GSYNC();
    {
        FRESH_IDS
        f32x4 gv[4];
#pragma unroll
        for (int i = 0; i < 2; ++i) { gv[2 * i] = *(const f32x4*)(P.gf + lane * 8 + 512 * i); gv[2 * i + 1] = *(const f32x4*)(P.gf + lane * 8 + 512 * i + 4); }
        for (int row = bx * 8 + wid; row < T_ALL; row += G * 8) {
            float sq = RSQ2[(size_t)row * 16 + (lane & 15)]; sq += __shfl_xor(sq, 1); sq += __shfl_xor(sq, 2); sq += __shfl_xor(sq, 4); sq += __shfl_xor(sq, 8);
            const float rstd = rsqrtf(sq * (1.0f / 1024.0f) + 1e-6f); float* o = P.out + (size_t)row * 1024; const bf16_t* xr = MERGED + (size_t)row * 1024;
#pragma unroll
            for (int i = 0; i < 2; ++i) { f32x4 a, b; unpack8(*(const u32x4*)(xr + lane * 8 + 512 * i), a, b);
                *(f32x4*)(o + lane * 8 + 512 * i) = a * rstd * gv[2 * i]; *(f32x4*)(o + lane * 8 + 512 * i + 4) = b * rstd * gv[2 * i + 1]; }
        }
    }
}

extern "C" void kernel_launch(void* const* d_in, const int* in_sizes, int n_in, void* d_out, int out_size, void* d_ws, size_t ws_size, hipStream_t stream) {
    static int grid_blocks = 0;
    if (grid_blocks == 0) {
        int dev = 0, cus = 0, per_cu = 0;
        hipGetDevice(&dev);
        hipDeviceGetAttribute(&cus, hipDeviceAttributeMultiprocessorCount, dev);
        if (hipFuncSetAttribute((const void*)mega, hipFuncAttributeMaxDynamicSharedMemorySize, LDS_BYTES) != hipSuccess) fprintf(stderr, "hipFuncSetAttribute failed\n");
        if (hipOccupancyMaxActiveBlocksPerMultiprocessor(&per_cu, (const void*)mega, NTHR, LDS_BYTES) != hipSuccess || per_cu < 1) { per_cu = 1; (void)hipGetLastError(); }
        grid_blocks = cus * (per_cu > 1 ? 1 : per_cu);
        if (ws_size < WS_END) fprintf(stderr, "workspace too small: %zu < %zu\n", ws_size, (size_t)WS_END);
    }
    Params p{};
    p.x = (const float*)d_in[0]; p.p = (const float*)d_in[1]; p.w_in = (const float*)d_in[2]; p.w_ret = (const float*)d_in[3]; p.w_sgu = (const float*)d_in[4];
    p.w_out = (const float*)d_in[5]; p.sws = (const float*)d_in[6]; p.sbs = (const float*)d_in[7]; p.wpg = (const float*)d_in[8]; p.wpp = (const float*)d_in[9];
    p.gm = (const float*)d_in[10]; p.gp = (const float*)d_in[11]; p.gf = (const float*)d_in[12];
    p.out = (float*)d_out; p.ws = (unsigned char*)d_ws;
    (void)hipMemsetAsync((char*)d_ws + WS_BAR, 0, XCD_BAR_WORDS * 4, stream);
    void* args[] = {&p};
    hipError_t e = hipLaunchCooperativeKernel((const void*)mega, dim3(grid_blocks), dim3(NTHR), args, LDS_BYTES, stream);
    if (e != hipSuccess) fprintf(stderr, "cooperative launch failed: %s (grid %d)\n", hipGetErrorString(e), grid_blocks);
}
```

```cpp
#include <hip/hip_runtime.h>
#include <hip/hip_cooperative_groups.h>
#include <cstdio>
namespace cg = cooperative_groups;

#define LAS __attribute__((address_space(3)))
typedef unsigned short bf16_t;
typedef short bf16x8 __attribute__((ext_vector_type(8)));
typedef float f32x4 __attribute__((ext_vector_type(4)));
typedef float f32x2 __attribute__((ext_vector_type(2)));
typedef unsigned u32x4 __attribute__((ext_vector_type(4)));
typedef unsigned u32x2 __attribute__((ext_vector_type(2)));

constexpr int T_ALL = 65536, DM = 1024, NSL = 2, TS = T_ALL / NSL, BSL = 16 / NSL;
constexpr int NTHR = 512;
constexpr int LDS_STAGE = 131072, LDS_BYTES = LDS_STAGE + 16;
constexpr size_t MiB = 1ull << 20;
constexpr size_t UB = (size_t)TS * 1024 * 2;
constexpr size_t WS_WIN = 0, WS_WR = 16 * MiB, WS_WS = 18 * MiB, WS_WO = 20 * MiB, WS_WG = 22 * MiB, WS_WPP = 24 * MiB, WS_WC = 24 * MiB + 512 * 1024,
                 WS_COS = 25 * MiB, WS_SIN = 26 * MiB, WS_RSQ1 = 27 * MiB, WS_RSQ2 = 27 * MiB + 256 * 1024, WS_BAR = 28 * MiB, WS_RS0 = 29 * MiB,
                 WS_H = 32 * MiB, WS_PB = 160 * MiB, WS_SL = 192 * MiB;
constexpr size_t WS_QK = WS_SL, WS_V = WS_SL + UB, WS_SV = WS_SL + 2 * UB, WS_RG2 = WS_SL + 3 * UB, WS_UG2 = WS_SL + 5 * UB, WS_MR2 = WS_SL + 7 * UB, WS_MS2 = WS_SL + 9 * UB,
                 WS_PP = WS_SL + 11 * UB, WS_END = WS_SL + 13 * UB;
static_assert(WS_END == 1024 * MiB, "workspace map");

__device__ __forceinline__ unsigned cvt_pk_bf16(float lo, float hi) { unsigned r; asm volatile("v_cvt_pk_bf16_f32 %0, %1, %2" : "=v"(r) : "v"(lo), "v"(hi)); return r; }
__device__ __forceinline__ float bf_lo(unsigned w) { return __uint_as_float(w << 16); }
__device__ __forceinline__ float bf_hi(unsigned w) { return __uint_as_float(w & 0xffff0000u); }
__device__ __forceinline__ float bf2f(unsigned short b) { return __uint_as_float(((unsigned)b) << 16); }
__device__ __forceinline__ float wave_sum(float v) {
#pragma unroll
    for (int o = 32; o >= 1; o >>= 1) v += __shfl_xor(v, o);
    return v;
}
__device__ __forceinline__ float sigmoidf_(float x) { return __builtin_amdgcn_rcpf(1.0f + __builtin_amdgcn_exp2f(-1.4426950408889634f * x)); }
__device__ __forceinline__ float fexp(float x) { return __builtin_amdgcn_exp2f(1.4426950408889634f * x); }
__device__ __forceinline__ f32x2 gelu_pk(f32x2 v) {
    const f32x2 av = __builtin_elementwise_abs(v), d = av * 0.2316418882f + 1.0f;
    f32x2 t; t.x = __builtin_amdgcn_rcpf(d.x); t.y = __builtin_amdgcn_rcpf(d.y);
    f32x2 q = t * 0.5307027145f + (-0.7265760135f); q = q * t + 0.7107068705f; q = q * t + (-0.142248368f); q = q * t + 0.127414796f; q = q * t;
    const f32x2 s = (v * v) * (-0.72134752044f);
    f32x2 e; e.x = __builtin_amdgcn_exp2f(s.x); e.y = __builtin_amdgcn_exp2f(s.y);
    const f32x2 m = v * (q * e), r = v - m;
    f32x2 o; o.x = v.x < 0.f ? m.x : r.x; o.y = v.y < 0.f ? m.y : r.y; return o;
}
__device__ __forceinline__ f32x4 gelu4(f32x4 v) { f32x2 a = gelu_pk((f32x2){v[0], v[1]}), b = gelu_pk((f32x2){v[2], v[3]}); return (f32x4){a.x, a.y, b.x, b.y}; }
__device__ __forceinline__ f32x4 sig4(f32x4 v) { return (f32x4){sigmoidf_(v[0]), sigmoidf_(v[1]), sigmoidf_(v[2]), sigmoidf_(v[3])}; }
__device__ __forceinline__ float lgam(int h) { return h == 0 ? -0.03174869831458027f : h == 1 ? -0.01574835696813892f : h == 2 ? -0.007843177461025892f : -0.003913899321136329f; }

namespace pg8 {
constexpr int BM = 256, BK = 64, HALF = 128, HTB = HALF * BK * 2, STAGE_BYTES = 8 * HTB, NXCD = 8, WGM = 8;
__host__ __device__ __forceinline__ int lds_byte(int r, int c) { const int st = (r >> 4) * 2 + (c >> 5), rr = r & 15, cc = c & 31, ob = rr * 64 + cc * 2; return st * 1024 + (ob ^ (((ob >> 9) & 1) << 5)); }
__host__ __device__ __forceinline__ void stage_rc(int b, int& R, int& C) { const int st = b / 1024, sb = b % 1024, swz = sb ^ (((sb >> 9) & 1) << 5); R = (st >> 1) * 16 + swz / 64; C = (st & 1) * 32 + (swz % 64) / 2; }
__host__ __device__ __forceinline__ int perm32(int rho) { const int n = rho >> 4, i = rho & 15; return 8 * (i >> 2) + 4 * n + (i & 3); }

struct Unit { int pm, pn, part; };
struct StaticOrder {
    int nM, nN, nwg, G, c;
    __device__ void init(int M, int N, int G_, int c_) { nM = M / BM; nN = N / BM; nwg = nM * nN; G = G_; c = c_; }
    __device__ bool next(int i, Unit& u) const {
        const long L = (long)i * G + c; if (L >= nwg) return false;
        int wgid = (int)L; { const int q = nwg / NXCD, r = nwg % NXCD, xcd = wgid % NXCD, off = wgid / NXCD; wgid = (xcd < r ? xcd * (q + 1) : r * (q + 1) + (xcd - r) * q) + off; }
        const int nig = WGM * nN, gid = wgid / nig, fm = gid * WGM, gsz = (nM - fm) < WGM ? (nM - fm) : WGM;
        u.pm = fm + ((wgid % nig) % gsz); u.pn = (wgid % nig) / gsz; u.part = 0; return true;
    }
};
struct DualOrder : StaticOrder {
    __device__ bool next(int i, Unit& u) const { if (!StaticOrder::next(i >> 1, u)) return false; u.part = i & 1; return true; }
};
struct Src1 { const bf16_t* A; const bf16_t* Bt; int K;
    __device__ __forceinline__ const char* a(const Unit& u) const { return (const char*)A + (size_t)u.pm * BM * K * 2; }
    __device__ __forceinline__ const char* b(const Unit& u) const { return (const char*)Bt + (size_t)u.pn * BM * K * 2; } };
struct Src1V { const bf16_t* A; const bf16_t* Bt; int K;
    __device__ __forceinline__ const char* a(const Unit& u) const { const char* pa = (const char*)A + (size_t)u.pm * BM * K * 2; const char* pb = (const char*)Bt + (size_t)u.pn * BM * K * 2; const long sw = (u.pn >= 4 && u.pn < 8) ? 1 : 0; return pa + sw * (long)(pb - pa); }
    __device__ __forceinline__ const char* b(const Unit& u) const { const char* pa = (const char*)A + (size_t)u.pm * BM * K * 2; const char* pb = (const char*)Bt + (size_t)u.pn * BM * K * 2; const long sw = (u.pn >= 4 && u.pn < 8) ? 1 : 0; return pb - sw * (long)(pb - pa); } };
struct Src2 { const bf16_t* A0; const bf16_t* B0; long dA, dB; int K;
    __device__ __forceinline__ const char* a(const Unit& u) const { return (const char*)A0 + (long)u.part * dA + (size_t)u.pm * BM * K * 2; }
    __device__ __forceinline__ const char* b(const Unit& u) const { return (const char*)B0 + (long)u.part * dB + (size_t)u.pn * BM * K * 2; } };

template <class Epi, class Sched, class Src>
__device__ __forceinline__ void gemm_phase(LAS unsigned char* lds, const Src& g, const int K, const Sched& S, const Epi& E) {
    int tid_ = threadIdx.x; asm volatile("" : "+v"(tid_));
    const int tid = tid_, wid = __builtin_amdgcn_readfirstlane(tid >> 6), lane = tid & 63, wr = wid >> 2, wc = wid & 3, fr = lane & 15, fq = lane >> 4;
    const int nt = K / BK;
    unsigned voffA[2], voffB[2];
#pragma unroll
    for (int i = 0; i < 2; ++i) { int R, C; stage_rc(tid * 16 + i * 8192, R, C); const int Rb = Epi::PERM ? ((R & ~31) + perm32(R & 31)) : R;
        voffA[i] = (unsigned)(R * K + C) * 2u; voffB[i] = (unsigned)(Rb * K + C) * 2u; }
    const size_t kstep = (size_t)(BK * 2);
    const size_t hstep = (size_t)HALF * K * 2;
    const unsigned ldsw = (unsigned)wid * 1024u;
    const int aoff = lds_byte(wr * 64 + fr, fq * 8), boff = lds_byte(wc * 32 + fr, fq * 8);
#define PG8_SA(b, h) (((b) * 2 + (h)) * HTB)
#define PG8_SB(b, h) ((4 + (b) * 2 + (h)) * HTB)
#define PG8_STAGE(bufoff, gbase, voff) do { _Pragma("unroll") for (int _i = 0; _i < 2; ++_i) \
        __builtin_amdgcn_global_load_lds((const unsigned*)((const char*)(gbase) + (voff)[_i]), (LAS unsigned*)(lds + (bufoff) + ldsw + _i * 8192), 16, 0, 0); } while (0)
#define PG8_LDA(dst, b, h) do { _Pragma("unroll") for (int m = 0; m < 4; ++m) _Pragma("unroll") for (int k = 0; k < 2; ++k) dst[m][k] = *(const LAS bf16x8*)(lds + PG8_SA(b, h) + aoff + m * 2048 + k * 1024); } while (0)
#define PG8_LDB(dst, b, h) do { _Pragma("unroll") for (int n = 0; n < 2; ++n) _Pragma("unroll") for (int k = 0; k < 2; ++k) dst[n][k] = *(const LAS bf16x8*)(lds + PG8_SB(b, h) + boff + n * 2048 + k * 1024); } while (0)
#define PG8_MMA(ai, bj, At, Bt) do { __builtin_amdgcn_s_setprio(1); _Pragma("unroll") for (int m = 0; m < 4; ++m) _Pragma("unroll") for (int n = 0; n < 2; ++n) _Pragma("unroll") for (int k = 0; k < 2; ++k) \
        acc[ai][bj][m][n] = __builtin_amdgcn_mfma_f32_16x16x32_bf16(Bt[n][k], At[m][k], acc[ai][bj][m][n], 0, 0, 0); __builtin_amdgcn_s_setprio(0); } while (0)
#define PG8_WAIT_V(n) asm volatile("s_waitcnt vmcnt(" #n ")" ::: "memory")
#define PG8_WAIT_L(n) asm volatile("s_waitcnt lgkmcnt(" #n ")" ::: "memory")
#define PG8_BAR __builtin_amdgcn_s_barrier()
#define PG8_SCHED __builtin_amdgcn_sched_barrier(0)
    Unit cur, nxt; int ui = 0;
    if (!S.next(0, cur)) return;
    f32x4 acc[2][2][4][2];
#pragma unroll
    for (int a = 0; a < 2; ++a)
#pragma unroll
        for (int b = 0; b < 2; ++b)
#pragma unroll
            for (int m = 0; m < 4; ++m)
#pragma unroll
                for (int n = 0; n < 2; ++n) acc[a][b][m][n] = (f32x4){0.f, 0.f, 0.f, 0.f};
    bf16x8 At[4][2], B0[2][2], B1[2][2];
    const char* cA = g.a(cur); const char* cB = g.b(cur);
    PG8_STAGE(PG8_SB(0, 0), cB, voffB); PG8_STAGE(PG8_SA(0, 0), cA, voffA); PG8_STAGE(PG8_SB(0, 1), cB + hstep, voffB); PG8_STAGE(PG8_SA(0, 1), cA + hstep, voffA);
    if (wr == 1) PG8_BAR;
    PG8_WAIT_V(4); PG8_BAR;
    PG8_STAGE(PG8_SB(1, 0), cB + kstep, voffB); PG8_STAGE(PG8_SA(1, 0), cA + kstep, voffA); PG8_STAGE(PG8_SB(1, 1), cB + hstep + kstep, voffB);
    PG8_WAIT_V(6); PG8_BAR;
    for (;;) {
        const bool has_next = S.next(ui + 1, nxt);
        const char* nA = has_next ? g.a(nxt) : cA; const char* nB = has_next ? g.b(nxt) : cB;
        for (int t = 0; t < nt; t += 2) {
            const bool last = (t == nt - 2);
            const char* a1 = cA + (size_t)(t + 1) * kstep;
            const char* a2 = last ? nA : cA + (size_t)(t + 2) * kstep; const char* b2 = last ? nB : cB + (size_t)(t + 2) * kstep;
            const char* a3 = a2 + kstep; const char* b3 = b2 + kstep;
            PG8_LDB(B0, 0, 0); PG8_SCHED; PG8_LDA(At, 0, 0); PG8_STAGE(PG8_SA(1, 1), a1 + hstep, voffA);
            PG8_WAIT_L(8); PG8_BAR; PG8_WAIT_L(0); PG8_MMA(0, 0, At, B0); PG8_BAR; PG8_SCHED;
            PG8_LDB(B1, 0, 1); PG8_STAGE(PG8_SB(0, 0), b2, voffB);
            PG8_BAR; PG8_WAIT_L(0); PG8_MMA(0, 1, At, B1); PG8_BAR;
            PG8_LDA(At, 0, 1); PG8_STAGE(PG8_SA(0, 0), a2, voffA);
            PG8_BAR; PG8_WAIT_L(0); PG8_MMA(1, 0, At, B0); PG8_BAR; PG8_SCHED;
            PG8_STAGE(PG8_SB(0, 1), b2 + hstep, voffB);
            PG8_WAIT_V(6); PG8_BAR; PG8_MMA(1, 1, At, B1); PG8_BAR;
            PG8_LDB(B0, 1, 0); PG8_SCHED; PG8_LDA(At, 1, 0); PG8_STAGE(PG8_SA(0, 1), a2 + hstep, voffA);
            PG8_WAIT_L(8); PG8_BAR; PG8_WAIT_L(0); PG8_MMA(0, 0, At, B0); PG8_BAR; PG8_SCHED;
            PG8_LDB(B1, 1, 1); PG8_STAGE(PG8_SB(1, 0), b3, voffB);
            PG8_BAR; PG8_WAIT_L(0); PG8_MMA(0, 1, At, B1); PG8_BAR;
            PG8_LDA(At, 1, 1); PG8_STAGE(PG8_SA(1, 0), a3, voffA);
            PG8_BAR; PG8_WAIT_L(0); PG8_MMA(1, 0, At, B0); PG8_BAR; PG8_SCHED;
            PG8_STAGE(PG8_SB(1, 1), b3 + hstep, voffB);
            PG8_WAIT_V(6); PG8_BAR; PG8_MMA(1, 1, At, B1); PG8_BAR;
        }
        {
            int epm = cur.pm, epn = cur.pn, efr = fr, efq = fq; asm volatile("" : "+s"(epm), "+s"(epn), "+v"(efr), "+v"(efq));
            const Unit eu{epm, epn, cur.part};
            E(acc, eu, wr, wc, efr, efq);
        }
        if (!has_next) break;
        if (!E.keep(cur)) {
#pragma unroll
            for (int a = 0; a < 2; ++a)
#pragma unroll
                for (int b = 0; b < 2; ++b)
#pragma unroll
                    for (int m = 0; m < 4; ++m)
#pragma unroll
                        for (int n = 0; n < 2; ++n) acc[a][b][m][n] = (f32x4){0.f, 0.f, 0.f, 0.f};
        }
        cur = nxt; cA = nA; cB = nB; ++ui;
    }
    PG8_WAIT_V(0);
    if (wr == 0) PG8_BAR;
    PG8_BAR;
#undef PG8_SA
#undef PG8_SB
#undef PG8_STAGE
#undef PG8_LDA
#undef PG8_LDB
#undef PG8_MMA
#undef PG8_WAIT_V
#undef PG8_WAIT_L
#undef PG8_BAR
#undef PG8_SCHED
}
}
using pg8::Unit;
typedef f32x4 AccT[2][2][4][2];

__device__ __forceinline__ u32x4 pack8(f32x4 a, f32x4 b) { u32x4 w; w.x = cvt_pk_bf16(a[0], a[1]); w.y = cvt_pk_bf16(a[2], a[3]); w.z = cvt_pk_bf16(b[0], b[1]); w.w = cvt_pk_bf16(b[2], b[3]); return w; }
__device__ __forceinline__ u32x2 pack4(f32x4 a) { u32x2 w; w.x = cvt_pk_bf16(a[0], a[1]); w.y = cvt_pk_bf16(a[2], a[3]); return w; }
__device__ __forceinline__ void unpack8(u32x4 w, f32x4& a, f32x4& b) { a = (f32x4){bf_lo(w.x), bf_hi(w.x), bf_lo(w.y), bf_hi(w.y)}; b = (f32x4){bf_lo(w.z), bf_hi(w.z), bf_lo(w.w), bf_hi(w.w)}; }
__device__ __forceinline__ f32x4 unpack4(u32x2 w) { return (f32x4){bf_lo(w.x), bf_hi(w.x), bf_lo(w.y), bf_hi(w.y)}; }

struct Epi1 {
    static constexpr bool PERM = true;
    bf16_t *QK, *UG; const float* cs; const float* sn; int sl; float* svs;
    __device__ __forceinline__ bool keep(const Unit&) const { return false; }
    __device__ __forceinline__ void operator()(AccT& acc, const Unit& u, int wr, int wc, int fr, int fq) const {
        const int pn = u.pn, cl = wc * 32 + 8 * fq, row0 = u.pm * 256 + wr * 64 + fr;
        if (pn < 4) {
            const int isk = pn >> 1, t = pn & 1, head = 2 * t + (cl >> 6), dim0 = cl & 63;
            const float sc = isk ? 1.0f : 0.08838834764831845f;
            bf16_t* base = QK + isk * 512 + head * 128 + dim0;
            f32x4 tb[2][2][4];
#define ROT_LD(b, buf) do { _Pragma("unroll") for (int mm = 0; mm < 2; ++mm) { const int pos_ = (row0 + ((b) >> 1) * 128 + (((b) & 1) * 2 + mm) * 16) & 4095; \
                tb[buf][mm][0] = *(const f32x4*)(cs + pos_ * 64 + dim0); tb[buf][mm][1] = *(const f32x4*)(cs + pos_ * 64 + dim0 + 4); \
                tb[buf][mm][2] = *(const f32x4*)(sn + pos_ * 64 + dim0); tb[buf][mm][3] = *(const f32x4*)(sn + pos_ * 64 + dim0 + 4); } } while (0)
            ROT_LD(0, 0);
#pragma unroll
            for (int b = 0; b < 4; ++b) {
                if (b + 1 < 4) ROT_LD(b + 1, (b + 1) & 1);
#pragma unroll
                for (int mm = 0; mm < 2; ++mm) {
                    const int ai = b >> 1, m = (b & 1) * 2 + mm, row = row0 + ai * 128 + m * 16;
                    const f32x4 c0 = tb[b & 1][mm][0], c1 = tb[b & 1][mm][1], s0 = tb[b & 1][mm][2], s1 = tb[b & 1][mm][3];
                    const f32x4 x1a = acc[ai][0][m][0], x1b = acc[ai][0][m][1], x2a = acc[ai][1][m][0], x2b = acc[ai][1][m][1];
                    const f32x4 o1a = (x1a * c0 - x2a * s0) * sc, o1b = (x1b * c1 - x2b * s1) * sc, o2a = (x2a * c0 + x1a * s0) * sc, o2b = (x2b * c1 + x1b * s1) * sc;
                    *(u32x4*)(base + (size_t)row * 1024) = pack8(o1a, o1b);
                    *(u32x4*)(base + (size_t)row * 1024 + 64) = pack8(o2a, o2b);
                }
            }
#undef ROT_LD
        } else if (pn >= 12 && pn < 20) {
            bf16_t* base = UG + 128 * (pn - 12) + cl;
#pragma unroll
            for (int ai = 0; ai < 2; ++ai)
#pragma unroll
                for (int m = 0; m < 4; ++m) {
                    const int row = row0 + ai * 128 + m * 16;
                    const f32x4 ua = gelu4(acc[ai][0][m][0]), ub = gelu4(acc[ai][0][m][1]);
                    const f32x4 ga = acc[ai][1][m][0], gb = acc[ai][1][m][1];
                    *(u32x4*)(base + (size_t)row * 1024) = pack8(ua * ga * sig4(ga), ub * gb * sig4(gb));
                }
        } else if (pn >= 24) {
            bf16_t* rbase = QK + (size_t)(3 + 2 * NSL + sl) * ((size_t)TS * 1024) + 128 * (pn - 24) + cl;
            bf16_t* sbase = QK + (size_t)(3 + 3 * NSL + sl) * ((size_t)TS * 1024) + 128 * (pn - 24) + cl;
#pragma unroll
            for (int ai = 0; ai < 2; ++ai)
#pragma unroll
                for (int m = 0; m < 4; ++m) {
                    const int row = row0 + ai * 128 + m * 16;
                    f32x4 r[2], sg[2];
#pragma unroll
                    for (int n = 0; n < 2; ++n) {
                        const f32x4 b = acc[ai][1][m][n];
                        const f32x4 one = (f32x4){1.0f + __builtin_amdgcn_exp2f(-1.4426950408889634f * b[0]), 1.0f + __builtin_amdgcn_exp2f(-1.4426950408889634f * b[1]),
                                                  1.0f + __builtin_amdgcn_exp2f(-1.4426950408889634f * b[2]), 1.0f + __builtin_amdgcn_exp2f(-1.4426950408889634f * b[3])};
                        sg[n] = (f32x4){__builtin_amdgcn_rcpf(one[0]), __builtin_amdgcn_rcpf(one[1]), __builtin_amdgcn_rcpf(one[2]), __builtin_amdgcn_rcpf(one[3])};
                        r[n] = sig4(acc[ai][0][m][n]) * one;
                    }
                    *(u32x4*)(rbase + (size_t)row * 1024) = pack8(r[0], r[1]);
                    *(u32x4*)(sbase + (size_t)row * 1024) = pack8(sg[0], sg[1]);
                    asm volatile("" ::: "memory");
                }
        } else if (pn < 8) {
            bf16_t* vt = QK + (size_t)TS * 1024;
#pragma unroll
            for (int ai = 0; ai < 2; ++ai)
#pragma unroll
                for (int m = 0; m < 4; ++m) {
                    const int e = ai * 128 + wr * 64 + m * 16 + fr;
#pragma unroll
                    for (int bj = 0; bj < 2; ++bj)
                        *(u32x4*)(vt + (((size_t)(u.pm * 2 + bj) * 4 + (pn - 4)) * 256 + e) * 128 + cl) = pack8(acc[ai][bj][m][0], acc[ai][bj][m][1]);
                }
        } else {
            const int act = pn < 8 ? 0 : pn < 12 ? 1 : pn < 24 ? 2 : 3;
            const int bidx = pn < 8 ? 1 : pn < 12 ? 3 + sl : pn < 24 ? 2 : pn < 28 ? 7 + sl : 9 + sl;
            const int tl = pn < 8 ? pn - 4 : pn < 12 ? pn - 8 : pn < 24 ? pn - 20 : pn < 28 ? pn - 24 : pn - 28;
            bf16_t* base = QK + (size_t)bidx * ((size_t)TS * 1024) + tl * 256 + cl;
#pragma unroll
            for (int ai = 0; ai < 2; ++ai)
#pragma unroll
                for (int m = 0; m < 4; ++m) {
                    const int row = row0 + ai * 128 + m * 16; float ssum = 0.f, ssq = 0.f;
#pragma unroll
                    for (int bj = 0; bj < 2; ++bj) {
                        f32x4 a = acc[ai][bj][m][0], b = acc[ai][bj][m][1];
                        if (act == 1) { a = a * sig4(a); b = b * sig4(b); }
                        else if (act == 2) { a = gelu4(a); b = gelu4(b);
                            ssum += ((a[0] + a[1]) + (a[2] + a[3])) + ((b[0] + b[1]) + (b[2] + b[3]));
                            ssq += ((a[0] * a[0] + a[1] * a[1]) + (a[2] * a[2] + a[3] * a[3])) + ((b[0] * b[0] + b[1] * b[1]) + (b[2] * b[2] + b[3] * b[3])); }
                        else if (act == 3) { a = sig4(a); b = sig4(b); }
                        *(u32x4*)(base + (size_t)row * 1024 + bj * 128) = pack8(a, b);
                    }
                    if (act == 2) {
                        ssum += __shfl_xor(ssum, 16); ssum += __shfl_xor(ssum, 32); ssq += __shfl_xor(ssq, 16); ssq += __shfl_xor(ssq, 32);
                        if (fq == 0) *(f32x2*)(svs + (size_t)row * 32 + tl * 8 + wc * 2) = (f32x2){ssum, ssq};
                    }
                }
        }
    }
};
struct Epi6 {
    static constexpr bool PERM = true;
    const bf16_t* MR; const bf16_t* MS; bf16_t* O;
    __device__ __forceinline__ bool keep(const Unit& u) const { return u.part == 0; }
    __device__ __forceinline__ void operator()(AccT& acc, const Unit& u, int wr, int wc, int fr, int fq) const {
        const int row0 = u.pm * 256 + wr * 64 + fr, col0 = u.pn * 256 + wc * 32 + 8 * fq;
        u32x4 sb[4][2];
#define E6_LD(g) do { _Pragma("unroll") for (int bj = 0; bj < 2; ++bj) { const size_t off_ = (size_t)(row0 + ((g) >> 2) * 128 + ((g) & 3) * 16) * 1024 + col0 + bj * 128; \
            if (u.part == 0) sb[(g) & 3][bj] = *(const u32x4*)(MR + off_); else sb[(g) & 3][bj] = *(const u32x4*)(MS + off_); } } while (0)
        E6_LD(0); E6_LD(1); E6_LD(2);
#pragma unroll
        for (int g = 0; g < 8; ++g) {
            if (g + 3 < 8) E6_LD(g + 3);
            const int ai = g >> 2, m = g & 3;
#pragma unroll
            for (int bj = 0; bj < 2; ++bj) {
                const size_t off = (size_t)(row0 + ai * 128 + m * 16) * 1024 + col0 + bj * 128;
                f32x4 sa, sbv; unpack8(sb[g & 3][bj], sa, sbv);
                if (u.part == 0) {
#pragma unroll
                    for (int j = 0; j < 4; ++j) { acc[ai][bj][m][0][j] *= sa[j]; acc[ai][bj][m][1][j] *= sbv[j]; }
                } else {
                    *(u32x4*)(O + off) = pack8(acc[ai][bj][m][0] * sa, acc[ai][bj][m][1] * sbv);
                }
            }
        }
#undef E6_LD
    }
};
struct EpiStore {
    static constexpr bool PERM = true;
    bf16_t* O;
    __device__ __forceinline__ bool keep(const Unit&) const { return false; }
    __device__ __forceinline__ void operator()(AccT& acc, const Unit& u, int wr, int wc, int fr, int fq) const {
        const int row0 = u.pm * 256 + wr * 64 + fr, col0 = u.pn * 256 + wc * 32 + 8 * fq;
#pragma unroll
        for (int ai = 0; ai < 2; ++ai)
#pragma unroll
            for (int m = 0; m < 4; ++m)
#pragma unroll
                for (int bj = 0; bj < 2; ++bj)
                    *(u32x4*)(O + (size_t)(row0 + ai * 128 + m * 16) * 1024 + col0 + bj * 128) = pack8(acc[ai][bj][m][0], acc[ai][bj][m][1]);
    }
};
struct Epi7 {
    static constexpr bool PERM = false;
    const bf16_t* hb; const float* rs0; const float* gm; bf16_t* X1B; float* rsq; int tok0;
    __device__ __forceinline__ bool keep(const Unit&) const { return false; }
    __device__ __forceinline__ void operator()(AccT& acc, const Unit& u, int wr, int wc, int fr, int fq) const {
        const int row0 = u.pm * 256 + wr * 64 + fr, col0 = u.pn * 256 + wc * 32 + 4 * fq;
        f32x4 ig[2][2];
#pragma unroll
        for (int bj = 0; bj < 2; ++bj)
#pragma unroll
            for (int n = 0; n < 2; ++n) { const f32x4 g4 = *(const f32x4*)(gm + col0 + bj * 128 + n * 16);
                ig[bj][n] = (f32x4){__builtin_amdgcn_rcpf(g4[0]), __builtin_amdgcn_rcpf(g4[1]), __builtin_amdgcn_rcpf(g4[2]), __builtin_amdgcn_rcpf(g4[3])}; }
        u32x2 xb[4][2][2]; float rsv[4];
#define E7_LD(g) do { const size_t tr_ = (size_t)tok0 + row0 + ((g) >> 2) * 128 + ((g) & 3) * 16; rsv[(g) & 3] = rs0[tr_]; \
            _Pragma("unroll") for (int bj = 0; bj < 2; ++bj) _Pragma("unroll") for (int n = 0; n < 2; ++n) \
            xb[(g) & 3][bj][n] = *(const u32x2*)(hb + tr_ * 1024 + col0 + bj * 128 + n * 16); } while (0)
        E7_LD(0); E7_LD(1); E7_LD(2);
#pragma unroll
        for (int g = 0; g < 8; ++g) {
            if (g + 3 < 8) E7_LD(g + 3);
            const int ai = g >> 2, m = g & 3, row = row0 + ai * 128 + m * 16; const size_t tok = (size_t)tok0 + row; float ss = 0.f;
            const float sr = rsv[g & 3];
#pragma unroll
            for (int bj = 0; bj < 2; ++bj)
#pragma unroll
                for (int n = 0; n < 2; ++n) {
                    const int col = col0 + bj * 128 + n * 16;
                    const f32x4 o = unpack4(xb[g & 3][bj][n]) * sr * ig[bj][n] + acc[ai][bj][m][n];
                    *(u32x2*)(X1B + (size_t)row * 1024 + col) = pack4(o);
                    ss += (o[0] * o[0] + o[1] * o[1]) + (o[2] * o[2] + o[3] * o[3]);
                }
            ss += __shfl_xor(ss, 16); ss += __shfl_xor(ss, 32);
            if (fq == 0) rsq[tok * 16 + u.pn * 4 + wc] = ss;
        }
#undef E7_LD
    }
};
struct Epi8 {
    static constexpr bool PERM = false;
    const bf16_t* X1B; bf16_t* X2B; const bf16_t* PP; const float* rsq1; float* rsq2; int tok0;
    __device__ __forceinline__ bool keep(const Unit&) const { return false; }
    __device__ __forceinline__ void operator()(AccT& acc, const Unit& u, int wr, int wc, int fr, int fq) const {
        const int row0 = u.pm * 256 + wr * 64 + fr, col0 = u.pn * 256 + wc * 32 + 4 * fq;
        float rs[8];
        {   f32x4 sl[8];
#pragma unroll
            for (int r = 0; r < 8; ++r) sl[r] = *(const f32x4*)(rsq1 + ((size_t)tok0 + row0 + (r >> 2) * 128 + (r & 3) * 16) * 16 + 4 * fq);
#pragma unroll
            for (int r = 0; r < 8; ++r) { float t = (sl[r][0] + sl[r][1]) + (sl[r][2] + sl[r][3]); t += __shfl_xor(t, 16); t += __shfl_xor(t, 32); rs[r] = t; } }
        u32x2 pb[4][2][2], xb[4][2][2];
#define E8_LD(g) do { _Pragma("unroll") for (int bj = 0; bj < 2; ++bj) _Pragma("unroll") for (int n = 0; n < 2; ++n) { \
            const size_t off_ = (size_t)(row0 + ((g) >> 2) * 128 + ((g) & 3) * 16) * 1024 + col0 + bj * 128 + n * 16; \
            pb[(g) & 3][bj][n] = *(const u32x2*)(PP + off_); xb[(g) & 3][bj][n] = *(const u32x2*)(X1B + off_); } } while (0)
        E8_LD(0); E8_LD(1); E8_LD(2);
#pragma unroll
        for (int g = 0; g < 8; ++g) {
            if (g + 3 < 8) E8_LD(g + 3);
            const int ai = g >> 2, m = g & 3, row = row0 + ai * 128 + m * 16; const size_t tok = (size_t)tok0 + row; float ss = 0.f;
            const float rstd = rsqrtf(rs[g] * (1.0f / 1024.0f) + 1e-6f);
#pragma unroll
            for (int bj = 0; bj < 2; ++bj)
#pragma unroll
                for (int n = 0; n < 2; ++n) {
                    const size_t off = (size_t)row * 1024 + col0 + bj * 128 + n * 16;
                    const f32x4 gt = sig4(acc[ai][bj][m][n] * rstd);
                    const f32x4 o = unpack4(xb[g & 3][bj][n]) + gt * unpack4(pb[g & 3][bj][n]);
                    *(u32x2*)(X2B + off) = pack4(o);
                    ss += (o[0] * o[0] + o[1] * o[1]) + (o[2] * o[2] + o[3] * o[3]);
                }
            ss += __shfl_xor(ss, 16); ss += __shfl_xor(ss, 32);
            if (fq == 0) rsq2[tok * 16 + u.pn * 4 + wc] = ss;
        }
#undef E8_LD
    }
};

__device__ __forceinline__ int srccol_win(int np) {
    const int pn = np >> 8, L = np & 255;
    if (pn < 4) { const int isk = pn >> 1, t = pn & 1, half = L >> 7, i = L & 127, head = 2 * t + (i >> 6), dim = (i & 63) + 64 * half; return isk * 512 + head * 128 + dim; }
    if (pn < 8) return 1024 + (pn - 4) * 256 + L;
    if (pn < 12) return 2048 + (pn - 8) * 256 + L;
    if (pn < 20) { const int t = pn - 12; return L < 128 ? 3072 + 128 * t + L : 5120 + 128 * t + (L - 128); }
    if (pn < 24) return 4096 + (pn - 20) * 256 + L;
    { const int t = pn - 24; return L < 128 ? 6144 + 128 * t + L : 7168 + 128 * t + (L - 128); }
}
__device__ __forceinline__ void p0_transpose(LAS float* tile, const float* src, int ldsrc, int k0, int c0, bf16_t* dst, int ldk, int n0, const float* kscale, int tid) {
#pragma unroll
    for (int p = 0; p < 2; ++p) {
        const int r = (tid >> 4) + 32 * p, c4 = (tid & 15) * 4;
        const f32x4 v = *(const f32x4*)(src + (size_t)(k0 + r) * ldsrc + c0 + c4);
        const float s = kscale ? kscale[k0 + r] : 1.0f;
        tile[r * 65 + c4 + 0] = v[0] * s; tile[r * 65 + c4 + 1] = v[1] * s; tile[r * 65 + c4 + 2] = v[2] * s; tile[r * 65 + c4 + 3] = v[3] * s;
    }
    __syncthreads();
    {
        const int n = tid >> 3, kc = (tid & 7) * 8;
        u32x4 w;
        w.x = cvt_pk_bf16(tile[(kc + 0) * 65 + n], tile[(kc + 1) * 65 + n]); w.y = cvt_pk_bf16(tile[(kc + 2) * 65 + n], tile[(kc + 3) * 65 + n]);
        w.z = cvt_pk_bf16(tile[(kc + 4) * 65 + n], tile[(kc + 5) * 65 + n]); w.w = cvt_pk_bf16(tile[(kc + 6) * 65 + n], tile[(kc + 7) * 65 + n]);
        *(u32x4*)(dst + (size_t)(n0 + n) * ldk + k0 + kc) = w;
    }
    __syncthreads();
}

struct Params { const float *x, *p, *w_in, *w_ret, *w_sgu, *w_out, *sws, *sbs, *wpg, *wpp, *gm, *gp, *gf; float* out; unsigned char* ws; };

__device__ __forceinline__ void phase0(const Params& P, LAS unsigned char* lds, int tid, int wid, int lane) {
    unsigned char* ws = P.ws;
    const int G = gridDim.x, bx = blockIdx.x;
    LAS float* tile = (LAS float*)lds;
    for (int idx = bx; idx < 3136; idx += G) {
        if (idx < 2048) { const int kt = idx & 15, ntl = idx >> 4; p0_transpose(tile, P.w_in, 8192, kt * 64, srccol_win(ntl * 64), (bf16_t*)(ws + WS_WIN), 1024, ntl * 64, nullptr, tid); }
        else if (idx < 3072) { const int w = (idx - 2048) >> 8, r = (idx - 2048) & 255, kt = r & 15, ntl = r >> 4;
            const float* src = w == 0 ? P.w_ret : w == 1 ? P.w_sgu : w == 2 ? P.w_out : P.wpg;
            bf16_t* dst = (bf16_t*)(ws + (w == 0 ? WS_WR : w == 1 ? WS_WS : w == 2 ? WS_WO : WS_WG));
            p0_transpose(tile, src, 1024, kt * 64, ntl * 64, dst, 1024, ntl * 64, w == 3 ? P.gp : nullptr, tid); }
        else { const int r = idx - 3072, kt = r & 3, ntl = r >> 2; p0_transpose(tile, P.wpp, 1024, kt * 64, ntl * 64, (bf16_t*)(ws + WS_WPP), 256, ntl * 64, nullptr, tid); }
    }
    const int gt = bx * NTHR + tid, gn = G * NTHR;
    for (int i = gt; i < 4 * 128 * 128; i += gn) { const int r = (i >> 7) & 127, c = i & 127; const float v = c <= r ? P.sws[i] : 0.0f; ((bf16_t*)(ws + WS_WC))[i] = (bf16_t)(cvt_pk_bf16(v, 0.f) & 0xffffu); }
    for (int i = gt; i < 4096 * 64; i += gn) {
        const int pos = i >> 6, j = i & 63;
        const float inv = exp2f(-(float)j * (13.287712379549449f / 64.0f));
        const float ang = (float)pos * inv;
        const double a = (double)ang; const double nrev = rint(a * 0.15915494309189535); const float r = (float)(a - nrev * 6.283185307179586);
        ((float*)(ws + WS_COS))[i] = cosf(r); ((float*)(ws + WS_SIN))[i] = sinf(r);
    }
    for (size_t i = (size_t)gt * 8; i < (size_t)T_ALL * 256; i += (size_t)gn * 8) {
        const f32x4 a = *(const f32x4*)(P.p + i), b = *(const f32x4*)(P.p + i + 4);
        *(u32x4*)((bf16_t*)(ws + WS_PB) + i) = pack8(a, b);
    }
    {
        f32x4 gv[4];
#pragma unroll
        for (int i = 0; i < 4; ++i) gv[i] = *(const f32x4*)(P.gm + lane * 4 + 256 * i);
        for (int row = bx * 8 + wid; row < T_ALL; row += G * 8) {
            const float* xr = P.x + (size_t)row * 1024; f32x4 v[4]; float ss = 0.f;
#pragma unroll
            for (int i = 0; i < 4; ++i) { v[i] = *(const f32x4*)(xr + lane * 4 + 256 * i); ss += (v[i][0] * v[i][0] + v[i][1] * v[i][1]) + (v[i][2] * v[i][2] + v[i][3] * v[i][3]); }
            ss = wave_sum(ss);
            const float rstd = rsqrtf(ss * (1.0f / 1024.0f) + 1e-6f);
            if (lane == 0) ((float*)(ws + WS_RS0))[row] = sqrtf(ss * (1.0f / 1024.0f) + 1e-6f);
            bf16_t* hr = (bf16_t*)(ws + WS_H) + (size_t)row * 1024;
#pragma unroll
            for (int i = 0; i < 4; ++i) *(u32x2*)(hr + lane * 4 + 256 * i) = pack4(v[i] * rstd * gv[i]);
        }
    }
}

template <int ROWS, int COLS> struct TileRegs { u32x4 v[ROWS * (COLS / 8) / NTHR]; };
template <int ROWS, int COLS>
__device__ __forceinline__ void tile_load(TileRegs<ROWS, COLS>& t, const bf16_t* src, size_t gp, int tid) {
    constexpr int CPR = COLS / 8, IT = ROWS * CPR / NTHR;
#pragma unroll
    for (int i = 0; i < IT; ++i) { const int c = tid + i * NTHR, r = c / CPR, ch = c % CPR; t.v[i] = *(const u32x4*)(src + (size_t)r * gp + ch * 8); }
}
template <int ROWS, int COLS>
__device__ __forceinline__ void tile_store_b128(const TileRegs<ROWS, COLS>& t, LAS unsigned char* dst, int lp, int tid) {
    constexpr int CPR = COLS / 8, IT = ROWS * CPR / NTHR;
#pragma unroll
    for (int i = 0; i < IT; ++i) { const int c = tid + i * NTHR, r = c / CPR, ch = c % CPR; *(LAS u32x4*)(dst + r * lp + ch * 16) = t.v[i]; }
}
template <int ROWS, int COLS>
__device__ __forceinline__ void tile_store_b32(const TileRegs<ROWS, COLS>& t, LAS unsigned char* dst, int lp, int tid) {
    constexpr int CPR = COLS / 8, IT = ROWS * CPR / NTHR;
#pragma unroll
    for (int i = 0; i < IT; ++i) { const int c = tid + i * NTHR, r = c / CPR, ch = c % CPR; LAS unsigned* d = (LAS unsigned*)(dst + r * lp + ch * 16); d[0] = t.v[i].x; d[1] = t.v[i].y; d[2] = t.v[i].z; d[3] = t.v[i].w; }
}
__device__ __forceinline__ void gather8(const LAS unsigned char* base, int pitch, int r0, int col, unsigned short (&o)[8]) {
    const LAS unsigned char* p = base + r0 * pitch + col * 2;
#pragma unroll
    for (int j = 0; j < 8; ++j) o[j] = *(const LAS unsigned short*)(p + j * pitch);
}
__device__ __forceinline__ bf16x8 mk8(const unsigned short (&o)[8]) { bf16x8 r;
#pragma unroll
    for (int j = 0; j < 8; ++j) r[j] = (short)o[j];
    return r; }

__device__ __forceinline__ void p2_unit(LAS unsigned char* lds, const bf16_t* QK, const bf16_t* V, bf16_t* KV, int unit, int tid, int wid, int lane) {
    const int fr = lane & 15, fq = lane >> 4, h = unit & 3; const size_t tok0 = (size_t)(unit >> 2) * 128; const float lg = lgam(h);
    LAS unsigned char* sK = lds; LAS unsigned char* sV = lds + 33280;
    TileRegs<128, 128> tk; TileRegs<256, 128> tv;
    asm volatile("" : "+v"(tid));
    tile_load(tk, QK + tok0 * 1024 + 512 + h * 128, 1024, tid);
    tile_load(tv, V + (size_t)unit * 32768, 128, tid);
    __syncthreads();
    tile_store_b32(tk, sK, 260, tid);
    tile_store_b128(tv, sV, 272, tid);
    __syncthreads();
    f32x4 acc[2][8];
#pragma unroll
    for (int a = 0; a < 2; ++a)
#pragma unroll
        for (int b = 0; b < 8; ++b) acc[a][b] = (f32x4){0.f, 0.f, 0.f, 0.f};
#pragma unroll
    for (int ks = 0; ks < 4; ++ks) {
        const int j0 = 32 * ks + 8 * fq;
        bf16x8 vf[2];
#pragma unroll
        for (int e2 = 0; e2 < 2; ++e2) {
            const u32x4 vr = *(const LAS u32x4*)(sV + (16 * (2 * wid + e2) + fr) * 272 + j0 * 2);
            u32x4 w;
            w.x = cvt_pk_bf16(bf_lo(vr.x) * fexp(lg * (float)(127 - j0 - 0)), bf_hi(vr.x) * fexp(lg * (float)(127 - j0 - 1)));
            w.y = cvt_pk_bf16(bf_lo(vr.y) * fexp(lg * (float)(127 - j0 - 2)), bf_hi(vr.y) * fexp(lg * (float)(127 - j0 - 3)));
            w.z = cvt_pk_bf16(bf_lo(vr.z) * fexp(lg * (float)(127 - j0 - 4)), bf_hi(vr.z) * fexp(lg * (float)(127 - j0 - 5)));
            w.w = cvt_pk_bf16(bf_lo(vr.w) * fexp(lg * (float)(127 - j0 - 6)), bf_hi(vr.w) * fexp(lg * (float)(127 - j0 - 7)));
            vf[e2] = __builtin_bit_cast(bf16x8, w);
        }
#pragma unroll
        for (int db = 0; db < 8; ++db) {
            unsigned short o[8]; gather8(sK, 260, j0, 16 * db + fr, o);
            const bf16x8 kf = mk8(o);
#pragma unroll
            for (int e2 = 0; e2 < 2; ++e2) acc[e2][db] = __builtin_amdgcn_mfma_f32_16x16x32_bf16(kf, vf[e2], acc[e2][db], 0, 0, 0);
        }
    }
    bf16_t* dst = KV + (size_t)unit * 32768;
#pragma unroll
    for (int e2 = 0; e2 < 2; ++e2)
#pragma unroll
        for (int db = 0; db < 8; ++db) *(u32x2*)(dst + (16 * (2 * wid + e2) + fr) * 128 + 16 * db + 4 * fq) = pack4(acc[e2][db]);
}

__device__ __forceinline__ void p4_unit(LAS unsigned char* lds, const bf16_t* QK, const bf16_t* V, const bf16_t* PREV, const bf16_t* RG, bf16_t* RO, int unit, int tid, int wid, int lane) {
    const int fr = lane & 15, fq = lane >> 4, h = unit & 3; const size_t tok0 = (size_t)(unit >> 2) * 128; const float lg = lgam(h);
    LAS unsigned char* sK = lds; LAS unsigned char* sP = lds + 34816;
    TileRegs<128, 128> tk; TileRegs<256, 128> tp; TileRegs<256, 128> tv;
    asm volatile("" : "+v"(tid));
    tile_load(tk, QK + tok0 * 1024 + 512 + h * 128, 1024, tid);
    tile_load(tp, PREV + (size_t)unit * 32768, 128, tid);
    bf16x8 qf[4];
    { const bf16_t* qrow = QK + (tok0 + 16 * wid + fr) * 1024 + h * 128 + 8 * fq;
#pragma unroll
      for (int ks = 0; ks < 4; ++ks) qf[ks] = *(const bf16x8*)(qrow + 32 * ks); }
    __syncthreads();
    tile_store_b128(tk, sK, 272, tid);
    tile_store_b128(tp, sP, 272, tid);
    asm volatile("" : "+v"(tid));
    tile_load(tv, V + (size_t)unit * 32768, 128, tid);
    __syncthreads();
    f32x4 sacc[8];
#pragma unroll
    for (int jb = 0; jb < 8; ++jb) {
        sacc[jb] = (f32x4){0.f, 0.f, 0.f, 0.f};
        if (jb <= wid) {
#pragma unroll
            for (int ks = 0; ks < 4; ++ks) { const bf16x8 kf = *(const LAS bf16x8*)(sK + (16 * jb + fr) * 272 + (32 * ks + 8 * fq) * 2); sacc[jb] = __builtin_amdgcn_mfma_f32_16x16x32_bf16(kf, qf[ks], sacc[jb], 0, 0, 0); }
        }
    }
    f32x4 acc[16];
    const int i = 16 * wid + fr; const float xi = fexp(lg * (float)(i + 1));
#pragma unroll
    for (int eb = 0; eb < 16; ++eb) {
        f32x4 a = (f32x4){0.f, 0.f, 0.f, 0.f};
#pragma unroll
        for (int ks = 0; ks < 4; ++ks) { const bf16x8 pf = *(const LAS bf16x8*)(sP + (16 * eb + fr) * 272 + (32 * ks + 8 * fq) * 2); a = __builtin_amdgcn_mfma_f32_16x16x32_bf16(pf, qf[ks], a, 0, 0, 0); }
        acc[eb] = a * xi;
    }
    bf16x8 pfr[4];
#pragma unroll
    for (int ks = 0; ks < 4; ++ks) {
        float pv[8];
#pragma unroll
        for (int hf = 0; hf < 2; ++hf)
#pragma unroll
            for (int r = 0; r < 4; ++r) { const int jb = 2 * ks + hf, j = 16 * jb + 4 * fq + r; pv[4 * hf + r] = (j <= i) ? sacc[jb][r] * fexp(lg * (float)(i - j)) : 0.0f; }
        u32x4 w; w.x = cvt_pk_bf16(pv[0], pv[1]); w.y = cvt_pk_bf16(pv[2], pv[3]); w.z = cvt_pk_bf16(pv[4], pv[5]); w.w = cvt_pk_bf16(pv[6], pv[7]);
        pfr[ks] = __builtin_bit_cast(bf16x8, w);
    }
    __syncthreads();
    asm volatile("" : "+v"(tid));
    tile_store_b128(tv, lds, 272, tid);
    __syncthreads();
#pragma unroll
    for (int ks = 0; ks < 4; ++ks) {
        if (2 * ks <= wid) {
#pragma unroll
            for (int eb = 0; eb < 16; ++eb) {
                const LAS unsigned char* p = lds + (16 * eb + fr) * 272 + (32 * ks + 4 * fq) * 2;
                const u32x2 lo = *(const LAS u32x2*)p, hi = *(const LAS u32x2*)(p + 32);
                const u32x4 w = (u32x4){lo.x, lo.y, hi.x, hi.y};
                acc[eb] = __builtin_amdgcn_mfma_f32_16x16x32_bf16(__builtin_bit_cast(bf16x8, w), pfr[ks], acc[eb], 0, 0, 0);
            }
        }
    }
    float s = 0.f;
#pragma unroll
    for (int eb = 0; eb < 16; ++eb) s += (acc[eb][0] + acc[eb][1]) + (acc[eb][2] + acc[eb][3]);
    s += __shfl_xor(s, 16); s += __shfl_xor(s, 32);
    const float mu = s * (1.0f / 256.0f); float q = 0.f;
#pragma unroll
    for (int eb = 0; eb < 16; ++eb) { const f32x4 d = acc[eb] - mu; q += (d[0] * d[0] + d[1] * d[1]) + (d[2] * d[2] + d[3] * d[3]); }
    q += __shfl_xor(q, 16); q += __shfl_xor(q, 32);
    const float rstd = rsqrtf(q * (1.0f / 256.0f) + 1e-5f);
    const bf16_t* rgrow = RG + (tok0 + i) * 1024 + h * 256 + 4 * fq; bf16_t* rorow = RO + (tok0 + i) * 1024 + h * 256 + 4 * fq;
    u32x2 gl[16];
#pragma unroll
    for (int eb = 0; eb < 16; ++eb) gl[eb] = *(const u32x2*)(rgrow + 16 * eb);
#pragma unroll
    for (int eb = 0; eb < 16; ++eb) *(u32x2*)(rorow + 16 * eb) = pack4((acc[eb] - mu) * rstd * unpack4(gl[eb]));
}

__device__ __forceinline__ void p5_unit(LAS unsigned char* lds, const bf16_t* SV, const float* SVS, bf16_t* UO, const bf16_t* WC, const float* bias, int chunk, int tid, int wid, int lane) {
    const int fr = lane & 15, fq = lane >> 4; const size_t tok0 = (size_t)chunk * 128;
    LAS unsigned char* sW = lds; LAS unsigned char* sV = lds + 34816; LAS float* st = (LAS float*)(lds + 34816 + 66048);
    __syncthreads();
    {
        const int r = 16 * wid + (lane >> 2);
        const float* sp = SVS + (tok0 + r) * 32 + (lane & 3) * 8;
        const f32x4 p0 = *(const f32x4*)sp, p1 = *(const f32x4*)(sp + 4);
        float sm = (p0[0] + p0[2]) + (p1[0] + p1[2]), sq = (p0[1] + p0[3]) + (p1[1] + p1[3]);
        sm += __shfl_xor(sm, 1); sm += __shfl_xor(sm, 2); sq += __shfl_xor(sq, 1); sq += __shfl_xor(sq, 2);
        const float mu = sm * (1.0f / 1024.0f), var = fmaxf(sq * (1.0f / 1024.0f) - mu * mu, 0.0f);
        if ((lane & 3) == 0) { st[2 * r] = mu; st[2 * r + 1] = rsqrtf(var + 1e-5f); }
    }
    TileRegs<128, 128> tw; TileRegs<128, 256> tv;
    { int tg = tid; asm volatile("" : "+v"(tg)); tile_load(tw, WC, 128, tg); tile_load(tv, SV + tok0 * 1024, 1024, tg); }
    for (int g = 0; g < 4; ++g) {
        __syncthreads();
        tile_store_b128(tw, sW, 272, tid);
#pragma unroll
        for (int i = 0; i < 8; ++i) {
            const int c = tid + i * NTHR, r = c >> 5, ch = c & 31;
            f32x4 a, b; unpack8(tv.v[i], a, b);
            const float mu = st[2 * r], rs = st[2 * r + 1];
            const u32x4 w = pack8((a - mu) * rs, (b - mu) * rs);
            LAS unsigned* d = (LAS unsigned*)(sV + r * 516 + ch * 16); d[0] = w.x; d[1] = w.y; d[2] = w.z; d[3] = w.w;
        }
        __syncthreads();
        int tg = tid; asm volatile("" : "+v"(tg));
        if (g < 3) { tile_load(tw, WC + (g + 1) * 16384, 128, tg); tile_load(tv, SV + tok0 * 1024 + (g + 1) * 256, 1024, tg); }
        u32x2 ul[8][2]; float bvl[8];
        {   const int lfr = tg & 15, lfq = (tg & 63) >> 4;
#pragma unroll
            for (int ib = 0; ib < 8; ++ib) { bvl[ib] = bias[g * 128 + 16 * ib + lfr];
#pragma unroll
                for (int c2 = 0; c2 < 2; ++c2) ul[ib][c2] = *(const u32x2*)(UO + (tok0 + 16 * ib + lfr) * 1024 + g * 256 + 16 * (2 * wid + c2) + 4 * lfq); } }
        f32x4 acc[8][2];
#pragma unroll
        for (int a = 0; a < 8; ++a)
#pragma unroll
            for (int b = 0; b < 2; ++b) acc[a][b] = (f32x4){0.f, 0.f, 0.f, 0.f};
#pragma unroll
        for (int ks = 0; ks < 4; ++ks) {
            bf16x8 vf[2];
#pragma unroll
            for (int c2 = 0; c2 < 2; ++c2) { unsigned short o[8]; gather8(sV, 516, 32 * ks + 8 * fq, 16 * (2 * wid + c2) + fr, o); vf[c2] = mk8(o); }
#pragma unroll
            for (int ib = 0; ib < 8; ++ib) {
                if (ib >= 2 * ks) {
                    const bf16x8 wf = *(const LAS bf16x8*)(sW + (16 * ib + fr) * 272 + (32 * ks + 8 * fq) * 2);
#pragma unroll
                    for (int c2 = 0; c2 < 2; ++c2) acc[ib][c2] = __builtin_amdgcn_mfma_f32_16x16x32_bf16(vf[c2], wf, acc[ib][c2], 0, 0, 0);
                }
            }
        }
#pragma unroll
        for (int ib = 0; ib < 8; ++ib)
#pragma unroll
            for (int c2 = 0; c2 < 2; ++c2)
                *(u32x2*)(UO + (tok0 + 16 * ib + fr) * 1024 + g * 256 + 16 * (2 * wid + c2) + 4 * fq) = pack4((acc[ib][c2] + bvl[ib]) * unpack4(ul[ib][c2]));
    }
}

#define XB_TMO      128
#define XB_XCNT(j)  (256  + 64 * (j))
#define XB_XSUB(j)  (1280 + 64 * (j))
#define XB_XGEN(j)  (2304 + 64 * (j))
#define XB_TOP      3328
#define XB_TOPGEN   3392
#define XCD_BAR_WORDS 3456
#define XB_SPIN_CAP (1u << 22)
__device__ __forceinline__ unsigned xb_ld(unsigned* p)              { return __hip_atomic_load(p, __ATOMIC_RELAXED, __HIP_MEMORY_SCOPE_AGENT); }
__device__ __forceinline__ unsigned xb_add(unsigned* p, unsigned v) { return __hip_atomic_fetch_add(p, v, __ATOMIC_RELAXED, __HIP_MEMORY_SCOPE_AGENT); }
__device__ __forceinline__ unsigned xb_xcc_id() { return (unsigned)__builtin_amdgcn_s_getreg((3 << 11) | 20) & 0xFu; }
#define XB_SPIN(cond, bar) do { unsigned _sp = 0; while (cond) { __builtin_amdgcn_s_sleep(1); \
    if ((++_sp & 255u) == 0u) { if (xb_ld(&(bar)[XB_TMO])) break; if (_sp > XB_SPIN_CAP) { atomicAdd(&(bar)[XB_TMO], 1u); break; } } } } while (0)
struct XcdBarrier { unsigned* bar; unsigned x; volatile LAS unsigned* st; };
__device__ __forceinline__ XcdBarrier xcd_barrier_post(unsigned* bar, volatile LAS unsigned* st) {
    XcdBarrier b; b.bar = bar; b.x = xb_xcc_id(); b.st = st;
    if (threadIdx.x == 0) (void)xb_add(&bar[XB_XCNT(b.x)], 1u);
    return b;
}
__device__ __forceinline__ void xcd_barrier_complete(unsigned* bar, unsigned x, unsigned& nloc, unsigned& nx) {
    const unsigned G = gridDim.x * gridDim.y * gridDim.z;
    unsigned sum, cnt, mine, sp = 0u;
    for (;;) {
        sum = 0u; cnt = 0u; mine = 0u;
#pragma nounroll
        for (unsigned j = 0; j < 16; ++j) { const unsigned c = xb_ld(&bar[XB_XCNT(j)]); sum += c; cnt += (c > 0u) ? 1u : 0u; mine = (j == x) ? c : mine; }
        if (sum == G) break;
        __builtin_amdgcn_s_sleep(1);
        if ((++sp & 255u) == 0u) { if (xb_ld(&bar[XB_TMO])) break; if (sp > XB_SPIN_CAP) { atomicAdd(&bar[XB_TMO], 1u); break; } }
    }
    nloc = mine > 0u ? mine : 1u; nx = cnt > 0u ? cnt : 1u;
}
__device__ __forceinline__ void xcd_barrier(const XcdBarrier& b) {
    asm volatile("s_waitcnt vmcnt(0)" ::: "memory");
    __syncthreads();
    if (threadIdx.x == 0) {
        unsigned* bar = b.bar;
        __builtin_amdgcn_s_waitcnt(0);
        unsigned nloc = b.st[0], nx = b.st[1];
        if (nloc == 0u) { xcd_barrier_complete(bar, b.x, nloc, nx); b.st[0] = nloc; b.st[1] = nx; }
        const unsigned old = xb_add(&bar[XB_XSUB(b.x)], 1u);
        const unsigned gen = old / nloc;
        if (old + 1u == (gen + 1u) * nloc) {
            __builtin_amdgcn_fence(__ATOMIC_RELEASE, "agent");
            asm volatile("s_waitcnt vmcnt(0)" ::: "memory");
            const unsigned og = xb_add(&bar[XB_TOP], 1u);
            const unsigned tg = og / nx;
            if (og + 1u == (tg + 1u) * nx) xb_add(&bar[XB_TOPGEN], 1u);
            else XB_SPIN(xb_ld(&bar[XB_TOPGEN]) == tg, bar);
            __builtin_amdgcn_fence(__ATOMIC_ACQUIRE, "agent");
            xb_add(&bar[XB_XGEN(b.x)], 1u);
            asm volatile("s_waitcnt vmcnt(0)" ::: "memory");
        } else {
            XB_SPIN(xb_ld(&bar[XB_XGEN(b.x)]) == gen, bar);
            __builtin_amdgcn_fence(__ATOMIC_ACQUIRE, "agent");
            asm volatile("s_waitcnt vmcnt(0)" ::: "memory");
        }
    }
    __syncthreads();
}

#if defined(EXPM) && (EXPM & 64)
#define GSYNC() do { xcd_barrier(xbar); xcd_barrier(xbar); } while (0)
#else
#define GSYNC() xcd_barrier(xbar)
#endif
#define FRESH_IDS int tid_ = threadIdx.x; asm volatile("" : "+v"(tid_)); const int tid = tid_, wid = __builtin_amdgcn_readfirstlane(tid >> 6), lane = tid & 63; (void)wid; (void)lane;
__global__ void __launch_bounds__(NTHR, 2) mega(Params P) {
    extern __shared__ __attribute__((aligned(16))) unsigned char lds_raw[];
    LAS unsigned char* lds = (LAS unsigned char*)lds_raw;
    cg::grid_group grid = cg::this_grid();
    const int G = gridDim.x, bx = blockIdx.x;
    unsigned char* ws = P.ws;
    bf16_t* const WIN = (bf16_t*)(ws + WS_WIN); bf16_t* const WR = (bf16_t*)(ws + WS_WR); bf16_t* const WSG = (bf16_t*)(ws + WS_WS); bf16_t* const WO = (bf16_t*)(ws + WS_WO);
    bf16_t* const WG = (bf16_t*)(ws + WS_WG); bf16_t* const WPP = (bf16_t*)(ws + WS_WPP); bf16_t* const WC = (bf16_t*)(ws + WS_WC);
    float* const RSQ1 = (float*)(ws + WS_SV); float* const RSQ2 = (float*)(ws + WS_SV + 8 * MiB);
    bf16_t* const H = (bf16_t*)(ws + WS_H); bf16_t* const PB = (bf16_t*)(ws + WS_PB);
    bf16_t* const QK = (bf16_t*)(ws + WS_QK); bf16_t* const V = (bf16_t*)(ws + WS_V); bf16_t* const SV = (bf16_t*)(ws + WS_SV);
    bf16_t* const RG2 = (bf16_t*)(ws + WS_RG2); bf16_t* const UG2 = (bf16_t*)(ws + WS_UG2); bf16_t* const MR2 = (bf16_t*)(ws + WS_MR2); bf16_t* const MS2 = (bf16_t*)(ws + WS_MS2);
    bf16_t* const PREV = (bf16_t*)P.out;
    bf16_t* const MERGED = (bf16_t*)P.out; bf16_t* const X2B = H; bf16_t* const X1B = QK;
    bf16_t* const PP = (bf16_t*)(ws + WS_PP);
    volatile LAS unsigned* xst = (volatile LAS unsigned*)(lds + LDS_STAGE);
    if (threadIdx.x < 4) xst[threadIdx.x] = 0u;
    __syncthreads();
    const XcdBarrier xbar = xcd_barrier_post((unsigned*)(ws + WS_BAR), xst);

    { FRESH_IDS phase0(P, lds, tid, wid, lane); }
    if (P.ws == nullptr) grid.sync();

    for (int sl = 0; sl < NSL; ++sl) {
        const int tokb = sl * TS;
        bf16_t* const RG = RG2 + (size_t)tokb * 1024; bf16_t* const UG = UG2 + (size_t)tokb * 1024;
        GSYNC();
        {
            pg8::Src1V g{H + (size_t)tokb * 1024, WIN, 1024}; pg8::StaticOrder S; S.init(TS, 8192, G, bx);
            Epi1 E{QK, UG, (const float*)(ws + WS_COS), (const float*)(ws + WS_SIN), sl, (float*)((unsigned char*)P.out + 64 * MiB)};
            pg8::gemm_phase(lds, g, 1024, S, E);
        }
        GSYNC();
        { FRESH_IDS for (int u = bx; u < BSL * 32 * 4; u += G) p2_unit(lds, QK, V, PREV, u, tid, wid, lane); }
        { FRESH_IDS for (int c = bx; c < BSL * 32; c += G) p5_unit(lds, SV, (const float*)((unsigned char*)P.out + 64 * MiB), UG, WC, P.sbs, c, tid, wid, lane); }
        GSYNC();
        { FRESH_IDS
        for (int it = bx * NTHR + tid; it < BSL * 4 * 256 * 32; it += G * NTHR) {
            const int d4 = it & 31, e = (it >> 5) & 255, h = (it >> 13) & 3, bl = it >> 15;
            const float cd = fexp(128.0f * lgam(h));
            f32x4 run = (f32x4){0.f, 0.f, 0.f, 0.f};
            const size_t base = ((size_t)(bl * 32) * 4 + h) * 32768 + e * 128 + d4 * 4;
#pragma unroll 8
            for (int n = 0; n < 32; ++n) {
                const size_t o = base + (size_t)n * 4 * 32768;
                const f32x4 kv = unpack4(*(const u32x2*)(PREV + o));
                *(u32x2*)(PREV + o) = pack4(run);
                run = kv + run * cd;
            }
        } }
        GSYNC();
        { FRESH_IDS for (int u = bx; u < BSL * 32 * 4; u += G) p4_unit(lds, QK, V, PREV, RG, RG, u, tid, wid, lane); }
    }
    GSYNC();
    {
        pg8::Src2 g{RG2, WR, (long)((const char*)UG2 - (const char*)RG2), (long)((const char*)WSG - (const char*)WR), 1024}; pg8::DualOrder S; S.init(T_ALL, 1024, G, bx);
        Epi6 E{MR2, MS2, MERGED};
        pg8::gemm_phase(lds, g, 1024, S, E);
    }
    GSYNC();
    {
        pg8::Src1 g{MERGED, WO, 1024}; pg8::StaticOrder S; S.init(T_ALL, 1024, G, bx);
        Epi7 E{H, (const float*)(ws + WS_RS0), P.gm, X1B, RSQ1, 0};
        pg8::gemm_phase(lds, g, 1024, S, E);
        pg8::Src1 g2{PB, WPP, 256};
        EpiStore E2{PP};
        pg8::gemm_phase(lds, g2, 256, S, E2);
    }
    GSYNC();
    {
        pg8::Src1 g{X1B, WG, 1024}; pg8::StaticOrder S; S.init(T_ALL, 1024, G, bx);
        Epi8 E{X1B, X2B, PP, RSQ1, RSQ2, 0};
        pg8::gemm_phase(lds, g, 1024, S, E);
    }
    GSYNC();
    {
        FRESH_IDS
        f32x4 gv[4];
#pragma unroll
        for (int i = 0; i < 2; ++i) { gv[2 * i] = *(const f32x4*)(P.gf + lane * 8 + 512 * i); gv[2 * i + 1] = *(const f32x4*)(P.gf + lane * 8 + 512 * i + 4); }
        for (int row = bx * 8 + wid; row < T_ALL; row += G * 8) {
            float sq = RSQ2[(size_t)row * 16 + (lane & 15)]; sq += __shfl_xor(sq, 1); sq += __shfl_xor(sq, 2); sq += __shfl_xor(sq, 4); sq += __shfl_xor(sq, 8);
            const float rstd = rsqrtf(sq * (1.0f / 1024.0f) + 1e-6f); float* o = P.out + (size_t)row * 1024; const bf16_t* xr = X2B + (size_t)row * 1024;
#pragma unroll
            for (int i = 0; i < 2; ++i) { f32x4 a, b; unpack8(*(const u32x4*)(xr + lane * 8 + 512 * i), a, b);
                *(f32x4*)(o + lane * 8 + 512 * i) = a * rstd * gv[2 * i]; *(f32x4*)(o + lane * 8 + 512 * i + 4) = b * rstd * gv[2 * i + 1]; }
        }
    }
}

extern "C" void kernel_launch(void* const* d_in, const int* in_sizes, int n_in, void* d_out, int out_size, void* d_ws, size_t ws_size, hipStream_t stream) {
    static int grid_blocks = 0;
    if (grid_blocks == 0) {
        int dev = 0, cus = 0, per_cu = 0;
        hipGetDevice(&dev);
        hipDeviceGetAttribute(&cus, hipDeviceAttributeMultiprocessorCount, dev);
        if (hipFuncSetAttribute((const void*)mega, hipFuncAttributeMaxDynamicSharedMemorySize, LDS_BYTES) != hipSuccess) fprintf(stderr, "hipFuncSetAttribute failed\n");
        if (hipOccupancyMaxActiveBlocksPerMultiprocessor(&per_cu, (const void*)mega, NTHR, LDS_BYTES) != hipSuccess || per_cu < 1) { per_cu = 1; (void)hipGetLastError(); }
        grid_blocks = cus * (per_cu > 1 ? 1 : per_cu);
        if (ws_size < WS_END) fprintf(stderr, "workspace too small: %zu < %zu\n", ws_size, (size_t)WS_END);
    }
    Params p{};
    p.x = (const float*)d_in[0]; p.p = (const float*)d_in[1]; p.w_in = (const float*)d_in[2]; p.w_ret = (const float*)d_in[3]; p.w_sgu = (const float*)d_in[4];
    p.w_out = (const float*)d_in[5]; p.sws = (const float*)d_in[6]; p.sbs = (const float*)d_in[7]; p.wpg = (const float*)d_in[8]; p.wpp = (const float*)d_in[9];
    p.gm = (const float*)d_in[10]; p.gp = (const float*)d_in[11]; p.gf = (const float*)d_in[12];
    p.out = (float*)d_out; p.ws = (unsigned char*)d_ws;
    (void)hipMemsetAsync((char*)d_ws + WS_BAR, 0, XCD_BAR_WORDS * 4, stream);
    void* args[] = {&p};
    hipError_t e = hipLaunchCooperativeKernel((const void*)mega, dim3(grid_blocks), dim3(NTHR), args, LDS_BYTES, stream);
    if (e != hipSuccess) fprintf(stderr, "cooperative launch failed: %s (grid %d)\n", hipGetErrorString(e), grid_blocks);
}
```

```cpp
#include <hip/hip_runtime.h>
#include <hip/hip_cooperative_groups.h>
#include <cstdio>
namespace cg = cooperative_groups;

#define LAS __attribute__((address_space(3)))
typedef unsigned short bf16_t;
typedef short bf16x8 __attribute__((ext_vector_type(8)));
typedef float f32x4 __attribute__((ext_vector_type(4)));
typedef float f32x2 __attribute__((ext_vector_type(2)));
typedef unsigned u32x4 __attribute__((ext_vector_type(4)));
typedef unsigned u32x2 __attribute__((ext_vector_type(2)));

constexpr int T_ALL = 65536, DM = 1024, NSL = 2, TS = T_ALL / NSL, BSL = 16 / NSL;
constexpr int NTHR = 512;
constexpr int LDS_STAGE = 131072, LDS_BYTES = LDS_STAGE + 16;
constexpr size_t MiB = 1ull << 20;
constexpr size_t UB = (size_t)TS * 1024 * 2;
constexpr size_t WS_WIN = 0, WS_WR = 16 * MiB, WS_WS = 18 * MiB, WS_WO = 20 * MiB, WS_WG = 22 * MiB, WS_WPP = 24 * MiB, WS_WC = 24 * MiB + 512 * 1024,
                 WS_COS = 25 * MiB, WS_SIN = 26 * MiB, WS_RSQ1 = 27 * MiB, WS_RSQ2 = 27 * MiB + 256 * 1024, WS_BAR = 28 * MiB, WS_RS0 = 29 * MiB,
                 WS_H = 32 * MiB, WS_PB = 160 * MiB, WS_SL = 192 * MiB;
constexpr size_t WS_QK = WS_SL, WS_V = WS_SL + UB, WS_SV = WS_SL + 2 * UB, WS_RG2 = WS_SL + 3 * UB, WS_UG2 = WS_SL + 5 * UB, WS_MR2 = WS_SL + 7 * UB, WS_MS2 = WS_SL + 9 * UB,
                 WS_PP = WS_SL + 11 * UB, WS_END = WS_SL + 13 * UB;
static_assert(WS_END == 1024 * MiB, "workspace map");

__device__ __forceinline__ unsigned cvt_pk_bf16(float lo, float hi) { unsigned r; asm volatile("v_cvt_pk_bf16_f32 %0, %1, %2" : "=v"(r) : "v"(lo), "v"(hi)); return r; }
__device__ __forceinline__ float bf_lo(unsigned w) { return __uint_as_float(w << 16); }
__device__ __forceinline__ float bf_hi(unsigned w) { return __uint_as_float(w & 0xffff0000u); }
__device__ __forceinline__ float bf2f(unsigned short b) { return __uint_as_float(((unsigned)b) << 16); }
__device__ __forceinline__ float wave_sum(float v) {
#pragma unroll
    for (int o = 32; o >= 1; o >>= 1) v += __shfl_xor(v, o);
    return v;
}
__device__ __forceinline__ float sigmoidf_(float x) { return __builtin_amdgcn_rcpf(1.0f + __builtin_amdgcn_exp2f(-1.4426950408889634f * x)); }
__device__ __forceinline__ float fexp(float x) { return __builtin_amdgcn_exp2f(1.4426950408889634f * x); }
__device__ __forceinline__ f32x2 gelu_pk(f32x2 v) {
    const f32x2 av = __builtin_elementwise_abs(v), d = av * 0.2316418882f + 1.0f;
    f32x2 t; t.x = __builtin_amdgcn_rcpf(d.x); t.y = __builtin_amdgcn_rcpf(d.y);
    f32x2 q = t * 0.5307027145f + (-0.7265760135f); q = q * t + 0.7107068705f; q = q * t + (-0.142248368f); q = q * t + 0.127414796f; q = q * t;
    const f32x2 s = (v * v) * (-0.72134752044f);
    f32x2 e; e.x = __builtin_amdgcn_exp2f(s.x); e.y = __builtin_amdgcn_exp2f(s.y);
    const f32x2 m = v * (q * e), r = v - m;
    f32x2 o; o.x = v.x < 0.f ? m.x : r.x; o.y = v.y < 0.f ? m.y : r.y; return o;
}
__device__ __forceinline__ f32x4 gelu4(f32x4 v) { f32x2 a = gelu_pk((f32x2){v[0], v[1]}), b = gelu_pk((f32x2){v[2], v[3]}); return (f32x4){a.x, a.y, b.x, b.y}; }
__device__ __forceinline__ f32x4 sig4(f32x4 v) { return (f32x4){sigmoidf_(v[0]), sigmoidf_(v[1]), sigmoidf_(v[2]), sigmoidf_(v[3])}; }
__device__ __forceinline__ float lgam(int h) { return h == 0 ? -0.03174869831458027f : h == 1 ? -0.01574835696813892f : h == 2 ? -0.007843177461025892f : -0.003913899321136329f; }

namespace pg8 {
constexpr int BM = 256, BK = 64, HALF = 128, HTB = HALF * BK * 2, STAGE_BYTES = 8 * HTB, NXCD = 8, WGM = 8;
__host__ __device__ __forceinline__ int lds_byte(int r, int c) { const int st = (r >> 4) * 2 + (c >> 5), rr = r & 15, cc = c & 31, ob = rr * 64 + cc * 2; return st * 1024 + (ob ^ (((ob >> 9) & 1) << 5)); }
__host__ __device__ __forceinline__ void stage_rc(int b, int& R, int& C) { const int st = b / 1024, sb = b % 1024, swz = sb ^ (((sb >> 9) & 1) << 5); R = (st >> 1) * 16 + swz / 64; C = (st & 1) * 32 + (swz % 64) / 2; }
__host__ __device__ __forceinline__ int perm32(int rho) { const int n = rho >> 4, i = rho & 15; return 8 * (i >> 2) + 4 * n + (i & 3); }

struct Unit { int pm, pn, part; };
struct StaticOrder {
    int nM, nN, nwg, G, c;
    __device__ void init(int M, int N, int G_, int c_) { nM = M / BM; nN = N / BM; nwg = nM * nN; G = G_; c = c_; }
    __device__ bool next(int i, Unit& u) const {
        const long L = (long)i * G + c; if (L >= nwg) return false;
        int wgid = (int)L; { const int q = nwg / NXCD, r = nwg % NXCD, xcd = wgid % NXCD, off = wgid / NXCD; wgid = (xcd < r ? xcd * (q + 1) : r * (q + 1) + (xcd - r) * q) + off; }
        const int nig = WGM * nN, gid = wgid / nig, fm = gid * WGM, gsz = (nM - fm) < WGM ? (nM - fm) : WGM;
        u.pm = fm + ((wgid % nig) % gsz); u.pn = (wgid % nig) / gsz; u.part = 0; return true;
    }
};
struct DualOrder : StaticOrder {
    __device__ bool next(int i, Unit& u) const { if (!StaticOrder::next(i >> 1, u)) return false; u.part = i & 1; return true; }
};
struct Src1 { const bf16_t* A; const bf16_t* Bt; int K;
    __device__ __forceinline__ const char* a(const Unit& u) const { return (const char*)A + (size_t)u.pm * BM * K * 2; }
    __device__ __forceinline__ const char* b(const Unit& u) const { return (const char*)Bt + (size_t)u.pn * BM * K * 2; } };
struct Src1V { const bf16_t* A; const bf16_t* Bt; int K;
    __device__ __forceinline__ const char* a(const Unit& u) const { const char* pa = (const char*)A + (size_t)u.pm * BM * K * 2; const char* pb = (const char*)Bt + (size_t)u.pn * BM * K * 2; const long sw = (u.pn >= 4 && u.pn < 8) ? 1 : 0; return pa + sw * (long)(pb - pa); }
    __device__ __forceinline__ const char* b(const Unit& u) const { const char* pa = (const char*)A + (size_t)u.pm * BM * K * 2; const char* pb = (const char*)Bt + (size_t)u.pn * BM * K * 2; const long sw = (u.pn >= 4 && u.pn < 8) ? 1 : 0; return pb - sw * (long)(pb - pa); } };
struct Src2 { const bf16_t* A0; const bf16_t* B0; long dA, dB; int K;
    __device__ __forceinline__ const char* a(const Unit& u) const { return (const char*)A0 + (long)u.part * dA + (size_t)u.pm * BM * K * 2; }
    __device__ __forceinline__ const char* b(const Unit& u) const { return (const char*)B0 + (long)u.part * dB + (size_t)u.pn * BM * K * 2; } };

template <class Epi, class Sched, class Src>
__device__ __forceinline__ void gemm_phase(LAS unsigned char* lds, const Src& g, const int K, const Sched& S, const Epi& E) {
    int tid_ = threadIdx.x; asm volatile("" : "+v"(tid_));
    const int tid = tid_, wid = __builtin_amdgcn_readfirstlane(tid >> 6), lane = tid & 63, wr = wid >> 2, wc = wid & 3, fr = lane & 15, fq = lane >> 4;
    const int nt = K / BK;
    unsigned voffA[2], voffB[2];
#pragma unroll
    for (int i = 0; i < 2; ++i) { int R, C; stage_rc(tid * 16 + i * 8192, R, C); const int Rb = Epi::PERM ? ((R & ~31) + perm32(R & 31)) : R;
        voffA[i] = (unsigned)(R * K + C) * 2u; voffB[i] = (unsigned)(Rb * K + C) * 2u; }
    const size_t kstep = (size_t)(BK * 2);
    const size_t hstep = (size_t)HALF * K * 2;
    const unsigned ldsw = (unsigned)wid * 1024u;
    const int aoff = lds_byte(wr * 64 + fr, fq * 8), boff = lds_byte(wc * 32 + fr, fq * 8);
#define PG8_SA(b, h) (((b) * 2 + (h)) * HTB)
#define PG8_SB(b, h) ((4 + (b) * 2 + (h)) * HTB)
#define PG8_STAGE(bufoff, gbase, voff) do { _Pragma("unroll") for (int _i = 0; _i < 2; ++_i) \
        __builtin_amdgcn_global_load_lds((const unsigned*)((const char*)(gbase) + (voff)[_i]), (LAS unsigned*)(lds + (bufoff) + ldsw + _i * 8192), 16, 0, 0); } while (0)
#define PG8_LDA(dst, b, h) do { _Pragma("unroll") for (int m = 0; m < 4; ++m) _Pragma("unroll") for (int k = 0; k < 2; ++k) dst[m][k] = *(const LAS bf16x8*)(lds + PG8_SA(b, h) + aoff + m * 2048 + k * 1024); } while (0)
#define PG8_LDB(dst, b, h) do { _Pragma("unroll") for (int n = 0; n < 2; ++n) _Pragma("unroll") for (int k = 0; k < 2; ++k) dst[n][k] = *(const LAS bf16x8*)(lds + PG8_SB(b, h) + boff + n * 2048 + k * 1024); } while (0)
#define PG8_MMA(ai, bj, At, Bt) do { __builtin_amdgcn_s_setprio(1); _Pragma("unroll") for (int m = 0; m < 4; ++m) _Pragma("unroll") for (int n = 0; n < 2; ++n) _Pragma("unroll") for (int k = 0; k < 2; ++k) \
        acc[ai][bj][m][n] = __builtin_amdgcn_mfma_f32_16x16x32_bf16(Bt[n][k], At[m][k], acc[ai][bj][m][n], 0, 0, 0); __builtin_amdgcn_s_setprio(0); } while (0)
#define PG8_WAIT_V(n) asm volatile("s_waitcnt vmcnt(" #n ")" ::: "memory")
#define PG8_WAIT_L(n) asm volatile("s_waitcnt lgkmcnt(" #n ")" ::: "memory")
#define PG8_BAR __builtin_amdgcn_s_barrier()
#define PG8_SCHED __builtin_amdgcn_sched_barrier(0)
    Unit cur, nxt; int ui = 0;
    if (!S.next(0, cur)) return;
    f32x4 acc[2][2][4][2];
#pragma unroll
    for (int a = 0; a < 2; ++a)
#pragma unroll
        for (int b = 0; b < 2; ++b)
#pragma unroll
            for (int m = 0; m < 4; ++m)
#pragma unroll
                for (int n = 0; n < 2; ++n) acc[a][b][m][n] = (f32x4){0.f, 0.f, 0.f, 0.f};
    bf16x8 At[4][2], B0[2][2], B1[2][2];
    const char* cA = g.a(cur); const char* cB = g.b(cur);
    PG8_STAGE(PG8_SB(0, 0), cB, voffB); PG8_STAGE(PG8_SA(0, 0), cA, voffA); PG8_STAGE(PG8_SB(0, 1), cB + hstep, voffB); PG8_STAGE(PG8_SA(0, 1), cA + hstep, voffA);
    if (wr == 1) PG8_BAR;
    PG8_WAIT_V(4); PG8_BAR;
    PG8_STAGE(PG8_SB(1, 0), cB + kstep, voffB); PG8_STAGE(PG8_SA(1, 0), cA + kstep, voffA); PG8_STAGE(PG8_SB(1, 1), cB + hstep + kstep, voffB);
    PG8_WAIT_V(6); PG8_BAR;
    for (;;) {
        const bool has_next = S.next(ui + 1, nxt);
        const char* nA = has_next ? g.a(nxt) : cA; const char* nB = has_next ? g.b(nxt) : cB;
        for (int t = 0; t < nt; t += 2) {
            const bool last = (t == nt - 2);
            const char* a1 = cA + (size_t)(t + 1) * kstep;
            const char* a2 = last ? nA : cA + (size_t)(t + 2) * kstep; const char* b2 = last ? nB : cB + (size_t)(t + 2) * kstep;
            const char* a3 = a2 + kstep; const char* b3 = b2 + kstep;
            PG8_LDB(B0, 0, 0); PG8_SCHED; PG8_LDA(At, 0, 0); PG8_STAGE(PG8_SA(1, 1), a1 + hstep, voffA);
            PG8_WAIT_L(8); PG8_BAR; PG8_WAIT_L(0); PG8_MMA(0, 0, At, B0); PG8_BAR; PG8_SCHED;
            PG8_LDB(B1, 0, 1); PG8_STAGE(PG8_SB(0, 0), b2, voffB);
            PG8_BAR; PG8_WAIT_L(0); PG8_MMA(0, 1, At, B1); PG8_BAR;
            PG8_LDA(At, 0, 1); PG8_STAGE(PG8_SA(0, 0), a2, voffA);
            PG8_BAR; PG8_WAIT_L(0); PG8_MMA(1, 0, At, B0); PG8_BAR; PG8_SCHED;
            PG8_STAGE(PG8_SB(0, 1), b2 + hstep, voffB);
            PG8_WAIT_V(6); PG8_BAR; PG8_MMA(1, 1, At, B1); PG8_BAR;
            PG8_LDB(B0, 1, 0); PG8_SCHED; PG8_LDA(At, 1, 0); PG8_STAGE(PG8_SA(0, 1), a2 + hstep, voffA);
            PG8_WAIT_L(8); PG8_BAR; PG8_WAIT_L(0); PG8_MMA(0, 0, At, B0); PG8_BAR; PG8_SCHED;
            PG8_LDB(B1, 1, 1); PG8_STAGE(PG8_SB(1, 0), b3, voffB);
            PG8_BAR; PG8_WAIT_L(0); PG8_MMA(0, 1, At, B1); PG8_BAR;
            PG8_LDA(At, 1, 1); PG8_STAGE(PG8_SA(1, 0), a3, voffA);
            PG8_BAR; PG8_WAIT_L(0); PG8_MMA(1, 0, At, B0); PG8_BAR; PG8_SCHED;
            PG8_STAGE(PG8_SB(1, 1), b3 + hstep, voffB);
            PG8_WAIT_V(6); PG8_BAR; PG8_MMA(1, 1, At, B1); PG8_BAR;
        }
        {
            int epm = cur.pm, epn = cur.pn, efr = fr, efq = fq; asm volatile("" : "+s"(epm), "+s"(epn), "+v"(efr), "+v"(efq));
            const Unit eu{epm, epn, cur.part};
            E(acc, eu, wr, wc, efr, efq);
        }
        if (!has_next) break;
        if (!E.keep(cur)) {
#pragma unroll
            for (int a = 0; a < 2; ++a)
#pragma unroll
                for (int b = 0; b < 2; ++b)
#pragma unroll
                    for (int m = 0; m < 4; ++m)
#pragma unroll
                        for (int n = 0; n < 2; ++n) acc[a][b][m][n] = (f32x4){0.f, 0.f, 0.f, 0.f};
        }
        cur = nxt; cA = nA; cB = nB; ++ui;
    }
    PG8_WAIT_V(0);
    if (wr == 0) PG8_BAR;
    PG8_BAR;
#undef PG8_SA
#undef PG8_SB
#undef PG8_STAGE
#undef PG8_LDA
#undef PG8_LDB
#undef PG8_MMA
#undef PG8_WAIT_V
#undef PG8_WAIT_L
#undef PG8_BAR
#undef PG8_SCHED
}
}
using pg8::Unit;
typedef f32x4 AccT[2][2][4][2];

__device__ __forceinline__ u32x4 pack8(f32x4 a, f32x4 b) { u32x4 w; w.x = cvt_pk_bf16(a[0], a[1]); w.y = cvt_pk_bf16(a[2], a[3]); w.z = cvt_pk_bf16(b[0], b[1]); w.w = cvt_pk_bf16(b[2], b[3]); return w; }
__device__ __forceinline__ u32x2 pack4(f32x4 a) { u32x2 w; w.x = cvt_pk_bf16(a[0], a[1]); w.y = cvt_pk_bf16(a[2], a[3]); return w; }
__device__ __forceinline__ void unpack8(u32x4 w, f32x4& a, f32x4& b) { a = (f32x4){bf_lo(w.x), bf_hi(w.x), bf_lo(w.y), bf_hi(w.y)}; b = (f32x4){bf_lo(w.z), bf_hi(w.z), bf_lo(w.w), bf_hi(w.w)}; }
__device__ __forceinline__ f32x4 unpack4(u32x2 w) { return (f32x4){bf_lo(w.x), bf_hi(w.x), bf_lo(w.y), bf_hi(w.y)}; }

struct Epi1 {
    static constexpr bool PERM = true;
    bf16_t *QK, *UG; const float* cs; const float* sn; int sl; float* svs;
    __device__ __forceinline__ bool keep(const Unit&) const { return false; }
    __device__ __forceinline__ void operator()(AccT& acc, const Unit& u, int wr, int wc, int fr, int fq) const {
        const int pn = u.pn, cl = wc * 32 + 8 * fq, row0 = u.pm * 256 + wr * 64 + fr;
        if (pn < 4) {
            const int isk = pn >> 1, t = pn & 1, head = 2 * t + (cl >> 6), dim0 = cl & 63;
            const float sc = isk ? 1.0f : 0.08838834764831845f;
            bf16_t* base = QK + isk * 512 + head * 128 + dim0;
            f32x4 tb[2][2][4];
#define ROT_LD(b, buf) do { _Pragma("unroll") for (int mm = 0; mm < 2; ++mm) { const int pos_ = (row0 + ((b) >> 1) * 128 + (((b) & 1) * 2 + mm) * 16) & 4095; \
                tb[buf][mm][0] = *(const f32x4*)(cs + pos_ * 64 + dim0); tb[buf][mm][1] = *(const f32x4*)(cs + pos_ * 64 + dim0 + 4); \
                tb[buf][mm][2] = *(const f32x4*)(sn + pos_ * 64 + dim0); tb[buf][mm][3] = *(const f32x4*)(sn + pos_ * 64 + dim0 + 4); } } while (0)
            ROT_LD(0, 0);
#pragma unroll
            for (int b = 0; b < 4; ++b) {
                if (b + 1 < 4) ROT_LD(b + 1, (b + 1) & 1);
#pragma unroll
                for (int mm = 0; mm < 2; ++mm) {
                    const int ai = b >> 1, m = (b & 1) * 2 + mm, row = row0 + ai * 128 + m * 16;
                    const f32x4 c0 = tb[b & 1][mm][0], c1 = tb[b & 1][mm][1], s0 = tb[b & 1][mm][2], s1 = tb[b & 1][mm][3];
                    const f32x4 x1a = acc[ai][0][m][0], x1b = acc[ai][0][m][1], x2a = acc[ai][1][m][0], x2b = acc[ai][1][m][1];
                    const f32x4 o1a = (x1a * c0 - x2a * s0) * sc, o1b = (x1b * c1 - x2b * s1) * sc, o2a = (x2a * c0 + x1a * s0) * sc, o2b = (x2b * c1 + x1b * s1) * sc;
                    *(u32x4*)(base + (size_t)row * 1024) = pack8(o1a, o1b);
                    *(u32x4*)(base + (size_t)row * 1024 + 64) = pack8(o2a, o2b);
                }
            }
#undef ROT_LD
        } else if (pn >= 12 && pn < 20) {
            bf16_t* base = UG + 128 * (pn - 12) + cl;
#pragma unroll
            for (int ai = 0; ai < 2; ++ai)
#pragma unroll
                for (int m = 0; m < 4; ++m) {
                    const int row = row0 + ai * 128 + m * 16;
                    const f32x4 ua = gelu4(acc[ai][0][m][0]), ub = gelu4(acc[ai][0][m][1]);
                    const f32x4 ga = acc[ai][1][m][0], gb = acc[ai][1][m][1];
                    *(u32x4*)(base + (size_t)row * 1024) = pack8(ua * ga * sig4(ga), ub * gb * sig4(gb));
                }
        } else if (pn >= 24) {
            bf16_t* rbase = QK + (size_t)(3 + 2 * NSL + sl) * ((size_t)TS * 1024) + 128 * (pn - 24) + cl;
            bf16_t* sbase = QK + (size_t)(3 + 3 * NSL + sl) * ((size_t)TS * 1024) + 128 * (pn - 24) + cl;
#pragma unroll
            for (int ai = 0; ai < 2; ++ai)
#pragma unroll
                for (int m = 0; m < 4; ++m) {
                    const int row = row0 + ai * 128 + m * 16;
                    f32x4 r[2], sg[2];
#pragma unroll
                    for (int n = 0; n < 2; ++n) {
                        const f32x4 b = acc[ai][1][m][n];
                        const f32x4 one = (f32x4){1.0f + __builtin_amdgcn_exp2f(-1.4426950408889634f * b[0]), 1.0f + __builtin_amdgcn_exp2f(-1.4426950408889634f * b[1]),
                                                  1.0f + __builtin_amdgcn_exp2f(-1.4426950408889634f * b[2]), 1.0f + __builtin_amdgcn_exp2f(-1.4426950408889634f * b[3])};
                        sg[n] = (f32x4){__builtin_amdgcn_rcpf(one[0]), __builtin_amdgcn_rcpf(one[1]), __builtin_amdgcn_rcpf(one[2]), __builtin_amdgcn_rcpf(one[3])};
                        r[n] = sig4(acc[ai][0][m][n]) * one;
                    }
                    *(u32x4*)(rbase + (size_t)row * 1024) = pack8(r[0], r[1]);
                    *(u32x4*)(sbase + (size_t)row * 1024) = pack8(sg[0], sg[1]);
                    asm volatile("" ::: "memory");
                }
        } else if (pn < 8) {
            bf16_t* vt = QK + (size_t)TS * 1024;
#pragma unroll
            for (int ai = 0; ai < 2; ++ai)
#pragma unroll
                for (int m = 0; m < 4; ++m) {
                    const int e = ai * 128 + wr * 64 + m * 16 + fr;
#pragma unroll
                    for (int bj = 0; bj < 2; ++bj)
                        *(u32x4*)(vt + (((size_t)(u.pm * 2 + bj) * 4 + (pn - 4)) * 256 + e) * 128 + cl) = pack8(acc[ai][bj][m][0], acc[ai][bj][m][1]);
                }
        } else {
            const int act = pn < 8 ? 0 : pn < 12 ? 1 : pn < 24 ? 2 : 3;
            const int bidx = pn < 8 ? 1 : pn < 12 ? 3 + sl : pn < 24 ? 2 : pn < 28 ? 7 + sl : 9 + sl;
            const int tl = pn < 8 ? pn - 4 : pn < 12 ? pn - 8 : pn < 24 ? pn - 20 : pn < 28 ? pn - 24 : pn - 28;
            bf16_t* base = QK + (size_t)bidx * ((size_t)TS * 1024) + tl * 256 + cl;
#pragma unroll
            for (int ai = 0; ai < 2; ++ai)
#pragma unroll
                for (int m = 0; m < 4; ++m) {
                    const int row = row0 + ai * 128 + m * 16; float ssum = 0.f, ssq = 0.f;
#pragma unroll
                    for (int bj = 0; bj < 2; ++bj) {
                        f32x4 a = acc[ai][bj][m][0], b = acc[ai][bj][m][1];
                        if (act == 1) { a = a * sig4(a); b = b * sig4(b); }
                        else if (act == 2) { a = gelu4(a); b = gelu4(b);
                            ssum += ((a[0] + a[1]) + (a[2] + a[3])) + ((b[0] + b[1]) + (b[2] + b[3]));
                            ssq += ((a[0] * a[0] + a[1] * a[1]) + (a[2] * a[2] + a[3] * a[3])) + ((b[0] * b[0] + b[1] * b[1]) + (b[2] * b[2] + b[3] * b[3])); }
                        else if (act == 3) { a = sig4(a); b = sig4(b); }
                        *(u32x4*)(base + (size_t)row * 1024 + bj * 128) = pack8(a, b);
                    }
                    if (act == 2) {
                        ssum += __shfl_xor(ssum, 16); ssum += __shfl_xor(ssum, 32); ssq += __shfl_xor(ssq, 16); ssq += __shfl_xor(ssq, 32);
                        if (fq == 0) *(f32x2*)(svs + (size_t)row * 32 + tl * 8 + wc * 2) = (f32x2){ssum, ssq};
                    }
                }
        }
    }
};
struct Epi6 {
    static constexpr bool PERM = true;
    const bf16_t* MR; const bf16_t* MS; bf16_t* O;
    __device__ __forceinline__ bool keep(const Unit& u) const { return u.part == 0; }
    __device__ __forceinline__ void operator()(AccT& acc, const Unit& u, int wr, int wc, int fr, int fq) const {
        const int row0 = u.pm * 256 + wr * 64 + fr, col0 = u.pn * 256 + wc * 32 + 8 * fq;
        u32x4 sb[4][2];
#define E6_LD(g) do { _Pragma("unroll") for (int bj = 0; bj < 2; ++bj) { const size_t off_ = (size_t)(row0 + ((g) >> 2) * 128 + ((g) & 3) * 16) * 1024 + col0 + bj * 128; \
            if (u.part == 0) sb[(g) & 3][bj] = *(const u32x4*)(MR + off_); else sb[(g) & 3][bj] = *(const u32x4*)(MS + off_); } } while (0)
        E6_LD(0); E6_LD(1); E6_LD(2);
#pragma unroll
        for (int g = 0; g < 8; ++g) {
            if (g + 3 < 8) E6_LD(g + 3);
            const int ai = g >> 2, m = g & 3;
#pragma unroll
            for (int bj = 0; bj < 2; ++bj) {
                const size_t off = (size_t)(row0 + ai * 128 + m * 16) * 1024 + col0 + bj * 128;
                f32x4 sa, sbv; unpack8(sb[g & 3][bj], sa, sbv);
                if (u.part == 0) {
#pragma unroll
                    for (int j = 0; j < 4; ++j) { acc[ai][bj][m][0][j] *= sa[j]; acc[ai][bj][m][1][j] *= sbv[j]; }
                } else {
                    *(u32x4*)(O + off) = pack8(acc[ai][bj][m][0] * sa, acc[ai][bj][m][1] * sbv);
                }
            }
        }
#undef E6_LD
    }
};
struct EpiStore {
    static constexpr bool PERM = true;
    bf16_t* O;
    __device__ __forceinline__ bool keep(const Unit&) const { return false; }
    __device__ __forceinline__ void operator()(AccT& acc, const Unit& u, int wr, int wc, int fr, int fq) const {
        const int row0 = u.pm * 256 + wr * 64 + fr, col0 = u.pn * 256 + wc * 32 + 8 * fq;
#pragma unroll
        for (int ai = 0; ai < 2; ++ai)
#pragma unroll
            for (int m = 0; m < 4; ++m)
#pragma unroll
                for (int bj = 0; bj < 2; ++bj)
                    *(u32x4*)(O + (size_t)(row0 + ai * 128 + m * 16) * 1024 + col0 + bj * 128) = pack8(acc[ai][bj][m][0], acc[ai][bj][m][1]);
    }
};
struct Epi7 {
    static constexpr bool PERM = true;
    const bf16_t* hb; const float* rs0; const float* gm; bf16_t* X1B; float* rsq; int tok0;
    __device__ __forceinline__ bool keep(const Unit&) const { return false; }
    __device__ __forceinline__ void operator()(AccT& acc, const Unit& u, int wr, int wc, int fr, int fq) const {
        const int row0 = u.pm * 256 + wr * 64 + fr, col0 = u.pn * 256 + wc * 32 + 8 * fq;
        f32x4 ig[2][2];
#pragma unroll
        for (int bj = 0; bj < 2; ++bj)
#pragma unroll
            for (int n = 0; n < 2; ++n) { const f32x4 g4 = *(const f32x4*)(gm + col0 + bj * 128 + n * 4);
                ig[bj][n] = (f32x4){__builtin_amdgcn_rcpf(g4[0]), __builtin_amdgcn_rcpf(g4[1]), __builtin_amdgcn_rcpf(g4[2]), __builtin_amdgcn_rcpf(g4[3])}; }
        u32x4 xb[4][2]; float rsv[4];
#define E7_LD(g) do { const size_t tr_ = (size_t)tok0 + row0 + ((g) >> 2) * 128 + ((g) & 3) * 16; rsv[(g) & 3] = rs0[tr_]; \
            _Pragma("unroll") for (int bj = 0; bj < 2; ++bj) xb[(g) & 3][bj] = *(const u32x4*)(hb + tr_ * 1024 + col0 + bj * 128); } while (0)
        E7_LD(0); E7_LD(1); E7_LD(2);
#pragma unroll
        for (int g = 0; g < 8; ++g) {
            if (g + 3 < 8) E7_LD(g + 3);
            const int ai = g >> 2, m = g & 3, row = row0 + ai * 128 + m * 16; const size_t tok = (size_t)tok0 + row; float ss = 0.f;
            const float sr = rsv[g & 3];
#pragma unroll
            for (int bj = 0; bj < 2; ++bj) {
                f32x4 ha, hb2; unpack8(xb[g & 3][bj], ha, hb2);
                const f32x4 o0 = ha * sr * ig[bj][0] + acc[ai][bj][m][0], o1 = hb2 * sr * ig[bj][1] + acc[ai][bj][m][1];
                *(u32x4*)(X1B + (size_t)row * 1024 + col0 + bj * 128) = pack8(o0, o1);
                ss += ((o0[0] * o0[0] + o0[1] * o0[1]) + (o0[2] * o0[2] + o0[3] * o0[3])) + ((o1[0] * o1[0] + o1[1] * o1[1]) + (o1[2] * o1[2] + o1[3] * o1[3]));
            }
            ss += __shfl_xor(ss, 16); ss += __shfl_xor(ss, 32);
            if (fq == 0) rsq[tok * 16 + u.pn * 4 + wc] = ss;
        }
#undef E7_LD
    }
};
struct Epi8 {
    static constexpr bool PERM = true;
    const bf16_t* X1B; bf16_t* X2B; const bf16_t* PP; const float* rsq1; float* rsq2; int tok0;
    __device__ __forceinline__ bool keep(const Unit&) const { return false; }
    __device__ __forceinline__ void operator()(AccT& acc, const Unit& u, int wr, int wc, int fr, int fq) const {
        const int row0 = u.pm * 256 + wr * 64 + fr, col0 = u.pn * 256 + wc * 32 + 8 * fq;
        float rs[8];
        {   f32x4 sl[8];
#pragma unroll
            for (int r = 0; r < 8; ++r) sl[r] = *(const f32x4*)(rsq1 + ((size_t)tok0 + row0 + (r >> 2) * 128 + (r & 3) * 16) * 16 + 4 * fq);
#pragma unroll
            for (int r = 0; r < 8; ++r) { float t = (sl[r][0] + sl[r][1]) + (sl[r][2] + sl[r][3]); t += __shfl_xor(t, 16); t += __shfl_xor(t, 32); rs[r] = t; } }
        u32x4 pb[4][2], xb[4][2];
#define E8_LD(g) do { _Pragma("unroll") for (int bj = 0; bj < 2; ++bj) { \
            const size_t off_ = (size_t)(row0 + ((g) >> 2) * 128 + ((g) & 3) * 16) * 1024 + col0 + bj * 128; \
            pb[(g) & 3][bj] = *(const u32x4*)(PP + off_); xb[(g) & 3][bj] = *(const u32x4*)(X1B + off_); } } while (0)
        E8_LD(0); E8_LD(1); E8_LD(2);
#pragma unroll
        for (int g = 0; g < 8; ++g) {
            if (g + 3 < 8) E8_LD(g + 3);
            const int ai = g >> 2, m = g & 3, row = row0 + ai * 128 + m * 16; const size_t tok = (size_t)tok0 + row; float ss = 0.f;
            const float rstd = rsqrtf(rs[g] * (1.0f / 1024.0f) + 1e-6f);
#pragma unroll
            for (int bj = 0; bj < 2; ++bj) {
                const size_t off = (size_t)row * 1024 + col0 + bj * 128;
                f32x4 pa, pc, xa, xc; unpack8(pb[g & 3][bj], pa, pc); unpack8(xb[g & 3][bj], xa, xc);
                const f32x4 o0 = xa + sig4(acc[ai][bj][m][0] * rstd) * pa, o1 = xc + sig4(acc[ai][bj][m][1] * rstd) * pc;
                *(u32x4*)(X2B + off) = pack8(o0, o1);
                ss += ((o0[0] * o0[0] + o0[1] * o0[1]) + (o0[2] * o0[2] + o0[3] * o0[3])) + ((o1[0] * o1[0] + o1[1] * o1[1]) + (o1[2] * o1[2] + o1[3] * o1[3]));
            }
            ss += __shfl_xor(ss, 16); ss += __shfl_xor(ss, 32);
            if (fq == 0) rsq2[tok * 16 + u.pn * 4 + wc] = ss;
        }
#undef E8_LD
    }
};

__device__ __forceinline__ int srccol_win(int np) {
    const int pn = np >> 8, L = np & 255;
    if (pn < 4) { const int isk = pn >> 1, t = pn & 1, half = L >> 7, i = L & 127, head = 2 * t + (i >> 6), dim = (i & 63) + 64 * half; return isk * 512 + head * 128 + dim; }
    if (pn < 8) return 1024 + (pn - 4) * 256 + L;
    if (pn < 12) return 2048 + (pn - 8) * 256 + L;
    if (pn < 20) { const int t = pn - 12; return L < 128 ? 3072 + 128 * t + L : 5120 + 128 * t + (L - 128); }
    if (pn < 24) return 4096 + (pn - 20) * 256 + L;
    { const int t = pn - 24; return L < 128 ? 6144 + 128 * t + L : 7168 + 128 * t + (L - 128); }
}
__device__ __forceinline__ void p0_transpose(LAS float* tile, const float* src, int ldsrc, int k0, int c0, bf16_t* dst, int ldk, int n0, const float* kscale, int tid) {
#pragma unroll
    for (int p = 0; p < 2; ++p) {
        const int r = (tid >> 4) + 32 * p, c4 = (tid & 15) * 4;
        const f32x4 v = *(const f32x4*)(src + (size_t)(k0 + r) * ldsrc + c0 + c4);
        const float s = kscale ? kscale[k0 + r] : 1.0f;
        tile[r * 65 + c4 + 0] = v[0] * s; tile[r * 65 + c4 + 1] = v[1] * s; tile[r * 65 + c4 + 2] = v[2] * s; tile[r * 65 + c4 + 3] = v[3] * s;
    }
    __syncthreads();
    {
        const int n = tid >> 3, kc = (tid & 7) * 8;
        u32x4 w;
        w.x = cvt_pk_bf16(tile[(kc + 0) * 65 + n], tile[(kc + 1) * 65 + n]); w.y = cvt_pk_bf16(tile[(kc + 2) * 65 + n], tile[(kc + 3) * 65 + n]);
        w.z = cvt_pk_bf16(tile[(kc + 4) * 65 + n], tile[(kc + 5) * 65 + n]); w.w = cvt_pk_bf16(tile[(kc + 6) * 65 + n], tile[(kc + 7) * 65 + n]);
        *(u32x4*)(dst + (size_t)(n0 + n) * ldk + k0 + kc) = w;
    }
    __syncthreads();
}

struct Params { const float *x, *p, *w_in, *w_ret, *w_sgu, *w_out, *sws, *sbs, *wpg, *wpp, *gm, *gp, *gf; float* out; unsigned char* ws; };

__device__ __forceinline__ void phase0(const Params& P, LAS unsigned char* lds, int tid, int wid, int lane) {
    unsigned char* ws = P.ws;
    const int G = gridDim.x, bx = blockIdx.x;
    LAS float* tile = (LAS float*)lds;
    for (int idx = bx; idx < 3136; idx += G) {
        if (idx < 2048) { const int kt = idx & 15, ntl = idx >> 4; p0_transpose(tile, P.w_in, 8192, kt * 64, srccol_win(ntl * 64), (bf16_t*)(ws + WS_WIN), 1024, ntl * 64, nullptr, tid); }
        else if (idx < 3072) { const int w = (idx - 2048) >> 8, r = (idx - 2048) & 255, kt = r & 15, ntl = r >> 4;
            const float* src = w == 0 ? P.w_ret : w == 1 ? P.w_sgu : w == 2 ? P.w_out : P.wpg;
            bf16_t* dst = (bf16_t*)(ws + (w == 0 ? WS_WR : w == 1 ? WS_WS : w == 2 ? WS_WO : WS_WG));
            p0_transpose(tile, src, 1024, kt * 64, ntl * 64, dst, 1024, ntl * 64, w == 3 ? P.gp : nullptr, tid); }
        else { const int r = idx - 3072, kt = r & 3, ntl = r >> 2; p0_transpose(tile, P.wpp, 1024, kt * 64, ntl * 64, (bf16_t*)(ws + WS_WPP), 256, ntl * 64, nullptr, tid); }
    }
    const int gt = bx * NTHR + tid, gn = G * NTHR;
    for (int i = gt; i < 4 * 128 * 128; i += gn) { const int r = (i >> 7) & 127, c = i & 127; const float v = c <= r ? P.sws[i] : 0.0f; ((bf16_t*)(ws + WS_WC))[i] = (bf16_t)(cvt_pk_bf16(v, 0.f) & 0xffffu); }
    for (int i = gt; i < 4096 * 64; i += gn) {
        const int pos = i >> 6, j = i & 63;
        const float inv = exp2f(-(float)j * (13.287712379549449f / 64.0f));
        const float ang = (float)pos * inv;
        const double a = (double)ang; const double nrev = rint(a * 0.15915494309189535); const float r = (float)(a - nrev * 6.283185307179586);
        ((float*)(ws + WS_COS))[i] = cosf(r); ((float*)(ws + WS_SIN))[i] = sinf(r);
    }
    for (size_t i = (size_t)gt * 8; i < (size_t)T_ALL * 256; i += (size_t)gn * 8) {
        const f32x4 a = *(const f32x4*)(P.p + i), b = *(const f32x4*)(P.p + i + 4);
        *(u32x4*)((bf16_t*)(ws + WS_PB) + i) = pack8(a, b);
    }
    {
        f32x4 gv[4];
#pragma unroll
        for (int i = 0; i < 4; ++i) gv[i] = *(const f32x4*)(P.gm + lane * 4 + 256 * i);
        for (int row = bx * 8 + wid; row < T_ALL; row += G * 8) {
            const float* xr = P.x + (size_t)row * 1024; f32x4 v[4]; float ss = 0.f;
#pragma unroll
            for (int i = 0; i < 4; ++i) { v[i] = *(const f32x4*)(xr + lane * 4 + 256 * i); ss += (v[i][0] * v[i][0] + v[i][1] * v[i][1]) + (v[i][2] * v[i][2] + v[i][3] * v[i][3]); }
            ss = wave_sum(ss);
            const float rstd = rsqrtf(ss * (1.0f / 1024.0f) + 1e-6f);
            if (lane == 0) ((float*)(ws + WS_RS0))[row] = sqrtf(ss * (1.0f / 1024.0f) + 1e-6f);
            bf16_t* hr = (bf16_t*)(ws + WS_H) + (size_t)row * 1024;
#pragma unroll
            for (int i = 0; i < 4; ++i) *(u32x2*)(hr + lane * 4 + 256 * i) = pack4(v[i] * rstd * gv[i]);
        }
    }
}

template <int ROWS, int COLS> struct TileRegs { u32x4 v[ROWS * (COLS / 8) / NTHR]; };
template <int ROWS, int COLS>
__device__ __forceinline__ void tile_load(TileRegs<ROWS, COLS>& t, const bf16_t* src, size_t gp, int tid) {
    constexpr int CPR = COLS / 8, IT = ROWS * CPR / NTHR;
#pragma unroll
    for (int i = 0; i < IT; ++i) { const int c = tid + i * NTHR, r = c / CPR, ch = c % CPR; t.v[i] = *(const u32x4*)(src + (size_t)r * gp + ch * 8); }
}
template <int ROWS, int COLS>
__device__ __forceinline__ void tile_store_b128(const TileRegs<ROWS, COLS>& t, LAS unsigned char* dst, int lp, int tid) {
    constexpr int CPR = COLS / 8, IT = ROWS * CPR / NTHR;
#pragma unroll
    for (int i = 0; i < IT; ++i) { const int c = tid + i * NTHR, r = c / CPR, ch = c % CPR; *(LAS u32x4*)(dst + r * lp + ch * 16) = t.v[i]; }
}
template <int ROWS, int COLS>
__device__ __forceinline__ void tile_store_b32(const TileRegs<ROWS, COLS>& t, LAS unsigned char* dst, int lp, int tid) {
    constexpr int CPR = COLS / 8, IT = ROWS * CPR / NTHR;
#pragma unroll
    for (int i = 0; i < IT; ++i) { const int c = tid + i * NTHR, r = c / CPR, ch = c % CPR; LAS unsigned* d = (LAS unsigned*)(dst + r * lp + ch * 16); d[0] = t.v[i].x; d[1] = t.v[i].y; d[2] = t.v[i].z; d[3] = t.v[i].w; }
}
__device__ __forceinline__ void gather8(const LAS unsigned char* base, int pitch, int r0, int col, unsigned short (&o)[8]) {
    const LAS unsigned char* p = base + r0 * pitch + col * 2;
#pragma unroll
    for (int j = 0; j < 8; ++j) o[j] = *(const LAS unsigned short*)(p + j * pitch);
}
__device__ __forceinline__ bf16x8 mk8(const unsigned short (&o)[8]) { bf16x8 r;
#pragma unroll
    for (int j = 0; j < 8; ++j) r[j] = (short)o[j];
    return r; }

__device__ __forceinline__ void p2_unit(LAS unsigned char* lds, const bf16_t* QK, const bf16_t* V, bf16_t* KV, int unit, int tid, int wid, int lane) {
    const int fr = lane & 15, fq = lane >> 4, h = unit & 3; const size_t tok0 = (size_t)(unit >> 2) * 128; const float lg = lgam(h);
    LAS unsigned char* sK = lds; LAS unsigned char* sV = lds + 33280;
    TileRegs<128, 128> tk; TileRegs<256, 128> tv;
    asm volatile("" : "+v"(tid));
    tile_load(tk, QK + tok0 * 1024 + 512 + h * 128, 1024, tid);
    tile_load(tv, V + (size_t)unit * 32768, 128, tid);
    __syncthreads();
    tile_store_b32(tk, sK, 260, tid);
    tile_store_b128(tv, sV, 272, tid);
    __syncthreads();
    f32x4 acc[2][8];
#pragma unroll
    for (int a = 0; a < 2; ++a)
#pragma unroll
        for (int b = 0; b < 8; ++b) acc[a][b] = (f32x4){0.f, 0.f, 0.f, 0.f};
#pragma unroll
    for (int ks = 0; ks < 4; ++ks) {
        const int j0 = 32 * ks + 8 * fq;
        bf16x8 vf[2];
#pragma unroll
        for (int e2 = 0; e2 < 2; ++e2) {
            const u32x4 vr = *(const LAS u32x4*)(sV + (16 * (2 * wid + e2) + fr) * 272 + j0 * 2);
            u32x4 w;
            w.x = cvt_pk_bf16(bf_lo(vr.x) * fexp(lg * (float)(127 - j0 - 0)), bf_hi(vr.x) * fexp(lg * (float)(127 - j0 - 1)));
            w.y = cvt_pk_bf16(bf_lo(vr.y) * fexp(lg * (float)(127 - j0 - 2)), bf_hi(vr.y) * fexp(lg * (float)(127 - j0 - 3)));
            w.z = cvt_pk_bf16(bf_lo(vr.z) * fexp(lg * (float)(127 - j0 - 4)), bf_hi(vr.z) * fexp(lg * (float)(127 - j0 - 5)));
            w.w = cvt_pk_bf16(bf_lo(vr.w) * fexp(lg * (float)(127 - j0 - 6)), bf_hi(vr.w) * fexp(lg * (float)(127 - j0 - 7)));
            vf[e2] = __builtin_bit_cast(bf16x8, w);
        }
#pragma unroll
        for (int db = 0; db < 8; ++db) {
            unsigned short o[8]; gather8(sK, 260, j0, 16 * db + fr, o);
            const bf16x8 kf = mk8(o);
#pragma unroll
            for (int e2 = 0; e2 < 2; ++e2) acc[e2][db] = __builtin_amdgcn_mfma_f32_16x16x32_bf16(kf, vf[e2], acc[e2][db], 0, 0, 0);
        }
    }
    bf16_t* dst = KV + (size_t)unit * 32768;
#pragma unroll
    for (int e2 = 0; e2 < 2; ++e2)
#pragma unroll
        for (int db = 0; db < 8; ++db) *(u32x2*)(dst + (16 * (2 * wid + e2) + fr) * 128 + 16 * db + 4 * fq) = pack4(acc[e2][db]);
}

__device__ __forceinline__ void p4_unit(LAS unsigned char* lds, const bf16_t* QK, const bf16_t* V, const bf16_t* PREV, const bf16_t* RG, bf16_t* RO, int unit, int tid, int wid, int lane) {
    const int fr = lane & 15, fq = lane >> 4, h = unit & 3; const size_t tok0 = (size_t)(unit >> 2) * 128; const float lg = lgam(h);
    LAS unsigned char* sK = lds; LAS unsigned char* sP = lds + 34816;
    TileRegs<128, 128> tk; TileRegs<256, 128> tp; TileRegs<256, 128> tv;
    asm volatile("" : "+v"(tid));
    tile_load(tk, QK + tok0 * 1024 + 512 + h * 128, 1024, tid);
    tile_load(tp, PREV + (size_t)unit * 32768, 128, tid);
    bf16x8 qf[4];
    { const bf16_t* qrow = QK + (tok0 + 16 * wid + fr) * 1024 + h * 128 + 8 * fq;
#pragma unroll
      for (int ks = 0; ks < 4; ++ks) qf[ks] = *(const bf16x8*)(qrow + 32 * ks); }
    __syncthreads();
    tile_store_b128(tk, sK, 272, tid);
    tile_store_b128(tp, sP, 272, tid);
    asm volatile("" : "+v"(tid));
    tile_load(tv, V + (size_t)unit * 32768, 128, tid);
    __syncthreads();
    f32x4 sacc[8];
#pragma unroll
    for (int jb = 0; jb < 8; ++jb) {
        sacc[jb] = (f32x4){0.f, 0.f, 0.f, 0.f};
        if (jb <= wid) {
#pragma unroll
            for (int ks = 0; ks < 4; ++ks) { const bf16x8 kf = *(const LAS bf16x8*)(sK + (16 * jb + fr) * 272 + (32 * ks + 8 * fq) * 2); sacc[jb] = __builtin_amdgcn_mfma_f32_16x16x32_bf16(kf, qf[ks], sacc[jb], 0, 0, 0); }
        }
    }
    f32x4 acc[16];
    const int i = 16 * wid + fr; const float xi = fexp(lg * (float)(i + 1));
#pragma unroll
    for (int eb = 0; eb < 16; ++eb) {
        f32x4 a = (f32x4){0.f, 0.f, 0.f, 0.f};
#pragma unroll
        for (int ks = 0; ks < 4; ++ks) { const bf16x8 pf = *(const LAS bf16x8*)(sP + (16 * eb + fr) * 272 + (32 * ks + 8 * fq) * 2); a = __builtin_amdgcn_mfma_f32_16x16x32_bf16(pf, qf[ks], a, 0, 0, 0); }
        acc[eb] = a * xi;
    }
    bf16x8 pfr[4];
#pragma unroll
    for (int ks = 0; ks < 4; ++ks) {
        float pv[8];
#pragma unroll
        for (int hf = 0; hf < 2; ++hf)
#pragma unroll
            for (int r = 0; r < 4; ++r) { const int jb = 2 * ks + hf, j = 16 * jb + 4 * fq + r; pv[4 * hf + r] = (j <= i) ? sacc[jb][r] * fexp(lg * (float)(i - j)) : 0.0f; }
        u32x4 w; w.x = cvt_pk_bf16(pv[0], pv[1]); w.y = cvt_pk_bf16(pv[2], pv[3]); w.z = cvt_pk_bf16(pv[4], pv[5]); w.w = cvt_pk_bf16(pv[6], pv[7]);
        pfr[ks] = __builtin_bit_cast(bf16x8, w);
    }
    __syncthreads();
    asm volatile("" : "+v"(tid));
    tile_store_b128(tv, lds, 272, tid);
    __syncthreads();
#pragma unroll
    for (int ks = 0; ks < 4; ++ks) {
        if (2 * ks <= wid) {
#pragma unroll
            for (int eb = 0; eb < 16; ++eb) {
                const LAS unsigned char* p = lds + (16 * eb + fr) * 272 + (32 * ks + 4 * fq) * 2;
                const u32x2 lo = *(const LAS u32x2*)p, hi = *(const LAS u32x2*)(p + 32);
                const u32x4 w = (u32x4){lo.x, lo.y, hi.x, hi.y};
                acc[eb] = __builtin_amdgcn_mfma_f32_16x16x32_bf16(__builtin_bit_cast(bf16x8, w), pfr[ks], acc[eb], 0, 0, 0);
            }
        }
    }
    float s = 0.f;
#pragma unroll
    for (int eb = 0; eb < 16; ++eb) s += (acc[eb][0] + acc[eb][1]) + (acc[eb][2] + acc[eb][3]);
    s += __shfl_xor(s, 16); s += __shfl_xor(s, 32);
    const float mu = s * (1.0f / 256.0f); float q = 0.f;
#pragma unroll
    for (int eb = 0; eb < 16; ++eb) { const f32x4 d = acc[eb] - mu; q += (d[0] * d[0] + d[1] * d[1]) + (d[2] * d[2] + d[3] * d[3]); }
    q += __shfl_xor(q, 16); q += __shfl_xor(q, 32);
    const float rstd = rsqrtf(q * (1.0f / 256.0f) + 1e-5f);
    const bf16_t* rgrow = RG + (tok0 + i) * 1024 + h * 256 + 4 * fq; bf16_t* rorow = RO + (tok0 + i) * 1024 + h * 256 + 4 * fq;
    u32x2 gl[16];
#pragma unroll
    for (int eb = 0; eb < 16; ++eb) gl[eb] = *(const u32x2*)(rgrow + 16 * eb);
#pragma unroll
    for (int eb = 0; eb < 16; ++eb) *(u32x2*)(rorow + 16 * eb) = pack4((acc[eb] - mu) * rstd * unpack4(gl[eb]));
}

__device__ __forceinline__ void p5_unit(LAS unsigned char* lds, const bf16_t* SV, const float* SVS, bf16_t* UO, const bf16_t* WC, const float* bias, int chunk, int tid, int wid, int lane) {
    const int fr = lane & 15, fq = lane >> 4; const size_t tok0 = (size_t)chunk * 128;
    LAS unsigned char* sW = lds; LAS unsigned char* sV = lds + 34816; LAS float* st = (LAS float*)(lds + 34816 + 66048);
    __syncthreads();
    {
        const int r = 16 * wid + (lane >> 2);
        const float* sp = SVS + (tok0 + r) * 32 + (lane & 3) * 8;
        const f32x4 p0 = *(const f32x4*)sp, p1 = *(const f32x4*)(sp + 4);
        float sm = (p0[0] + p0[2]) + (p1[0] + p1[2]), sq = (p0[1] + p0[3]) + (p1[1] + p1[3]);
        sm += __shfl_xor(sm, 1); sm += __shfl_xor(sm, 2); sq += __shfl_xor(sq, 1); sq += __shfl_xor(sq, 2);
        const float mu = sm * (1.0f / 1024.0f), var = fmaxf(sq * (1.0f / 1024.0f) - mu * mu, 0.0f);
        if ((lane & 3) == 0) { st[2 * r] = mu; st[2 * r + 1] = rsqrtf(var + 1e-5f); }
    }
    TileRegs<128, 128> tw; TileRegs<128, 256> tv;
    { int tg = tid; asm volatile("" : "+v"(tg)); tile_load(tw, WC, 128, tg); tile_load(tv, SV + tok0 * 1024, 1024, tg); }
    for (int g = 0; g < 4; ++g) {
        __syncthreads();
        tile_store_b128(tw, sW, 272, tid);
#pragma unroll
        for (int i = 0; i < 8; ++i) {
            const int c = tid + i * NTHR, r = c >> 5, ch = c & 31;
            f32x4 a, b; unpack8(tv.v[i], a, b);
            const float mu = st[2 * r], rs = st[2 * r + 1];
            const u32x4 w = pack8((a - mu) * rs, (b - mu) * rs);
            LAS unsigned* d = (LAS unsigned*)(sV + r * 516 + ch * 16); d[0] = w.x; d[1] = w.y; d[2] = w.z; d[3] = w.w;
        }
        __syncthreads();
        int tg = tid; asm volatile("" : "+v"(tg));
        if (g < 3) { tile_load(tw, WC + (g + 1) * 16384, 128, tg); tile_load(tv, SV + tok0 * 1024 + (g + 1) * 256, 1024, tg); }
        u32x2 ul[8][2]; float bvl[8];
        {   const int lfr = tg & 15, lfq = (tg & 63) >> 4;
#pragma unroll
            for (int ib = 0; ib < 8; ++ib) { bvl[ib] = bias[g * 128 + 16 * ib + lfr];
#pragma unroll
                for (int c2 = 0; c2 < 2; ++c2) ul[ib][c2] = *(const u32x2*)(UO + (tok0 + 16 * ib + lfr) * 1024 + g * 256 + 16 * (2 * wid + c2) + 4 * lfq); } }
        f32x4 acc[8][2];
#pragma unroll
        for (int a = 0; a < 8; ++a)
#pragma unroll
            for (int b = 0; b < 2; ++b) acc[a][b] = (f32x4){0.f, 0.f, 0.f, 0.f};
#pragma unroll
        for (int ks = 0; ks < 4; ++ks) {
            bf16x8 vf[2];
#pragma unroll
            for (int c2 = 0; c2 < 2; ++c2) { unsigned short o[8]; gather8(sV, 516, 32 * ks + 8 * fq, 16 * (2 * wid + c2) + fr, o); vf[c2] = mk8(o); }
#pragma unroll
            for (int ib = 0; ib < 8; ++ib) {
                if (ib >= 2 * ks) {
                    const bf16x8 wf = *(const LAS bf16x8*)(sW + (16 * ib + fr) * 272 + (32 * ks + 8 * fq) * 2);
#pragma unroll
                    for (int c2 = 0; c2 < 2; ++c2) acc[ib][c2] = __builtin_amdgcn_mfma_f32_16x16x32_bf16(vf[c2], wf, acc[ib][c2], 0, 0, 0);
                }
            }
        }
#pragma unroll
        for (int ib = 0; ib < 8; ++ib)
#pragma unroll
            for (int c2 = 0; c2 < 2; ++c2)
                *(u32x2*)(UO + (tok0 + 16 * ib + fr) * 1024 + g * 256 + 16 * (2 * wid + c2) + 4 * fq) = pack4((acc[ib][c2] + bvl[ib]) * unpack4(ul[ib][c2]));
    }
}

#define XB_TMO      128
#define XB_XCNT(j)  (256  + 64 * (j))
#define XB_XSUB(j)  (1280 + 64 * (j))
#define XB_XGEN(j)  (2304 + 64 * (j))
#define XB_TOP      3328
#define XB_TOPGEN   3392
#define XCD_BAR_WORDS 3456
#define XB_SPIN_CAP (1u << 22)
__device__ __forceinline__ unsigned xb_ld(unsigned* p)              { return __hip_atomic_load(p, __ATOMIC_RELAXED, __HIP_MEMORY_SCOPE_AGENT); }
__device__ __forceinline__ unsigned xb_add(unsigned* p, unsigned v) { return __hip_atomic_fetch_add(p, v, __ATOMIC_RELAXED, __HIP_MEMORY_SCOPE_AGENT); }
__device__ __forceinline__ unsigned xb_xcc_id() { return (unsigned)__builtin_amdgcn_s_getreg((3 << 11) | 20) & 0xFu; }
#define XB_SPIN(cond, bar) do { unsigned _sp = 0; while (cond) { __builtin_amdgcn_s_sleep(1); \
    if ((++_sp & 255u) == 0u) { if (xb_ld(&(bar)[XB_TMO])) break; if (_sp > XB_SPIN_CAP) { atomicAdd(&(bar)[XB_TMO], 1u); break; } } } } while (0)
struct XcdBarrier { unsigned* bar; unsigned x; volatile LAS unsigned* st; };
__device__ __forceinline__ XcdBarrier xcd_barrier_post(unsigned* bar, volatile LAS unsigned* st) {
    XcdBarrier b; b.bar = bar; b.x = xb_xcc_id(); b.st = st;
    if (threadIdx.x == 0) (void)xb_add(&bar[XB_XCNT(b.x)], 1u);
    return b;
}
__device__ __forceinline__ void xcd_barrier_complete(unsigned* bar, unsigned x, unsigned& nloc, unsigned& nx) {
    const unsigned G = gridDim.x * gridDim.y * gridDim.z;
    unsigned sum, cnt, mine, sp = 0u;
    for (;;) {
        sum = 0u; cnt = 0u; mine = 0u;
#pragma nounroll
        for (unsigned j = 0; j < 16; ++j) { const unsigned c = xb_ld(&bar[XB_XCNT(j)]); sum += c; cnt += (c > 0u) ? 1u : 0u; mine = (j == x) ? c : mine; }
        if (sum == G) break;
        __builtin_amdgcn_s_sleep(1);
        if ((++sp & 255u) == 0u) { if (xb_ld(&bar[XB_TMO])) break; if (sp > XB_SPIN_CAP) { atomicAdd(&bar[XB_TMO], 1u); break; } }
    }
    nloc = mine > 0u ? mine : 1u; nx = cnt > 0u ? cnt : 1u;
}
__device__ __forceinline__ void xcd_barrier(const XcdBarrier& b) {
    asm volatile("s_waitcnt vmcnt(0)" ::: "memory");
    __syncthreads();
    if (threadIdx.x == 0) {
        unsigned* bar = b.bar;
        __builtin_amdgcn_s_waitcnt(0);
        unsigned nloc = b.st[0], nx = b.st[1];
        if (nloc == 0u) { xcd_barrier_complete(bar, b.x, nloc, nx); b.st[0] = nloc; b.st[1] = nx; }
        const unsigned old = xb_add(&bar[XB_XSUB(b.x)], 1u);
        const unsigned gen = old / nloc;
        if (old + 1u == (gen + 1u) * nloc) {
            __builtin_amdgcn_fence(__ATOMIC_RELEASE, "agent");
            asm volatile("s_waitcnt vmcnt(0)" ::: "memory");
            const unsigned og = xb_add(&bar[XB_TOP], 1u);
            const unsigned tg = og / nx;
            if (og + 1u == (tg + 1u) * nx) xb_add(&bar[XB_TOPGEN], 1u);
            else XB_SPIN(xb_ld(&bar[XB_TOPGEN]) == tg, bar);
            __builtin_amdgcn_fence(__ATOMIC_ACQUIRE, "agent");
            xb_add(&bar[XB_XGEN(b.x)], 1u);
            asm volatile("s_waitcnt vmcnt(0)" ::: "memory");
        } else {
            XB_SPIN(xb_ld(&bar[XB_XGEN(b.x)]) == gen, bar);
            __builtin_amdgcn_fence(__ATOMIC_ACQUIRE, "agent");
            asm volatile("s_waitcnt vmcnt(0)" ::: "memory");
        }
    }
    __syncthreads();
}

#if defined(EXPM) && (EXPM & 64)
#define GSYNC() do { xcd_barrier(xbar); xcd_barrier(xbar); } while (0)
#else
#define GSYNC() xcd_barrier(xbar)
#endif
#define FRESH_IDS int tid_ = threadIdx.x; asm volatile("" : "+v"(tid_)); const int tid = tid_, wid = __builtin_amdgcn_readfirstlane(tid >> 6), lane = tid & 63; (void)wid; (void)lane;
__global__ void __launch_bounds__(NTHR, 2) mega(Params P) {
    extern __shared__ __attribute__((aligned(16))) unsigned char lds_raw[];
    LAS unsigned char* lds = (LAS unsigned char*)lds_raw;
    cg::grid_group grid = cg::this_grid();
    const int G = gridDim.x, bx = blockIdx.x;
    unsigned char* ws = P.ws;
    bf16_t* const WIN = (bf16_t*)(ws + WS_WIN); bf16_t* const WR = (bf16_t*)(ws + WS_WR); bf16_t* const WSG = (bf16_t*)(ws + WS_WS); bf16_t* const WO = (bf16_t*)(ws + WS_WO);
    bf16_t* const WG = (bf16_t*)(ws + WS_WG); bf16_t* const WPP = (bf16_t*)(ws + WS_WPP); bf16_t* const WC = (bf16_t*)(ws + WS_WC);
    float* const RSQ1 = (float*)(ws + WS_SV); float* const RSQ2 = (float*)(ws + WS_SV + 8 * MiB);
    bf16_t* const H = (bf16_t*)(ws + WS_H); bf16_t* const PB = (bf16_t*)(ws + WS_PB);
    bf16_t* const QK = (bf16_t*)(ws + WS_QK); bf16_t* const V = (bf16_t*)(ws + WS_V); bf16_t* const SV = (bf16_t*)(ws + WS_SV);
    bf16_t* const RG2 = (bf16_t*)(ws + WS_RG2); bf16_t* const UG2 = (bf16_t*)(ws + WS_UG2); bf16_t* const MR2 = (bf16_t*)(ws + WS_MR2); bf16_t* const MS2 = (bf16_t*)(ws + WS_MS2);
    bf16_t* const PREV = (bf16_t*)P.out;
    bf16_t* const MERGED = (bf16_t*)P.out; bf16_t* const X2B = H; bf16_t* const X1B = QK;
    bf16_t* const PP = (bf16_t*)(ws + WS_PP);
    volatile LAS unsigned* xst = (volatile LAS unsigned*)(lds + LDS_STAGE);
    if (threadIdx.x < 4) xst[threadIdx.x] = 0u;
    __syncthreads();
    const XcdBarrier xbar = xcd_barrier_post((unsigned*)(ws + WS_BAR), xst);

    { FRESH_IDS phase0(P, lds, tid, wid, lane); }
    if (P.ws == nullptr) grid.sync();

    for (int sl = 0; sl < NSL; ++sl) {
        const int tokb = sl * TS;
        bf16_t* const RG = RG2 + (size_t)tokb * 1024; bf16_t* const UG = UG2 + (size_t)tokb * 1024;
        GSYNC();
        {
            pg8::Src1V g{H + (size_t)tokb * 1024, WIN, 1024}; pg8::StaticOrder S; S.init(TS, 8192, G, bx);
            Epi1 E{QK, UG, (const float*)(ws + WS_COS), (const float*)(ws + WS_SIN), sl, (float*)((unsigned char*)P.out + 64 * MiB)};
            pg8::gemm_phase(lds, g, 1024, S, E);
        }
        GSYNC();
        { FRESH_IDS for (int u = bx; u < BSL * 32 * 4; u += G) p2_unit(lds, QK, V, PREV, u, tid, wid, lane); }
        { FRESH_IDS for (int c = bx; c < BSL * 32; c += G) p5_unit(lds, SV, (const float*)((unsigned char*)P.out + 64 * MiB), UG, WC, P.sbs, c, tid, wid, lane); }
        GSYNC();
        { FRESH_IDS
        for (int it = bx * NTHR + tid; it < BSL * 4 * 256 * 32; it += G * NTHR) {
            const int d4 = it & 31, e = (it >> 5) & 255, h = (it >> 13) & 3, bl = it >> 15;
            const float cd = fexp(128.0f * lgam(h));
            f32x4 run = (f32x4){0.f, 0.f, 0.f, 0.f};
            const size_t base = ((size_t)(bl * 32) * 4 + h) * 32768 + e * 128 + d4 * 4;
#pragma unroll 8
            for (int n = 0; n < 32; ++n) {
                const size_t o = base + (size_t)n * 4 * 32768;
                const f32x4 kv = unpack4(*(const u32x2*)(PREV + o));
                *(u32x2*)(PREV + o) = pack4(run);
                run = kv + run * cd;
            }
        } }
        GSYNC();
        { FRESH_IDS for (int u = bx; u < BSL * 32 * 4; u += G) p4_unit(lds, QK, V, PREV, RG, RG, u, tid, wid, lane); }
    }
    GSYNC();
    {
        pg8::Src2 g{RG2, WR, (long)((const char*)UG2 - (const char*)RG2), (long)((const char*)WSG - (const char*)WR), 1024}; pg8::DualOrder S; S.init(T_ALL, 1024, G, bx);
        Epi6 E{MR2, MS2, MERGED};
        pg8::gemm_phase(lds, g, 1024, S, E);
    }
    GSYNC();
    {
        pg8::Src1 g{MERGED, WO, 1024}; pg8::StaticOrder S; S.init(T_ALL, 1024, G, bx);
        Epi7 E{H, (const float*)(ws + WS_RS0), P.gm, X1B, RSQ1, 0};
        pg8::gemm_phase(lds, g, 1024, S, E);
        pg8::Src1 g2{PB, WPP, 256};
        EpiStore E2{PP};
        pg8::gemm_phase(lds, g2, 256, S, E2);
    }
    GSYNC();
    {
        pg8::Src1 g{X1B, WG, 1024}; pg8::StaticOrder S; S.init(T_ALL, 1024, G, bx);
        Epi8 E{X1B, X2B, PP, RSQ1, RSQ2, 0};
        pg8::gemm_phase(lds, g, 1024, S, E);
    }
    GSYNC();
    {
        FRESH_IDS
        f32x4 gv[4];
#pragma unroll
        for (int i = 0; i < 2; ++i) { gv[2 * i] = *(const f32x4*)(P.gf + lane * 8 + 512 * i); gv[2 * i + 1] = *(const f32x4*)(P.gf + lane * 8 + 512 * i + 4); }
        for (int row = bx * 8 + wid; row < T_ALL; row += G * 8) {
            float sq = RSQ2[(size_t)row * 16 + (lane & 15)]; sq += __shfl_xor(sq, 1); sq += __shfl_xor(sq, 2); sq += __shfl_xor(sq, 4); sq += __shfl_xor(sq, 8);
            const float rstd = rsqrtf(sq * (1.0f / 1024.0f) + 1e-6f); float* o = P.out + (size_t)row * 1024; const bf16_t* xr = X2B + (size_t)row * 1024;
#pragma unroll
            for (int i = 0; i < 2; ++i) { f32x4 a, b; unpack8(*(const u32x4*)(xr + lane * 8 + 512 * i), a, b);
                *(f32x4*)(o + lane * 8 + 512 * i) = a * rstd * gv[2 * i]; *(f32x4*)(o + lane * 8 + 512 * i + 4) = b * rstd * gv[2 * i + 1]; }
        }
    }
}

extern "C" void kernel_launch(void* const* d_in, const int* in_sizes, int n_in, void* d_out, int out_size, void* d_ws, size_t ws_size, hipStream_t stream) {
    static int grid_blocks = 0;
    if (grid_blocks == 0) {
        int dev = 0, cus = 0, per_cu = 0;
        hipGetDevice(&dev);
        hipDeviceGetAttribute(&cus, hipDeviceAttributeMultiprocessorCount, dev);
        if (hipFuncSetAttribute((const void*)mega, hipFuncAttributeMaxDynamicSharedMemorySize, LDS_BYTES) != hipSuccess) fprintf(stderr, "hipFuncSetAttribute failed\n");
        if (hipOccupancyMaxActiveBlocksPerMultiprocessor(&per_cu, (const void*)mega, NTHR, LDS_BYTES) != hipSuccess || per_cu < 1) { per_cu = 1; (void)hipGetLastError(); }
        grid_blocks = cus * (per_cu > 1 ? 1 : per_cu);
        if (ws_size < WS_END) fprintf(stderr, "workspace too small: %zu < %zu\n", ws_size, (size_t)WS_END);
    }
    Params p{};
    p.x = (const float*)d_in[0]; p.p = (const float*)d_in[1]; p.w_in = (const float*)d_in[2]; p.w_ret = (const float*)d_in[3]; p.w_sgu = (const float*)d_in[4];
    p.w_out = (const float*)d_in[5]; p.sws = (const float*)d_in[6]; p.sbs = (const float*)d_in[7]; p.wpg = (const float*)d_in[8]; p.wpp = (const float*)d_in[9];
    p.gm = (const float*)d_in[10]; p.gp = (const float*)d_in[11]; p.gf = (const float*)d_in[12];
    p.out = (float*)d_out; p.ws = (unsigned char*)d_ws;
    (void)hipMemsetAsync((char*)d_ws + WS_BAR, 0, XCD_BAR_WORDS * 4, stream);
    void* args[] = {&p};
    hipError_t e = hipLaunchCooperativeKernel((const void*)mega, dim3(grid_blocks), dim3(NTHR), args, LDS_BYTES, stream);
    if (e != hipSuccess) fprintf(stderr, "cooperative launch failed: %s (grid %d)\n", hipGetErrorString(e), grid_blocks);
}
```

```cpp
#include <hip/hip_runtime.h>
#include <hip/hip_cooperative_groups.h>
#include <cstdio>
namespace cg = cooperative_groups;

#define LAS __attribute__((address_space(3)))
typedef unsigned short bf16_t;
typedef short bf16x8 __attribute__((ext_vector_type(8)));
typedef float f32x4 __attribute__((ext_vector_type(4)));
typedef float f32x2 __attribute__((ext_vector_type(2)));
typedef unsigned u32x4 __attribute__((ext_vector_type(4)));
typedef unsigned u32x2 __attribute__((ext_vector_type(2)));

constexpr int T_ALL = 65536, DM = 1024, NSL = 2, TS = T_ALL / NSL, BSL = 16 / NSL;
constexpr int NTHR = 512;
constexpr int LDS_STAGE = 131072, LDS_BYTES = LDS_STAGE + 16;
constexpr size_t MiB = 1ull << 20;
constexpr size_t UB = (size_t)TS * 1024 * 2;
constexpr size_t WS_WIN = 0, WS_WR = 16 * MiB, WS_WS = 18 * MiB, WS_WO = 20 * MiB, WS_WG = 22 * MiB, WS_WPP = 24 * MiB, WS_WC = 24 * MiB + 512 * 1024,
                 WS_COS = 25 * MiB, WS_SIN = 26 * MiB, WS_RSQ1 = 27 * MiB, WS_RSQ2 = 27 * MiB + 256 * 1024, WS_BAR = 28 * MiB, WS_RS0 = 29 * MiB,
                 WS_H = 32 * MiB, WS_PB = 160 * MiB, WS_SL = 192 * MiB;
constexpr size_t WS_QK = WS_SL, WS_V = WS_SL + UB, WS_SV = WS_SL + 2 * UB, WS_RG2 = WS_SL + 3 * UB, WS_UG2 = WS_SL + 5 * UB, WS_MR2 = WS_SL + 7 * UB, WS_MS2 = WS_SL + 9 * UB,
                 WS_PP = WS_SL + 11 * UB, WS_END = WS_SL + 13 * UB;
static_assert(WS_END == 1024 * MiB, "workspace map");

__device__ __forceinline__ unsigned cvt_pk_bf16(float lo, float hi) { unsigned r; asm volatile("v_cvt_pk_bf16_f32 %0, %1, %2" : "=v"(r) : "v"(lo), "v"(hi)); return r; }
__device__ __forceinline__ float bf_lo(unsigned w) { return __uint_as_float(w << 16); }
__device__ __forceinline__ float bf_hi(unsigned w) { return __uint_as_float(w & 0xffff0000u); }
__device__ __forceinline__ float bf2f(unsigned short b) { return __uint_as_float(((unsigned)b) << 16); }
__device__ __forceinline__ float wave_sum(float v) {
#pragma unroll
    for (int o = 32; o >= 1; o >>= 1) v += __shfl_xor(v, o);
    return v;
}
__device__ __forceinline__ float sigmoidf_(float x) { return __builtin_amdgcn_rcpf(1.0f + __builtin_amdgcn_exp2f(-1.4426950408889634f * x)); }
__device__ __forceinline__ float fexp(float x) { return __builtin_amdgcn_exp2f(1.4426950408889634f * x); }
__device__ __forceinline__ f32x2 gelu_pk(f32x2 v) {
    const f32x2 av = __builtin_elementwise_abs(v), d = av * 0.2316418882f + 1.0f;
    f32x2 t; t.x = __builtin_amdgcn_rcpf(d.x); t.y = __builtin_amdgcn_rcpf(d.y);
    f32x2 q = t * 0.5307027145f + (-0.7265760135f); q = q * t + 0.7107068705f; q = q * t + (-0.142248368f); q = q * t + 0.127414796f; q = q * t;
    const f32x2 s = (v * v) * (-0.72134752044f);
    f32x2 e; e.x = __builtin_amdgcn_exp2f(s.x); e.y = __builtin_amdgcn_exp2f(s.y);
    const f32x2 m = v * (q * e), r = v - m;
    f32x2 o; o.x = v.x < 0.f ? m.x : r.x; o.y = v.y < 0.f ? m.y : r.y; return o;
}
__device__ __forceinline__ f32x4 gelu4(f32x4 v) { f32x2 a = gelu_pk((f32x2){v[0], v[1]}), b = gelu_pk((f32x2){v[2], v[3]}); return (f32x4){a.x, a.y, b.x, b.y}; }
__device__ __forceinline__ f32x4 sig4(f32x4 v) { return (f32x4){sigmoidf_(v[0]), sigmoidf_(v[1]), sigmoidf_(v[2]), sigmoidf_(v[3])}; }
__device__ __forceinline__ float lgam(int h) { return h == 0 ? -0.03174869831458027f : h == 1 ? -0.01574835696813892f : h == 2 ? -0.007843177461025892f : -0.003913899321136329f; }

namespace pg8 {
constexpr int BM = 256, BK = 64, HALF = 128, HTB = HALF * BK * 2, STAGE_BYTES = 8 * HTB, NXCD = 8, WGM = 8;
__host__ __device__ __forceinline__ int lds_byte(int r, int c) { const int st = (r >> 4) * 2 + (c >> 5), rr = r & 15, cc = c & 31, ob = rr * 64 + cc * 2; return st * 1024 + (ob ^ (((ob >> 9) & 1) << 5)); }
__host__ __device__ __forceinline__ void stage_rc(int b, int& R, int& C) { const int st = b / 1024, sb = b % 1024, swz = sb ^ (((sb >> 9) & 1) << 5); R = (st >> 1) * 16 + swz / 64; C = (st & 1) * 32 + (swz % 64) / 2; }
__host__ __device__ __forceinline__ int perm32(int rho) { const int n = rho >> 4, i = rho & 15; return 8 * (i >> 2) + 4 * n + (i & 3); }

struct Unit { int pm, pn, part; };
struct StaticOrder {
    int nM, nN, nwg, G, c;
    __device__ void init(int M, int N, int G_, int c_) { nM = M / BM; nN = N / BM; nwg = nM * nN; G = G_; c = c_; }
    __device__ bool next(int i, Unit& u) const {
        const long L = (long)i * G + c; if (L >= nwg) return false;
        int wgid = (int)L; { const int q = nwg / NXCD, r = nwg % NXCD, xcd = wgid % NXCD, off = wgid / NXCD; wgid = (xcd < r ? xcd * (q + 1) : r * (q + 1) + (xcd - r) * q) + off; }
        const int nig = WGM * nN, gid = wgid / nig, fm = gid * WGM, gsz = (nM - fm) < WGM ? (nM - fm) : WGM;
        u.pm = fm + ((wgid % nig) % gsz); u.pn = (wgid % nig) / gsz; u.part = 0; return true;
    }
};
struct DualOrder : StaticOrder {
    __device__ bool next(int i, Unit& u) const { if (!StaticOrder::next(i >> 1, u)) return false; u.part = i & 1; return true; }
};
struct Src1 { const bf16_t* A; const bf16_t* Bt; int K;
    __device__ __forceinline__ const char* a(const Unit& u) const { return (const char*)A + (size_t)u.pm * BM * K * 2; }
    __device__ __forceinline__ const char* b(const Unit& u) const { return (const char*)Bt + (size_t)u.pn * BM * K * 2; } };
struct Src1V { const bf16_t* A; const bf16_t* Bt; int K;
    __device__ __forceinline__ const char* a(const Unit& u) const { const char* pa = (const char*)A + (size_t)u.pm * BM * K * 2; const char* pb = (const char*)Bt + (size_t)u.pn * BM * K * 2; const long sw = (u.pn >= 4 && u.pn < 8) ? 1 : 0; return pa + sw * (long)(pb - pa); }
    __device__ __forceinline__ const char* b(const Unit& u) const { const char* pa = (const char*)A + (size_t)u.pm * BM * K * 2; const char* pb = (const char*)Bt + (size_t)u.pn * BM * K * 2; const long sw = (u.pn >= 4 && u.pn < 8) ? 1 : 0; return pb - sw * (long)(pb - pa); } };
struct Src2 { const bf16_t* A0; const bf16_t* B0; long dA, dB; int K;
    __device__ __forceinline__ const char* a(const Unit& u) const { return (const char*)A0 + (long)u.part * dA + (size_t)u.pm * BM * K * 2; }
    __device__ __forceinline__ const char* b(const Unit& u) const { return (const char*)B0 + (long)u.part * dB + (size_t)u.pn * BM * K * 2; } };

template <class Epi, class Sched, class Src>
__device__ __forceinline__ void gemm_phase(LAS unsigned char* lds, const Src& g, const int K, const Sched& S, const Epi& E) {
    int tid_ = threadIdx.x; asm volatile("" : "+v"(tid_));
    const int tid = tid_, wid = __builtin_amdgcn_readfirstlane(tid >> 6), lane = tid & 63, wr = wid >> 2, wc = wid & 3, fr = lane & 15, fq = lane >> 4;
    const int nt = K / BK;
    unsigned voffA[2], voffB[2];
#pragma unroll
    for (int i = 0; i < 2; ++i) { int R, C; stage_rc(tid * 16 + i * 8192, R, C); const int Rb = Epi::PERM ? ((R & ~31) + perm32(R & 31)) : R;
        voffA[i] = (unsigned)(R * K + C) * 2u; voffB[i] = (unsigned)(Rb * K + C) * 2u; }
    const size_t kstep = (size_t)(BK * 2);
    const size_t hstep = (size_t)HALF * K * 2;
    const unsigned ldsw = (unsigned)wid * 1024u;
    const int aoff = lds_byte(wr * 64 + fr, fq * 8), boff = lds_byte(wc * 32 + fr, fq * 8);
#define PG8_SA(b, h) (((b) * 2 + (h)) * HTB)
#define PG8_SB(b, h) ((4 + (b) * 2 + (h)) * HTB)
#define PG8_STAGE(bufoff, gbase, voff) do { _Pragma("unroll") for (int _i = 0; _i < 2; ++_i) \
        __builtin_amdgcn_global_load_lds((const unsigned*)((const char*)(gbase) + (voff)[_i]), (LAS unsigned*)(lds + (bufoff) + ldsw + _i * 8192), 16, 0, 0); } while (0)
#define PG8_LDA(dst, b, h) do { _Pragma("unroll") for (int m = 0; m < 4; ++m) _Pragma("unroll") for (int k = 0; k < 2; ++k) dst[m][k] = *(const LAS bf16x8*)(lds + PG8_SA(b, h) + aoff + m * 2048 + k * 1024); } while (0)
#define PG8_LDB(dst, b, h) do { _Pragma("unroll") for (int n = 0; n < 2; ++n) _Pragma("unroll") for (int k = 0; k < 2; ++k) dst[n][k] = *(const LAS bf16x8*)(lds + PG8_SB(b, h) + boff + n * 2048 + k * 1024); } while (0)
#define PG8_MMA(ai, bj, At, Bt) do { __builtin_amdgcn_s_setprio(1); _Pragma("unroll") for (int m = 0; m < 4; ++m) _Pragma("unroll") for (int n = 0; n < 2; ++n) _Pragma("unroll") for (int k = 0; k < 2; ++k) \
        acc[ai][bj][m][n] = __builtin_amdgcn_mfma_f32_16x16x32_bf16(Bt[n][k], At[m][k], acc[ai][bj][m][n], 0, 0, 0); __builtin_amdgcn_s_setprio(0); } while (0)
#define PG8_WAIT_V(n) asm volatile("s_waitcnt vmcnt(" #n ")" ::: "memory")
#define PG8_WAIT_L(n) asm volatile("s_waitcnt lgkmcnt(" #n ")" ::: "memory")
#define PG8_BAR __builtin_amdgcn_s_barrier()
#define PG8_SCHED __builtin_amdgcn_sched_barrier(0)
    Unit cur, nxt; int ui = 0;
    if (!S.next(0, cur)) return;
    f32x4 acc[2][2][4][2];
#pragma unroll
    for (int a = 0; a < 2; ++a)
#pragma unroll
        for (int b = 0; b < 2; ++b)
#pragma unroll
            for (int m = 0; m < 4; ++m)
#pragma unroll
                for (int n = 0; n < 2; ++n) acc[a][b][m][n] = (f32x4){0.f, 0.f, 0.f, 0.f};
    bf16x8 At[4][2], B0[2][2], B1[2][2];
    const char* cA = g.a(cur); const char* cB = g.b(cur);
    PG8_STAGE(PG8_SB(0, 0), cB, voffB); PG8_STAGE(PG8_SA(0, 0), cA, voffA); PG8_STAGE(PG8_SB(0, 1), cB + hstep, voffB); PG8_STAGE(PG8_SA(0, 1), cA + hstep, voffA);
    if (wr == 1) PG8_BAR;
    PG8_WAIT_V(4); PG8_BAR;
    PG8_STAGE(PG8_SB(1, 0), cB + kstep, voffB); PG8_STAGE(PG8_SA(1, 0), cA + kstep, voffA); PG8_STAGE(PG8_SB(1, 1), cB + hstep + kstep, voffB);
    PG8_WAIT_V(6); PG8_BAR;
    for (;;) {
        const bool has_next = S.next(ui + 1, nxt);
        const char* nA = has_next ? g.a(nxt) : cA; const char* nB = has_next ? g.b(nxt) : cB;
        for (int t = 0; t < nt; t += 2) {
            const bool last = (t == nt - 2);
            const char* a1 = cA + (size_t)(t + 1) * kstep;
            const char* a2 = last ? nA : cA + (size_t)(t + 2) * kstep; const char* b2 = last ? nB : cB + (size_t)(t + 2) * kstep;
            const char* a3 = a2 + kstep; const char* b3 = b2 + kstep;
            PG8_LDB(B0, 0, 0); PG8_SCHED; PG8_LDA(At, 0, 0); PG8_STAGE(PG8_SA(1, 1), a1 + hstep, voffA);
            PG8_WAIT_L(8); PG8_BAR; PG8_WAIT_L(0); PG8_MMA(0, 0, At, B0); PG8_BAR; PG8_SCHED;
            PG8_LDB(B1, 0, 1); PG8_STAGE(PG8_SB(0, 0), b2, voffB);
            PG8_BAR; PG8_WAIT_L(0); PG8_MMA(0, 1, At, B1); PG8_BAR;
            PG8_LDA(At, 0, 1); PG8_STAGE(PG8_SA(0, 0), a2, voffA);
            PG8_BAR; PG8_WAIT_L(0); PG8_MMA(1, 0, At, B0); PG8_BAR; PG8_SCHED;
            PG8_STAGE(PG8_SB(0, 1), b2 + hstep, voffB);
            PG8_WAIT_V(6); PG8_BAR; PG8_MMA(1, 1, At, B1); PG8_BAR;
            PG8_LDB(B0, 1, 0); PG8_SCHED; PG8_LDA(At, 1, 0); PG8_STAGE(PG8_SA(0, 1), a2 + hstep, voffA);
            PG8_WAIT_L(8); PG8_BAR; PG8_WAIT_L(0); PG8_MMA(0, 0, At, B0); PG8_BAR; PG8_SCHED;
            PG8_LDB(B1, 1, 1); PG8_STAGE(PG8_SB(1, 0), b3, voffB);
            PG8_BAR; PG8_WAIT_L(0); PG8_MMA(0, 1, At, B1); PG8_BAR;
            PG8_LDA(At, 1, 1); PG8_STAGE(PG8_SA(1, 0), a3, voffA);
            PG8_BAR; PG8_WAIT_L(0); PG8_MMA(1, 0, At, B0); PG8_BAR; PG8_SCHED;
            PG8_STAGE(PG8_SB(1, 1), b3 + hstep, voffB);
            PG8_WAIT_V(6); PG8_BAR; PG8_MMA(1, 1, At, B1); PG8_BAR;
        }
        {
            int epm = cur.pm, epn = cur.pn, efr = fr, efq = fq; asm volatile("" : "+s"(epm), "+s"(epn), "+v"(efr), "+v"(efq));
            const Unit eu{epm, epn, cur.part};
            E(acc, eu, wr, wc, efr, efq);
        }
        if (!has_next) break;
        if (!E.keep(cur)) {
#pragma unroll
            for (int a = 0; a < 2; ++a)
#pragma unroll
                for (int b = 0; b < 2; ++b)
#pragma unroll
                    for (int m = 0; m < 4; ++m)
#pragma unroll
                        for (int n = 0; n < 2; ++n) acc[a][b][m][n] = (f32x4){0.f, 0.f, 0.f, 0.f};
        }
        cur = nxt; cA = nA; cB = nB; ++ui;
    }
    PG8_WAIT_V(0);
    if (wr == 0) PG8_BAR;
    PG8_BAR;
#undef PG8_SA
#undef PG8_SB
#undef PG8_STAGE
#undef PG8_LDA
#undef PG8_LDB
#undef PG8_MMA
#undef PG8_WAIT_V
#undef PG8_WAIT_L
#undef PG8_BAR
#undef PG8_SCHED
}
}
using pg8::Unit;
typedef f32x4 AccT[2][2][4][2];

__device__ __forceinline__ u32x4 pack8(f32x4 a, f32x4 b) { u32x4 w; w.x = cvt_pk_bf16(a[0], a[1]); w.y = cvt_pk_bf16(a[2], a[3]); w.z = cvt_pk_bf16(b[0], b[1]); w.w = cvt_pk_bf16(b[2], b[3]); return w; }
__device__ __forceinline__ u32x2 pack4(f32x4 a) { u32x2 w; w.x = cvt_pk_bf16(a[0], a[1]); w.y = cvt_pk_bf16(a[2], a[3]); return w; }
__device__ __forceinline__ void unpack8(u32x4 w, f32x4& a, f32x4& b) { a = (f32x4){bf_lo(w.x), bf_hi(w.x), bf_lo(w.y), bf_hi(w.y)}; b = (f32x4){bf_lo(w.z), bf_hi(w.z), bf_lo(w.w), bf_hi(w.w)}; }
__device__ __forceinline__ f32x4 unpack4(u32x2 w) { return (f32x4){bf_lo(w.x), bf_hi(w.x), bf_lo(w.y), bf_hi(w.y)}; }

struct Epi1 {
    static constexpr bool PERM = true;
    bf16_t *QK, *UG; const float* cs; const float* sn; int sl; float* svs;
    __device__ __forceinline__ bool keep(const Unit&) const { return false; }
    __device__ __forceinline__ void operator()(AccT& acc, const Unit& u, int wr, int wc, int fr, int fq) const {
        const int pn = u.pn, cl = wc * 32 + 8 * fq, row0 = u.pm * 256 + wr * 64 + fr;
        if (pn < 4) {
            const int isk = pn >> 1, t = pn & 1, head = 2 * t + (cl >> 6), dim0 = cl & 63;
            const float sc = isk ? 1.0f : 0.08838834764831845f;
            bf16_t* base = QK + isk * 512 + head * 128 + dim0;
            f32x4 tb[2][2][4];
#define ROT_LD(b, buf) do { _Pragma("unroll") for (int mm = 0; mm < 2; ++mm) { const int pos_ = (row0 + ((b) >> 1) * 128 + (((b) & 1) * 2 + mm) * 16) & 4095; \
                tb[buf][mm][0] = *(const f32x4*)(cs + pos_ * 64 + dim0); tb[buf][mm][1] = *(const f32x4*)(cs + pos_ * 64 + dim0 + 4); \
                tb[buf][mm][2] = *(const f32x4*)(sn + pos_ * 64 + dim0); tb[buf][mm][3] = *(const f32x4*)(sn + pos_ * 64 + dim0 + 4); } } while (0)
            ROT_LD(0, 0);
#pragma unroll
            for (int b = 0; b < 4; ++b) {
                if (b + 1 < 4) ROT_LD(b + 1, (b + 1) & 1);
#pragma unroll
                for (int mm = 0; mm < 2; ++mm) {
                    const int ai = b >> 1, m = (b & 1) * 2 + mm, row = row0 + ai * 128 + m * 16;
                    const f32x4 c0 = tb[b & 1][mm][0], c1 = tb[b & 1][mm][1], s0 = tb[b & 1][mm][2], s1 = tb[b & 1][mm][3];
                    const f32x4 x1a = acc[ai][0][m][0], x1b = acc[ai][0][m][1], x2a = acc[ai][1][m][0], x2b = acc[ai][1][m][1];
                    const f32x4 o1a = (x1a * c0 - x2a * s0) * sc, o1b = (x1b * c1 - x2b * s1) * sc, o2a = (x2a * c0 + x1a * s0) * sc, o2b = (x2b * c1 + x1b * s1) * sc;
                    *(u32x4*)(base + (size_t)row * 1024) = pack8(o1a, o1b);
                    *(u32x4*)(base + (size_t)row * 1024 + 64) = pack8(o2a, o2b);
                }
            }
#undef ROT_LD
        } else if (pn >= 12 && pn < 20) {
            bf16_t* base = UG + 128 * (pn - 12) + cl;
#pragma unroll
            for (int ai = 0; ai < 2; ++ai)
#pragma unroll
                for (int m = 0; m < 4; ++m) {
                    const int row = row0 + ai * 128 + m * 16;
                    const f32x4 ua = gelu4(acc[ai][0][m][0]), ub = gelu4(acc[ai][0][m][1]);
                    const f32x4 ga = acc[ai][1][m][0], gb = acc[ai][1][m][1];
                    *(u32x4*)(base + (size_t)row * 1024) = pack8(ua * ga * sig4(ga), ub * gb * sig4(gb));
                }
        } else if (pn >= 24) {
            bf16_t* rbase = QK + (size_t)(3 + 2 * NSL + sl) * ((size_t)TS * 1024) + 128 * (pn - 24) + cl;
            bf16_t* sbase = QK + (size_t)(3 + 3 * NSL + sl) * ((size_t)TS * 1024) + 128 * (pn - 24) + cl;
#pragma unroll
            for (int ai = 0; ai < 2; ++ai)
#pragma unroll
                for (int m = 0; m < 4; ++m) {
                    const int row = row0 + ai * 128 + m * 16;
                    f32x4 r[2], sg[2];
#pragma unroll
                    for (int n = 0; n < 2; ++n) {
                        const f32x4 b = acc[ai][1][m][n];
                        const f32x4 one = (f32x4){1.0f + __builtin_amdgcn_exp2f(-1.4426950408889634f * b[0]), 1.0f + __builtin_amdgcn_exp2f(-1.4426950408889634f * b[1]),
                                                  1.0f + __builtin_amdgcn_exp2f(-1.4426950408889634f * b[2]), 1.0f + __builtin_amdgcn_exp2f(-1.4426950408889634f * b[3])};
                        sg[n] = (f32x4){__builtin_amdgcn_rcpf(one[0]), __builtin_amdgcn_rcpf(one[1]), __builtin_amdgcn_rcpf(one[2]), __builtin_amdgcn_rcpf(one[3])};
                        r[n] = sig4(acc[ai][0][m][n]) * one;
                    }
                    *(u32x4*)(rbase + (size_t)row * 1024) = pack8(r[0], r[1]);
                    *(u32x4*)(sbase + (size_t)row * 1024) = pack8(sg[0], sg[1]);
                    asm volatile("" ::: "memory");
                }
        } else if (pn < 8) {
            bf16_t* vt = QK + (size_t)TS * 1024;
#pragma unroll
            for (int ai = 0; ai < 2; ++ai)
#pragma unroll
                for (int m = 0; m < 4; ++m) {
                    const int e = ai * 128 + wr * 64 + m * 16 + fr;
#pragma unroll
                    for (int bj = 0; bj < 2; ++bj)
                        *(u32x4*)(vt + (((size_t)(u.pm * 2 + bj) * 4 + (pn - 4)) * 256 + e) * 128 + cl) = pack8(acc[ai][bj][m][0], acc[ai][bj][m][1]);
                }
        } else {
            const int act = pn < 8 ? 0 : pn < 12 ? 1 : pn < 24 ? 2 : 3;
            const int bidx = pn < 8 ? 1 : pn < 12 ? 3 + sl : pn < 24 ? 2 : pn < 28 ? 7 + sl : 9 + sl;
            const int tl = pn < 8 ? pn - 4 : pn < 12 ? pn - 8 : pn < 24 ? pn - 20 : pn < 28 ? pn - 24 : pn - 28;
            bf16_t* base = QK + (size_t)bidx * ((size_t)TS * 1024) + tl * 256 + cl;
#pragma unroll
            for (int ai = 0; ai < 2; ++ai)
#pragma unroll
                for (int m = 0; m < 4; ++m) {
                    const int row = row0 + ai * 128 + m * 16; float ssum = 0.f, ssq = 0.f;
#pragma unroll
                    for (int bj = 0; bj < 2; ++bj) {
                        f32x4 a = acc[ai][bj][m][0], b = acc[ai][bj][m][1];
                        if (act == 1) { a = a * sig4(a); b = b * sig4(b); }
                        else if (act == 2) { a = gelu4(a); b = gelu4(b);
                            ssum += ((a[0] + a[1]) + (a[2] + a[3])) + ((b[0] + b[1]) + (b[2] + b[3]));
                            ssq += ((a[0] * a[0] + a[1] * a[1]) + (a[2] * a[2] + a[3] * a[3])) + ((b[0] * b[0] + b[1] * b[1]) + (b[2] * b[2] + b[3] * b[3])); }
                        else if (act == 3) { a = sig4(a); b = sig4(b); }
                        *(u32x4*)(base + (size_t)row * 1024 + bj * 128) = pack8(a, b);
                    }
                    if (act == 2) {
                        ssum += __shfl_xor(ssum, 16); ssum += __shfl_xor(ssum, 32); ssq += __shfl_xor(ssq, 16); ssq += __shfl_xor(ssq, 32);
                        if (fq == 0) *(f32x2*)(svs + (size_t)row * 32 + tl * 8 + wc * 2) = (f32x2){ssum, ssq};
                    }
                }
        }
    }
};
struct Epi6 {
    static constexpr bool PERM = true;
    const bf16_t* MR; const bf16_t* MS; bf16_t* O;
    __device__ __forceinline__ bool keep(const Unit& u) const { return u.part == 0; }
    __device__ __forceinline__ void operator()(AccT& acc, const Unit& u, int wr, int wc, int fr, int fq) const {
        const int row0 = u.pm * 256 + wr * 64 + fr, col0 = u.pn * 256 + wc * 32 + 8 * fq;
        u32x4 sb[4][2];
#define E6_LD(g) do { _Pragma("unroll") for (int bj = 0; bj < 2; ++bj) { const size_t off_ = (size_t)(row0 + ((g) >> 2) * 128 + ((g) & 3) * 16) * 1024 + col0 + bj * 128; \
            if (u.part == 0) sb[(g) & 3][bj] = *(const u32x4*)(MR + off_); else sb[(g) & 3][bj] = *(const u32x4*)(MS + off_); } } while (0)
        E6_LD(0); E6_LD(1); E6_LD(2);
#pragma unroll
        for (int g = 0; g < 8; ++g) {
            if (g + 3 < 8) E6_LD(g + 3);
            const int ai = g >> 2, m = g & 3;
#pragma unroll
            for (int bj = 0; bj < 2; ++bj) {
                const size_t off = (size_t)(row0 + ai * 128 + m * 16) * 1024 + col0 + bj * 128;
                f32x4 sa, sbv; unpack8(sb[g & 3][bj], sa, sbv);
                if (u.part == 0) {
#pragma unroll
                    for (int j = 0; j < 4; ++j) { acc[ai][bj][m][0][j] *= sa[j]; acc[ai][bj][m][1][j] *= sbv[j]; }
                } else {
                    *(u32x4*)(O + off) = pack8(acc[ai][bj][m][0] * sa, acc[ai][bj][m][1] * sbv);
                }
            }
        }
#undef E6_LD
    }
};
struct EpiStore {
    static constexpr bool PERM = true;
    bf16_t* O;
    __device__ __forceinline__ bool keep(const Unit&) const { return false; }
    __device__ __forceinline__ void operator()(AccT& acc, const Unit& u, int wr, int wc, int fr, int fq) const {
        const int row0 = u.pm * 256 + wr * 64 + fr, col0 = u.pn * 256 + wc * 32 + 8 * fq;
#pragma unroll
        for (int ai = 0; ai < 2; ++ai)
#pragma unroll
            for (int m = 0; m < 4; ++m)
#pragma unroll
                for (int bj = 0; bj < 2; ++bj)
                    *(u32x4*)(O + (size_t)(row0 + ai * 128 + m * 16) * 1024 + col0 + bj * 128) = pack8(acc[ai][bj][m][0], acc[ai][bj][m][1]);
    }
};
struct Epi7 {
    static constexpr bool PERM = true;
    const bf16_t* hb; const float* rs0; const float* gm; bf16_t* X1B; float* rsq; int tok0;
    __device__ __forceinline__ bool keep(const Unit&) const { return false; }
    __device__ __forceinline__ void operator()(AccT& acc, const Unit& u, int wr, int wc, int fr, int fq) const {
        const int row0 = u.pm * 256 + wr * 64 + fr, col0 = u.pn * 256 + wc * 32 + 8 * fq;
        f32x4 ig[2][2];
#pragma unroll
        for (int bj = 0; bj < 2; ++bj)
#pragma unroll
            for (int n = 0; n < 2; ++n) { const f32x4 g4 = *(const f32x4*)(gm + col0 + bj * 128 + n * 4);
                ig[bj][n] = (f32x4){__builtin_amdgcn_rcpf(g4[0]), __builtin_amdgcn_rcpf(g4[1]), __builtin_amdgcn_rcpf(g4[2]), __builtin_amdgcn_rcpf(g4[3])}; }
        u32x4 xb[4][2]; float rsv[4];
#define E7_LD(g) do { const size_t tr_ = (size_t)tok0 + row0 + ((g) >> 2) * 128 + ((g) & 3) * 16; rsv[(g) & 3] = rs0[tr_]; \
            _Pragma("unroll") for (int bj = 0; bj < 2; ++bj) xb[(g) & 3][bj] = *(const u32x4*)(hb + tr_ * 1024 + col0 + bj * 128); } while (0)
        E7_LD(0); E7_LD(1); E7_LD(2);
#pragma unroll
        for (int g = 0; g < 8; ++g) {
            if (g + 3 < 8) E7_LD(g + 3);
            const int ai = g >> 2, m = g & 3, row = row0 + ai * 128 + m * 16; const size_t tok = (size_t)tok0 + row; float ss = 0.f;
            const float sr = rsv[g & 3];
#pragma unroll
            for (int bj = 0; bj < 2; ++bj) {
                f32x4 ha, hb2; unpack8(xb[g & 3][bj], ha, hb2);
                const f32x4 o0 = ha * sr * ig[bj][0] + acc[ai][bj][m][0], o1 = hb2 * sr * ig[bj][1] + acc[ai][bj][m][1];
                *(u32x4*)(X1B + (size_t)row * 1024 + col0 + bj * 128) = pack8(o0, o1);
                ss += ((o0[0] * o0[0] + o0[1] * o0[1]) + (o0[2] * o0[2] + o0[3] * o0[3])) + ((o1[0] * o1[0] + o1[1] * o1[1]) + (o1[2] * o1[2] + o1[3] * o1[3]));
            }
            ss += __shfl_xor(ss, 16); ss += __shfl_xor(ss, 32);
            if (fq == 0) rsq[tok * 16 + u.pn * 4 + wc] = ss;
        }
#undef E7_LD
    }
};
struct Epi8 {
    static constexpr bool PERM = true;
    const bf16_t* X1B; bf16_t* X2B; const bf16_t* PP; const float* rsq1; float* rsq2; int tok0;
    __device__ __forceinline__ bool keep(const Unit&) const { return false; }
    __device__ __forceinline__ void operator()(AccT& acc, const Unit& u, int wr, int wc, int fr, int fq) const {
        const int row0 = u.pm * 256 + wr * 64 + fr, col0 = u.pn * 256 + wc * 32 + 8 * fq;
        float rs[8];
        {   f32x4 sl[8];
#pragma unroll
            for (int r = 0; r < 8; ++r) sl[r] = *(const f32x4*)(rsq1 + ((size_t)tok0 + row0 + (r >> 2) * 128 + (r & 3) * 16) * 16 + 4 * fq);
#pragma unroll
            for (int r = 0; r < 8; ++r) { float t = (sl[r][0] + sl[r][1]) + (sl[r][2] + sl[r][3]); t += __shfl_xor(t, 16); t += __shfl_xor(t, 32); rs[r] = t; } }
        u32x4 pb[4][2], xb[4][2];
#define E8_LD(g) do { _Pragma("unroll") for (int bj = 0; bj < 2; ++bj) { \
            const size_t off_ = (size_t)(row0 + ((g) >> 2) * 128 + ((g) & 3) * 16) * 1024 + col0 + bj * 128; \
            pb[(g) & 3][bj] = *(const u32x4*)(PP + off_); xb[(g) & 3][bj] = *(const u32x4*)(X1B + off_); } } while (0)
        E8_LD(0); E8_LD(1); E8_LD(2);
#pragma unroll
        for (int g = 0; g < 8; ++g) {
            if (g + 3 < 8) E8_LD(g + 3);
            const int ai = g >> 2, m = g & 3, row = row0 + ai * 128 + m * 16; const size_t tok = (size_t)tok0 + row; float ss = 0.f;
            const float rstd = rsqrtf(rs[g] * (1.0f / 1024.0f) + 1e-6f);
#pragma unroll
            for (int bj = 0; bj < 2; ++bj) {
                const size_t off = (size_t)row * 1024 + col0 + bj * 128;
                f32x4 pa, pc, xa, xc; unpack8(pb[g & 3][bj], pa, pc); unpack8(xb[g & 3][bj], xa, xc);
                const f32x4 o0 = xa + sig4(acc[ai][bj][m][0] * rstd) * pa, o1 = xc + sig4(acc[ai][bj][m][1] * rstd) * pc;
                *(u32x4*)(X2B + off) = pack8(o0, o1);
                ss += ((o0[0] * o0[0] + o0[1] * o0[1]) + (o0[2] * o0[2] + o0[3] * o0[3])) + ((o1[0] * o1[0] + o1[1] * o1[1]) + (o1[2] * o1[2] + o1[3] * o1[3]));
            }
            ss += __shfl_xor(ss, 16); ss += __shfl_xor(ss, 32);
            if (fq == 0) rsq2[tok * 16 + u.pn * 4 + wc] = ss;
        }
#undef E8_LD
    }
};

__device__ __forceinline__ int srccol_win(int np) {
    const int pn = np >> 8, L = np & 255;
    if (pn < 4) { const int isk = pn >> 1, t = pn & 1, half = L >> 7, i = L & 127, head = 2 * t + (i >> 6), dim = (i & 63) + 64 * half; return isk * 512 + head * 128 + dim; }
    if (pn < 8) return 1024 + (pn - 4) * 256 + L;
    if (pn < 12) return 2048 + (pn - 8) * 256 + L;
    if (pn < 20) { const int t = pn - 12; return L < 128 ? 3072 + 128 * t + L : 5120 + 128 * t + (L - 128); }
    if (pn < 24) return 4096 + (pn - 20) * 256 + L;
    { const int t = pn - 24; return L < 128 ? 6144 + 128 * t + L : 7168 + 128 * t + (L - 128); }
}
__device__ __forceinline__ void p0_transpose(LAS float* tile, const float* src, int ldsrc, int k0, int c0, bf16_t* dst, int ldk, int n0, const float* kscale, int tid) {
#pragma unroll
    for (int p = 0; p < 2; ++p) {
        const int r = (tid >> 4) + 32 * p, c4 = (tid & 15) * 4;
        const f32x4 v = *(const f32x4*)(src + (size_t)(k0 + r) * ldsrc + c0 + c4);
        const float s = kscale ? kscale[k0 + r] : 1.0f;
        tile[r * 65 + c4 + 0] = v[0] * s; tile[r * 65 + c4 + 1] = v[1] * s; tile[r * 65 + c4 + 2] = v[2] * s; tile[r * 65 + c4 + 3] = v[3] * s;
    }
    __syncthreads();
    {
        const int n = tid >> 3, kc = (tid & 7) * 8;
        u32x4 w;
        w.x = cvt_pk_bf16(tile[(kc + 0) * 65 + n], tile[(kc + 1) * 65 + n]); w.y = cvt_pk_bf16(tile[(kc + 2) * 65 + n], tile[(kc + 3) * 65 + n]);
        w.z = cvt_pk_bf16(tile[(kc + 4) * 65 + n], tile[(kc + 5) * 65 + n]); w.w = cvt_pk_bf16(tile[(kc + 6) * 65 + n], tile[(kc + 7) * 65 + n]);
        *(u32x4*)(dst + (size_t)(n0 + n) * ldk + k0 + kc) = w;
    }
    __syncthreads();
}

struct Params { const float *x, *p, *w_in, *w_ret, *w_sgu, *w_out, *sws, *sbs, *wpg, *wpp, *gm, *gp, *gf; float* out; unsigned char* ws; };

__device__ __forceinline__ void phase0(const Params& P, LAS unsigned char* lds, int tid, int wid, int lane) {
    unsigned char* ws = P.ws;
    const int G = gridDim.x, bx = blockIdx.x;
    LAS float* tile = (LAS float*)lds;
    for (int idx = bx; idx < 3136; idx += G) {
        if (idx < 2048) { const int kt = idx & 15, ntl = idx >> 4; p0_transpose(tile, P.w_in, 8192, kt * 64, srccol_win(ntl * 64), (bf16_t*)(ws + WS_WIN), 1024, ntl * 64, nullptr, tid); }
        else if (idx < 3072) { const int w = (idx - 2048) >> 8, r = (idx - 2048) & 255, kt = r & 15, ntl = r >> 4;
            const float* src = w == 0 ? P.w_ret : w == 1 ? P.w_sgu : w == 2 ? P.w_out : P.wpg;
            bf16_t* dst = (bf16_t*)(ws + (w == 0 ? WS_WR : w == 1 ? WS_WS : w == 2 ? WS_WO : WS_WG));
            p0_transpose(tile, src, 1024, kt * 64, ntl * 64, dst, 1024, ntl * 64, w == 3 ? P.gp : nullptr, tid); }
        else { const int r = idx - 3072, kt = r & 3, ntl = r >> 2; p0_transpose(tile, P.wpp, 1024, kt * 64, ntl * 64, (bf16_t*)(ws + WS_WPP), 256, ntl * 64, nullptr, tid); }
    }
    const int gt = bx * NTHR + tid, gn = G * NTHR;
    for (int i = gt; i < 4 * 128 * 128; i += gn) { const int r = (i >> 7) & 127, c = i & 127; const float v = c <= r ? P.sws[i] : 0.0f; ((bf16_t*)(ws + WS_WC))[i] = (bf16_t)(cvt_pk_bf16(v, 0.f) & 0xffffu); }
    for (int i = gt; i < 4096 * 64; i += gn) {
        const int pos = i >> 6, j = i & 63;
        const float inv = exp2f(-(float)j * (13.287712379549449f / 64.0f));
        const float ang = (float)pos * inv;
        const double a = (double)ang; const double nrev = rint(a * 0.15915494309189535); const float r = (float)(a - nrev * 6.283185307179586);
        ((float*)(ws + WS_COS))[i] = cosf(r); ((float*)(ws + WS_SIN))[i] = sinf(r);
    }
    for (size_t i = (size_t)gt * 8; i < (size_t)T_ALL * 256; i += (size_t)gn * 8) {
        const f32x4 a = *(const f32x4*)(P.p + i), b = *(const f32x4*)(P.p + i + 4);
        *(u32x4*)((bf16_t*)(ws + WS_PB) + i) = pack8(a, b);
    }
    {
        f32x4 gv[4];
#pragma unroll
        for (int i = 0; i < 4; ++i) gv[i] = *(const f32x4*)(P.gm + lane * 4 + 256 * i);
        for (int row = bx * 8 + wid; row < T_ALL; row += G * 8) {
            const float* xr = P.x + (size_t)row * 1024; f32x4 v[4]; float ss = 0.f;
#pragma unroll
            for (int i = 0; i < 4; ++i) { v[i] = *(const f32x4*)(xr + lane * 4 + 256 * i); ss += (v[i][0] * v[i][0] + v[i][1] * v[i][1]) + (v[i][2] * v[i][2] + v[i][3] * v[i][3]); }
            ss = wave_sum(ss);
            const float rstd = rsqrtf(ss * (1.0f / 1024.0f) + 1e-6f);
            if (lane == 0) ((float*)(ws + WS_RS0))[row] = sqrtf(ss * (1.0f / 1024.0f) + 1e-6f);
            bf16_t* hr = (bf16_t*)(ws + WS_H) + (size_t)row * 1024;
#pragma unroll
            for (int i = 0; i < 4; ++i) *(u32x2*)(hr + lane * 4 + 256 * i) = pack4(v[i] * rstd * gv[i]);
        }
    }
}

template <int ROWS, int COLS> struct TileRegs { u32x4 v[ROWS * (COLS / 8) / NTHR]; };
template <int ROWS, int COLS>
__device__ __forceinline__ void tile_load(TileRegs<ROWS, COLS>& t, const bf16_t* src, size_t gp, int tid) {
    constexpr int CPR = COLS / 8, IT = ROWS * CPR / NTHR;
#pragma unroll
    for (int i = 0; i < IT; ++i) { const int c = tid + i * NTHR, r = c / CPR, ch = c % CPR; t.v[i] = *(const u32x4*)(src + (size_t)r * gp + ch * 8); }
}
template <int ROWS, int COLS>
__device__ __forceinline__ void tile_store_b128(const TileRegs<ROWS, COLS>& t, LAS unsigned char* dst, int lp, int tid) {
    constexpr int CPR = COLS / 8, IT = ROWS * CPR / NTHR;
#pragma unroll
    for (int i = 0; i < IT; ++i) { const int c = tid + i * NTHR, r = c / CPR, ch = c % CPR; *(LAS u32x4*)(dst + r * lp + ch * 16) = t.v[i]; }
}
template <int ROWS, int COLS>
__device__ __forceinline__ void tile_store_b32(const TileRegs<ROWS, COLS>& t, LAS unsigned char* dst, int lp, int tid) {
    constexpr int CPR = COLS / 8, IT = ROWS * CPR / NTHR;
#pragma unroll
    for (int i = 0; i < IT; ++i) { const int c = tid + i * NTHR, r = c / CPR, ch = c % CPR; LAS unsigned* d = (LAS unsigned*)(dst + r * lp + ch * 16); d[0] = t.v[i].x; d[1] = t.v[i].y; d[2] = t.v[i].z; d[3] = t.v[i].w; }
}
__device__ __forceinline__ void gather8(const LAS unsigned char* base, int pitch, int r0, int col, unsigned short (&o)[8]) {
    const LAS unsigned char* p = base + r0 * pitch + col * 2;
#pragma unroll
    for (int j = 0; j < 8; ++j) o[j] = *(const LAS unsigned short*)(p + j * pitch);
}
__device__ __forceinline__ bf16x8 mk8(const unsigned short (&o)[8]) { bf16x8 r;
#pragma unroll
    for (int j = 0; j < 8; ++j) r[j] = (short)o[j];
    return r; }

__device__ __forceinline__ void p2_unit(LAS unsigned char* lds, const bf16_t* QK, const bf16_t* V, bf16_t* KV, int unit, int tid, int wid, int lane) {
    const int fr = lane & 15, fq = lane >> 4, h = unit & 3; const size_t tok0 = (size_t)(unit >> 2) * 128; const float lg = lgam(h);
    LAS unsigned char* sK = lds; LAS unsigned char* sV = lds + 33280;
    TileRegs<128, 128> tk; TileRegs<256, 128> tv;
    asm volatile("" : "+v"(tid));
    tile_load(tk, QK + tok0 * 1024 + 512 + h * 128, 1024, tid);
    tile_load(tv, V + (size_t)unit * 32768, 128, tid);
    __syncthreads();
    tile_store_b32(tk, sK, 260, tid);
    tile_store_b128(tv, sV, 272, tid);
    __syncthreads();
    f32x4 acc[2][8];
#pragma unroll
    for (int a = 0; a < 2; ++a)
#pragma unroll
        for (int b = 0; b < 8; ++b) acc[a][b] = (f32x4){0.f, 0.f, 0.f, 0.f};
#pragma unroll
    for (int ks = 0; ks < 4; ++ks) {
        const int j0 = 32 * ks + 8 * fq;
        bf16x8 vf[2];
#pragma unroll
        for (int e2 = 0; e2 < 2; ++e2) {
            const u32x4 vr = *(const LAS u32x4*)(sV + (16 * (2 * wid + e2) + fr) * 272 + j0 * 2);
            u32x4 w;
            w.x = cvt_pk_bf16(bf_lo(vr.x) * fexp(lg * (float)(127 - j0 - 0)), bf_hi(vr.x) * fexp(lg * (float)(127 - j0 - 1)));
            w.y = cvt_pk_bf16(bf_lo(vr.y) * fexp(lg * (float)(127 - j0 - 2)), bf_hi(vr.y) * fexp(lg * (float)(127 - j0 - 3)));
            w.z = cvt_pk_bf16(bf_lo(vr.z) * fexp(lg * (float)(127 - j0 - 4)), bf_hi(vr.z) * fexp(lg * (float)(127 - j0 - 5)));
            w.w = cvt_pk_bf16(bf_lo(vr.w) * fexp(lg * (float)(127 - j0 - 6)), bf_hi(vr.w) * fexp(lg * (float)(127 - j0 - 7)));
            vf[e2] = __builtin_bit_cast(bf16x8, w);
        }
#pragma unroll
        for (int db = 0; db < 8; ++db) {
            unsigned short o[8]; gather8(sK, 260, j0, 16 * db + fr, o);
            const bf16x8 kf = mk8(o);
#pragma unroll
            for (int e2 = 0; e2 < 2; ++e2) acc[e2][db] = __builtin_amdgcn_mfma_f32_16x16x32_bf16(kf, vf[e2], acc[e2][db], 0, 0, 0);
        }
    }
    bf16_t* dst = KV + (size_t)unit * 32768;
#pragma unroll
    for (int e2 = 0; e2 < 2; ++e2)
#pragma unroll
        for (int db = 0; db < 8; ++db) *(u32x2*)(dst + (16 * (2 * wid + e2) + fr) * 128 + 16 * db + 4 * fq) = pack4(acc[e2][db]);
}

__device__ __forceinline__ void p4_unit(LAS unsigned char* lds, const bf16_t* QK, const bf16_t* V, const bf16_t* PREV, const bf16_t* RG, bf16_t* RO, int unit, int tid, int wid, int lane) {
    const int fr = lane & 15, fq = lane >> 4, h = unit & 3; const size_t tok0 = (size_t)(unit >> 2) * 128; const float lg = lgam(h);
    LAS unsigned char* sK = lds; LAS unsigned char* sP = lds + 34816;
    TileRegs<128, 128> tk; TileRegs<256, 128> tp; TileRegs<256, 128> tv;
    asm volatile("" : "+v"(tid));
    tile_load(tk, QK + tok0 * 1024 + 512 + h * 128, 1024, tid);
    tile_load(tp, PREV + (size_t)unit * 32768, 128, tid);
    bf16x8 qf[4];
    { const bf16_t* qrow = QK + (tok0 + 16 * wid + fr) * 1024 + h * 128 + 8 * fq;
#pragma unroll
      for (int ks = 0; ks < 4; ++ks) qf[ks] = *(const bf16x8*)(qrow + 32 * ks); }
    __syncthreads();
    tile_store_b128(tk, sK, 272, tid);
    tile_store_b128(tp, sP, 272, tid);
    asm volatile("" : "+v"(tid));
    tile_load(tv, V + (size_t)unit * 32768, 128, tid);
    __syncthreads();
    f32x4 sacc[8];
#pragma unroll
    for (int jb = 0; jb < 8; ++jb) {
        sacc[jb] = (f32x4){0.f, 0.f, 0.f, 0.f};
        if (jb <= wid) {
#pragma unroll
            for (int ks = 0; ks < 4; ++ks) { const bf16x8 kf = *(const LAS bf16x8*)(sK + (16 * jb + fr) * 272 + (32 * ks + 8 * fq) * 2); sacc[jb] = __builtin_amdgcn_mfma_f32_16x16x32_bf16(kf, qf[ks], sacc[jb], 0, 0, 0); }
        }
    }
    f32x4 acc[16];
    const int i = 16 * wid + fr; const float xi = fexp(lg * (float)(i + 1));
#pragma unroll
    for (int eb = 0; eb < 16; ++eb) {
        f32x4 a = (f32x4){0.f, 0.f, 0.f, 0.f};
#pragma unroll
        for (int ks = 0; ks < 4; ++ks) { const bf16x8 pf = *(const LAS bf16x8*)(sP + (32 * (eb >> 1) + 8 * (fr >> 2) + 4 * (eb & 1) + (fr & 3)) * 272 + (32 * ks + 8 * fq) * 2); a = __builtin_amdgcn_mfma_f32_16x16x32_bf16(pf, qf[ks], a, 0, 0, 0); }
        acc[eb] = a * xi;
    }
    bf16x8 pfr[4];
#pragma unroll
    for (int ks = 0; ks < 4; ++ks) {
        float pv[8];
#pragma unroll
        for (int hf = 0; hf < 2; ++hf)
#pragma unroll
            for (int r = 0; r < 4; ++r) { const int jb = 2 * ks + hf, j = 16 * jb + 4 * fq + r; pv[4 * hf + r] = (j <= i) ? sacc[jb][r] * fexp(lg * (float)(i - j)) : 0.0f; }
        u32x4 w; w.x = cvt_pk_bf16(pv[0], pv[1]); w.y = cvt_pk_bf16(pv[2], pv[3]); w.z = cvt_pk_bf16(pv[4], pv[5]); w.w = cvt_pk_bf16(pv[6], pv[7]);
        pfr[ks] = __builtin_bit_cast(bf16x8, w);
    }
    __syncthreads();
    asm volatile("" : "+v"(tid));
    tile_store_b128(tv, lds, 272, tid);
    __syncthreads();
#pragma unroll
    for (int ks = 0; ks < 4; ++ks) {
        if (2 * ks <= wid) {
#pragma unroll
            for (int eb = 0; eb < 16; ++eb) {
                const LAS unsigned char* p = lds + (32 * (eb >> 1) + 8 * (fr >> 2) + 4 * (eb & 1) + (fr & 3)) * 272 + (32 * ks + 4 * fq) * 2;
                const u32x2 lo = *(const LAS u32x2*)p, hi = *(const LAS u32x2*)(p + 32);
                const u32x4 w = (u32x4){lo.x, lo.y, hi.x, hi.y};
                acc[eb] = __builtin_amdgcn_mfma_f32_16x16x32_bf16(__builtin_bit_cast(bf16x8, w), pfr[ks], acc[eb], 0, 0, 0);
            }
        }
    }
    float s = 0.f;
#pragma unroll
    for (int eb = 0; eb < 16; ++eb) s += (acc[eb][0] + acc[eb][1]) + (acc[eb][2] + acc[eb][3]);
    s += __shfl_xor(s, 16); s += __shfl_xor(s, 32);
    const float mu = s * (1.0f / 256.0f); float q = 0.f;
#pragma unroll
    for (int eb = 0; eb < 16; ++eb) { const f32x4 d = acc[eb] - mu; q += (d[0] * d[0] + d[1] * d[1]) + (d[2] * d[2] + d[3] * d[3]); }
    q += __shfl_xor(q, 16); q += __shfl_xor(q, 32);
    const float rstd = rsqrtf(q * (1.0f / 256.0f) + 1e-5f);
    const bf16_t* rgrow = RG + (tok0 + i) * 1024 + h * 256 + 8 * fq; bf16_t* rorow = RO + (tok0 + i) * 1024 + h * 256 + 8 * fq;
    u32x4 gl[8];
#pragma unroll
    for (int k = 0; k < 8; ++k) gl[k] = *(const u32x4*)(rgrow + 32 * k);
#pragma unroll
    for (int k = 0; k < 8; ++k) { f32x4 ga, gb; unpack8(gl[k], ga, gb); *(u32x4*)(rorow + 32 * k) = pack8((acc[2 * k] - mu) * rstd * ga, (acc[2 * k + 1] - mu) * rstd * gb); }
}

__device__ __forceinline__ void p5_unit(LAS unsigned char* lds, const bf16_t* SV, const float* SVS, bf16_t* UO, const bf16_t* WC, const float* bias, int chunk, int tid, int wid, int lane) {
    const int fr = lane & 15, fq = lane >> 4; const size_t tok0 = (size_t)chunk * 128;
    LAS unsigned char* sW = lds; LAS unsigned char* sV = lds + 34816; LAS float* st = (LAS float*)(lds + 34816 + 66048);
    __syncthreads();
    {
        const int r = 16 * wid + (lane >> 2);
        const float* sp = SVS + (tok0 + r) * 32 + (lane & 3) * 8;
        const f32x4 p0 = *(const f32x4*)sp, p1 = *(const f32x4*)(sp + 4);
        float sm = (p0[0] + p0[2]) + (p1[0] + p1[2]), sq = (p0[1] + p0[3]) + (p1[1] + p1[3]);
        sm += __shfl_xor(sm, 1); sm += __shfl_xor(sm, 2); sq += __shfl_xor(sq, 1); sq += __shfl_xor(sq, 2);
        const float mu = sm * (1.0f / 1024.0f), var = fmaxf(sq * (1.0f / 1024.0f) - mu * mu, 0.0f);
        if ((lane & 3) == 0) { st[2 * r] = mu; st[2 * r + 1] = rsqrtf(var + 1e-5f); }
    }
    TileRegs<128, 128> tw; TileRegs<128, 256> tv;
    { int tg = tid; asm volatile("" : "+v"(tg)); tile_load(tw, WC, 128, tg); tile_load(tv, SV + tok0 * 1024, 1024, tg); }
    for (int g = 0; g < 4; ++g) {
        __syncthreads();
        tile_store_b128(tw, sW, 272, tid);
#pragma unroll
        for (int i = 0; i < 8; ++i) {
            const int c = tid + i * NTHR, r = c >> 5, ch = c & 31;
            f32x4 a, b; unpack8(tv.v[i], a, b);
            const float mu = st[2 * r], rs = st[2 * r + 1];
            const u32x4 w = pack8((a - mu) * rs, (b - mu) * rs);
            LAS unsigned* d = (LAS unsigned*)(sV + r * 516 + ch * 16); d[0] = w.x; d[1] = w.y; d[2] = w.z; d[3] = w.w;
        }
        __syncthreads();
        int tg = tid; asm volatile("" : "+v"(tg));
        if (g < 3) { tile_load(tw, WC + (g + 1) * 16384, 128, tg); tile_load(tv, SV + tok0 * 1024 + (g + 1) * 256, 1024, tg); }
        u32x4 ul[8]; float bvl[8];
        {   const int lfr = tg & 15, lfq = (tg & 63) >> 4;
#pragma unroll
            for (int ib = 0; ib < 8; ++ib) { bvl[ib] = bias[g * 128 + 16 * ib + lfr];
                ul[ib] = *(const u32x4*)(UO + (tok0 + 16 * ib + lfr) * 1024 + g * 256 + 32 * wid + 8 * lfq); } }
        f32x4 acc[8][2];
#pragma unroll
        for (int a = 0; a < 8; ++a)
#pragma unroll
            for (int b = 0; b < 2; ++b) acc[a][b] = (f32x4){0.f, 0.f, 0.f, 0.f};
#pragma unroll
        for (int ks = 0; ks < 4; ++ks) {
            bf16x8 vf[2];
#pragma unroll
            for (int c2 = 0; c2 < 2; ++c2) { unsigned short o[8]; gather8(sV, 516, 32 * ks + 8 * fq, 32 * wid + 8 * (fr >> 2) + 4 * c2 + (fr & 3), o); vf[c2] = mk8(o); }
#pragma unroll
            for (int ib = 0; ib < 8; ++ib) {
                if (ib >= 2 * ks) {
                    const bf16x8 wf = *(const LAS bf16x8*)(sW + (16 * ib + fr) * 272 + (32 * ks + 8 * fq) * 2);
#pragma unroll
                    for (int c2 = 0; c2 < 2; ++c2) acc[ib][c2] = __builtin_amdgcn_mfma_f32_16x16x32_bf16(vf[c2], wf, acc[ib][c2], 0, 0, 0);
                }
            }
        }
#pragma unroll
        for (int ib = 0; ib < 8; ++ib) { f32x4 ua, ub; unpack8(ul[ib], ua, ub);
            *(u32x4*)(UO + (tok0 + 16 * ib + fr) * 1024 + g * 256 + 32 * wid + 8 * fq) = pack8((acc[ib][0] + bvl[ib]) * ua, (acc[ib][1] + bvl[ib]) * ub); }
    }
}

#define XB_TMO      128
#define XB_XCNT(j)  (256  + 64 * (j))
#define XB_XSUB(j)  (1280 + 64 * (j))
#define XB_XGEN(j)  (2304 + 64 * (j))
#define XB_TOP      3328
#define XB_TOPGEN   3392
#define XCD_BAR_WORDS 3456
#define XB_SPIN_CAP (1u << 22)
__device__ __forceinline__ unsigned xb_ld(unsigned* p)              { return __hip_atomic_load(p, __ATOMIC_RELAXED, __HIP_MEMORY_SCOPE_AGENT); }
__device__ __forceinline__ unsigned xb_add(unsigned* p, unsigned v) { return __hip_atomic_fetch_add(p, v, __ATOMIC_RELAXED, __HIP_MEMORY_SCOPE_AGENT); }
__device__ __forceinline__ unsigned xb_xcc_id() { return (unsigned)__builtin_amdgcn_s_getreg((3 << 11) | 20) & 0xFu; }
#define XB_SPIN(cond, bar) do { unsigned _sp = 0; while (cond) { __builtin_amdgcn_s_sleep(1); \
    if ((++_sp & 255u) == 0u) { if (xb_ld(&(bar)[XB_TMO])) break; if (_sp > XB_SPIN_CAP) { atomicAdd(&(bar)[XB_TMO], 1u); break; } } } } while (0)
struct XcdBarrier { unsigned* bar; unsigned x; volatile LAS unsigned* st; };
__device__ __forceinline__ XcdBarrier xcd_barrier_post(unsigned* bar, volatile LAS unsigned* st) {
    XcdBarrier b; b.bar = bar; b.x = xb_xcc_id(); b.st = st;
    if (threadIdx.x == 0) (void)xb_add(&bar[XB_XCNT(b.x)], 1u);
    return b;
}
__device__ __forceinline__ void xcd_barrier_complete(unsigned* bar, unsigned x, unsigned& nloc, unsigned& nx) {
    const unsigned G = gridDim.x * gridDim.y * gridDim.z;
    unsigned sum, cnt, mine, sp = 0u;
    for (;;) {
        sum = 0u; cnt = 0u; mine = 0u;
#pragma nounroll
        for (unsigned j = 0; j < 16; ++j) { const unsigned c = xb_ld(&bar[XB_XCNT(j)]); sum += c; cnt += (c > 0u) ? 1u : 0u; mine = (j == x) ? c : mine; }
        if (sum == G) break;
        __builtin_amdgcn_s_sleep(1);
        if ((++sp & 255u) == 0u) { if (xb_ld(&bar[XB_TMO])) break; if (sp > XB_SPIN_CAP) { atomicAdd(&bar[XB_TMO], 1u); break; } }
    }
    nloc = mine > 0u ? mine : 1u; nx = cnt > 0u ? cnt : 1u;
}
__device__ __forceinline__ void xcd_barrier(const XcdBarrier& b) {
    asm volatile("s_waitcnt vmcnt(0)" ::: "memory");
    __syncthreads();
    if (threadIdx.x == 0) {
        unsigned* bar = b.bar;
        __builtin_amdgcn_s_waitcnt(0);
        unsigned nloc = b.st[0], nx = b.st[1];
        if (nloc == 0u) { xcd_barrier_complete(bar, b.x, nloc, nx); b.st[0] = nloc; b.st[1] = nx; }
        const unsigned old = xb_add(&bar[XB_XSUB(b.x)], 1u);
        const unsigned gen = old / nloc;
        if (old + 1u == (gen + 1u) * nloc) {
            __builtin_amdgcn_fence(__ATOMIC_RELEASE, "agent");
            asm volatile("s_waitcnt vmcnt(0)" ::: "memory");
            const unsigned og = xb_add(&bar[XB_TOP], 1u);
            const unsigned tg = og / nx;
            if (og + 1u == (tg + 1u) * nx) xb_add(&bar[XB_TOPGEN], 1u);
            else XB_SPIN(xb_ld(&bar[XB_TOPGEN]) == tg, bar);
            __builtin_amdgcn_fence(__ATOMIC_ACQUIRE, "agent");
            xb_add(&bar[XB_XGEN(b.x)], 1u);
            asm volatile("s_waitcnt vmcnt(0)" ::: "memory");
        } else {
            XB_SPIN(xb_ld(&bar[XB_XGEN(b.x)]) == gen, bar);
            __builtin_amdgcn_fence(__ATOMIC_ACQUIRE, "agent");
            asm volatile("s_waitcnt vmcnt(0)" ::: "memory");
        }
    }
    __syncthreads();
}

#if defined(EXPM) && (EXPM & 64)
#define GSYNC() do { xcd_barrier(xbar); xcd_barrier(xbar); } while (0)
#else
#define GSYNC() xcd_barrier(xbar)
#endif
#define FRESH_IDS int tid_ = threadIdx.x; asm volatile("" : "+v"(tid_)); const int tid = tid_, wid = __builtin_amdgcn_readfirstlane(tid >> 6), lane = tid & 63; (void)wid; (void)lane;
__global__ void __launch_bounds__(NTHR, 2) mega(Params P) {
    extern __shared__ __attribute__((aligned(16))) unsigned char lds_raw[];
    LAS unsigned char* lds = (LAS unsigned char*)lds_raw;
    cg::grid_group grid = cg::this_grid();
    const int G = gridDim.x, bx = blockIdx.x;
    unsigned char* ws = P.ws;
    bf16_t* const WIN = (bf16_t*)(ws + WS_WIN); bf16_t* const WR = (bf16_t*)(ws + WS_WR); bf16_t* const WSG = (bf16_t*)(ws + WS_WS); bf16_t* const WO = (bf16_t*)(ws + WS_WO);
    bf16_t* const WG = (bf16_t*)(ws + WS_WG); bf16_t* const WPP = (bf16_t*)(ws + WS_WPP); bf16_t* const WC = (bf16_t*)(ws + WS_WC);
    float* const RSQ1 = (float*)(ws + WS_SV); float* const RSQ2 = (float*)(ws + WS_SV + 8 * MiB);
    bf16_t* const H = (bf16_t*)(ws + WS_H); bf16_t* const PB = (bf16_t*)(ws + WS_PB);
    bf16_t* const QK = (bf16_t*)(ws + WS_QK); bf16_t* const V = (bf16_t*)(ws + WS_V); bf16_t* const SV = (bf16_t*)(ws + WS_SV);
    bf16_t* const RG2 = (bf16_t*)(ws + WS_RG2); bf16_t* const UG2 = (bf16_t*)(ws + WS_UG2); bf16_t* const MR2 = (bf16_t*)(ws + WS_MR2); bf16_t* const MS2 = (bf16_t*)(ws + WS_MS2);
    bf16_t* const PREV = (bf16_t*)P.out;
    bf16_t* const MERGED = (bf16_t*)P.out; bf16_t* const X2B = H; bf16_t* const X1B = QK;
    bf16_t* const PP = (bf16_t*)(ws + WS_PP);
    volatile LAS unsigned* xst = (volatile LAS unsigned*)(lds + LDS_STAGE);
    if (threadIdx.x < 4) xst[threadIdx.x] = 0u;
    __syncthreads();
    const XcdBarrier xbar = xcd_barrier_post((unsigned*)(ws + WS_BAR), xst);

    { FRESH_IDS phase0(P, lds, tid, wid, lane); }
    if (P.ws == nullptr) grid.sync();

    for (int sl = 0; sl < NSL; ++sl) {
        const int tokb = sl * TS;
        bf16_t* const RG = RG2 + (size_t)tokb * 1024; bf16_t* const UG = UG2 + (size_t)tokb * 1024;
        GSYNC();
        {
            pg8::Src1V g{H + (size_t)tokb * 1024, WIN, 1024}; pg8::StaticOrder S; S.init(TS, 8192, G, bx);
            Epi1 E{QK, UG, (const float*)(ws + WS_COS), (const float*)(ws + WS_SIN), sl, (float*)((unsigned char*)P.out + 64 * MiB)};
            pg8::gemm_phase(lds, g, 1024, S, E);
        }
        GSYNC();
        { FRESH_IDS for (int u = bx; u < BSL * 32 * 4; u += G) p2_unit(lds, QK, V, PREV, u, tid, wid, lane); }
        { FRESH_IDS for (int c = bx; c < BSL * 32; c += G) p5_unit(lds, SV, (const float*)((unsigned char*)P.out + 64 * MiB), UG, WC, P.sbs, c, tid, wid, lane); }
        GSYNC();
        { FRESH_IDS
        for (int it = bx * NTHR + tid; it < BSL * 4 * 256 * 32; it += G * NTHR) {
            const int d4 = it & 31, e = (it >> 5) & 255, h = (it >> 13) & 3, bl = it >> 15;
            const float cd = fexp(128.0f * lgam(h));
            f32x4 run = (f32x4){0.f, 0.f, 0.f, 0.f};
            const size_t base = ((size_t)(bl * 32) * 4 + h) * 32768 + e * 128 + d4 * 4;
#pragma unroll 8
            for (int n = 0; n < 32; ++n) {
                const size_t o = base + (size_t)n * 4 * 32768;
                const f32x4 kv = unpack4(*(const u32x2*)(PREV + o));
                *(u32x2*)(PREV + o) = pack4(run);
                run = kv + run * cd;
            }
        } }
        GSYNC();
        { FRESH_IDS for (int u = bx; u < BSL * 32 * 4; u += G) p4_unit(lds, QK, V, PREV, RG, RG, u, tid, wid, lane); }
    }
    GSYNC();
    {
        pg8::Src2 g{RG2, WR, (long)((const char*)UG2 - (const char*)RG2), (long)((const char*)WSG - (const char*)WR), 1024}; pg8::DualOrder S; S.init(T_ALL, 1024, G, bx);
        Epi6 E{MR2, MS2, MERGED};
        pg8::gemm_phase(lds, g, 1024, S, E);
    }
    GSYNC();
    {
        pg8::Src1 g{MERGED, WO, 1024}; pg8::StaticOrder S; S.init(T_ALL, 1024, G, bx);
        Epi7 E{H, (const float*)(ws + WS_RS0), P.gm, X1B, RSQ1, 0};
        pg8::gemm_phase(lds, g, 1024, S, E);
        pg8::Src1 g2{PB, WPP, 256};
        EpiStore E2{PP};
        pg8::gemm_phase(lds, g2, 256, S, E2);
    }
    GSYNC();
    {
        pg8::Src1 g{X1B, WG, 1024}; pg8::StaticOrder S; S.init(T_ALL, 1024, G, bx);
        Epi8 E{X1B, X2B, PP, RSQ1, RSQ2, 0};
        pg8::gemm_phase(lds, g, 1024, S, E);
    }
    GSYNC();
    {
        FRESH_IDS
        f32x4 gv[4];
#pragma unroll
        for (int i = 0; i < 2; ++i) { gv[2 * i] = *(const f32x4*)(P.gf + lane * 8 + 512 * i); gv[2 * i + 1] = *(const f32x4*)(P.gf + lane * 8 + 512 * i + 4); }
        for (int row = bx * 8 + wid; row < T_ALL; row += G * 8) {
            float sq = RSQ2[(size_t)row * 16 + (lane & 15)]; sq += __shfl_xor(sq, 1); sq += __shfl_xor(sq, 2); sq += __shfl_xor(sq, 4); sq += __shfl_xor(sq, 8);
            const float rstd = rsqrtf(sq * (1.0f / 1024.0f) + 1e-6f); float* o = P.out + (size_t)row * 1024; const bf16_t* xr = X2B + (size_t)row * 1024;
#pragma unroll
            for (int i = 0; i < 2; ++i) { f32x4 a, b; unpack8(*(const u32x4*)(xr + lane * 8 + 512 * i), a, b);
                *(f32x4*)(o + lane * 8 + 512 * i) = a * rstd * gv[2 * i]; *(f32x4*)(o + lane * 8 + 512 * i + 4) = b * rstd * gv[2 * i + 1]; }
        }
    }
}

extern "C" void kernel_launch(void* const* d_in, const int* in_sizes, int n_in, void* d_out, int out_size, void* d_ws, size_t ws_size, hipStream_t stream) {
    static int grid_blocks = 0;
    if (grid_blocks == 0) {
        int dev = 0, cus = 0, per_cu = 0;
        hipGetDevice(&dev);
        hipDeviceGetAttribute(&cus, hipDeviceAttributeMultiprocessorCount, dev);
        if (hipFuncSetAttribute((const void*)mega, hipFuncAttributeMaxDynamicSharedMemorySize, LDS_BYTES) != hipSuccess) fprintf(stderr, "hipFuncSetAttribute failed\n");
        if (hipOccupancyMaxActiveBlocksPerMultiprocessor(&per_cu, (const void*)mega, NTHR, LDS_BYTES) != hipSuccess || per_cu < 1) { per_cu = 1; (void)hipGetLastError(); }
        grid_blocks = cus * (per_cu > 1 ? 1 : per_cu);
        if (ws_size < WS_END) fprintf(stderr, "workspace too small: %zu < %zu\n", ws_size, (size_t)WS_END);
    }
    Params p{};
    p.x = (const float*)d_in[0]; p.p = (const float*)d_in[1]; p.w_in = (const float*)d_in[2]; p.w_ret = (const float*)d_in[3]; p.w_sgu = (const float*)d_in[4];
    p.w_out = (const float*)d_in[5]; p.sws = (const float*)d_in[6]; p.sbs = (const float*)d_in[7]; p.wpg = (const float*)d_in[8]; p.wpp = (const float*)d_in[9];
    p.gm = (const float*)d_in[10]; p.gp = (const float*)d_in[11]; p.gf = (const float*)d_in[12];
    p.out = (float*)d_out; p.ws = (unsigned char*)d_ws;
    (void)hipMemsetAsync((char*)d_ws + WS_BAR, 0, XCD_BAR_WORDS * 4, stream);
    void* args[] = {&p};
    hipError_t e = hipLaunchCooperativeKernel((const void*)mega, dim3(grid_blocks), dim3(NTHR), args, LDS_BYTES, stream);
    if (e != hipSuccess) fprintf(stderr, "cooperative launch failed: %s (grid %d)\n", hipGetErrorString(e), grid_blocks);
}
```

```cpp
#include <hip/hip_runtime.h>
#include <hip/hip_cooperative_groups.h>
#include <cstdio>
namespace cg = cooperative_groups;

#define LAS __attribute__((address_space(3)))
typedef unsigned short bf16_t;
typedef short bf16x8 __attribute__((ext_vector_type(8)));
typedef float f32x4 __attribute__((ext_vector_type(4)));
typedef float f32x2 __attribute__((ext_vector_type(2)));
typedef unsigned u32x4 __attribute__((ext_vector_type(4)));
typedef unsigned u32x2 __attribute__((ext_vector_type(2)));

constexpr int T_ALL = 65536, DM = 1024, NSL = 2, TS = T_ALL / NSL, BSL = 16 / NSL;
constexpr int NTHR = 512;
constexpr int LDS_STAGE = 131072, LDS_BYTES = LDS_STAGE + 16;
constexpr size_t MiB = 1ull << 20;
constexpr size_t UB = (size_t)TS * 1024 * 2;
constexpr size_t WS_WIN = 0, WS_WR = 16 * MiB, WS_WS = 18 * MiB, WS_WO = 20 * MiB, WS_WG = 22 * MiB, WS_WPP = 24 * MiB, WS_WC = 24 * MiB + 512 * 1024,
                 WS_COS = 25 * MiB, WS_SIN = 26 * MiB, WS_RSQ1 = 27 * MiB, WS_RSQ2 = 27 * MiB + 256 * 1024, WS_BAR = 28 * MiB, WS_RS0 = 29 * MiB,
                 WS_H = 32 * MiB, WS_PB = 160 * MiB, WS_SL = 192 * MiB;
constexpr size_t WS_QK = WS_SL, WS_V = WS_SL + UB, WS_SV = WS_SL + 2 * UB, WS_RG2 = WS_SL + 3 * UB, WS_UG2 = WS_SL + 5 * UB, WS_MR2 = WS_SL + 7 * UB, WS_MS2 = WS_SL + 9 * UB,
                 WS_PP = WS_SL + 11 * UB, WS_END = WS_SL + 13 * UB;
static_assert(WS_END == 1024 * MiB, "workspace map");

__device__ __forceinline__ unsigned cvt_pk_bf16(float lo, float hi) { unsigned r; asm volatile("v_cvt_pk_bf16_f32 %0, %1, %2" : "=v"(r) : "v"(lo), "v"(hi)); return r; }
__device__ __forceinline__ float bf_lo(unsigned w) { return __uint_as_float(w << 16); }
__device__ __forceinline__ float bf_hi(unsigned w) { return __uint_as_float(w & 0xffff0000u); }
__device__ __forceinline__ float bf2f(unsigned short b) { return __uint_as_float(((unsigned)b) << 16); }
__device__ __forceinline__ float wave_sum(float v) {
#pragma unroll
    for (int o = 32; o >= 1; o >>= 1) v += __shfl_xor(v, o);
    return v;
}
__device__ __forceinline__ float sigmoidf_(float x) { return __builtin_amdgcn_rcpf(1.0f + __builtin_amdgcn_exp2f(-1.4426950408889634f * x)); }
__device__ __forceinline__ float fexp(float x) { return __builtin_amdgcn_exp2f(1.4426950408889634f * x); }
__device__ __forceinline__ f32x2 gelu_pk(f32x2 v) {
    const f32x2 av = __builtin_elementwise_abs(v), d = av * 0.2316418882f + 1.0f;
    f32x2 t; t.x = __builtin_amdgcn_rcpf(d.x); t.y = __builtin_amdgcn_rcpf(d.y);
    f32x2 q = t * 0.5307027145f + (-0.7265760135f); q = q * t + 0.7107068705f; q = q * t + (-0.142248368f); q = q * t + 0.127414796f; q = q * t;
    const f32x2 s = (v * v) * (-0.72134752044f);
    f32x2 e; e.x = __builtin_amdgcn_exp2f(s.x); e.y = __builtin_amdgcn_exp2f(s.y);
    const f32x2 m = v * (q * e), r = v - m;
    f32x2 o; o.x = v.x < 0.f ? m.x : r.x; o.y = v.y < 0.f ? m.y : r.y; return o;
}
__device__ __forceinline__ f32x4 gelu4(f32x4 v) { f32x2 a = gelu_pk((f32x2){v[0], v[1]}), b = gelu_pk((f32x2){v[2], v[3]}); return (f32x4){a.x, a.y, b.x, b.y}; }
__device__ __forceinline__ f32x4 sig4(f32x4 v) { return (f32x4){sigmoidf_(v[0]), sigmoidf_(v[1]), sigmoidf_(v[2]), sigmoidf_(v[3])}; }
__device__ __forceinline__ float lgam(int h) { return h == 0 ? -0.03174869831458027f : h == 1 ? -0.01574835696813892f : h == 2 ? -0.007843177461025892f : -0.003913899321136329f; }

namespace pg8 {
constexpr int BM = 256, BK = 64, HALF = 128, HTB = HALF * BK * 2, STAGE_BYTES = 8 * HTB, NXCD = 8, WGM = 8;
__host__ __device__ __forceinline__ int lds_byte(int r, int c) { const int st = (r >> 4) * 2 + (c >> 5), rr = r & 15, cc = c & 31, ob = rr * 64 + cc * 2; return st * 1024 + (ob ^ (((ob >> 9) & 1) << 5)); }
__host__ __device__ __forceinline__ void stage_rc(int b, int& R, int& C) { const int st = b / 1024, sb = b % 1024, swz = sb ^ (((sb >> 9) & 1) << 5); R = (st >> 1) * 16 + swz / 64; C = (st & 1) * 32 + (swz % 64) / 2; }
__host__ __device__ __forceinline__ int perm32(int rho) { const int n = rho >> 4, i = rho & 15; return 8 * (i >> 2) + 4 * n + (i & 3); }

struct Unit { int pm, pn, part; };
struct StaticOrder {
    int nM, nN, nwg, G, c;
    __device__ void init(int M, int N, int G_, int c_) { nM = M / BM; nN = N / BM; nwg = nM * nN; G = G_; c = c_; }
    __device__ bool next(int i, Unit& u) const {
        const long L = (long)i * G + c; if (L >= nwg) return false;
        int wgid = (int)L; { const int q = nwg / NXCD, r = nwg % NXCD, xcd = wgid % NXCD, off = wgid / NXCD; wgid = (xcd < r ? xcd * (q + 1) : r * (q + 1) + (xcd - r) * q) + off; }
        const int nig = WGM * nN, gid = wgid / nig, fm = gid * WGM, gsz = (nM - fm) < WGM ? (nM - fm) : WGM;
        u.pm = fm + ((wgid % nig) % gsz); u.pn = (wgid % nig) / gsz; u.part = 0; return true;
    }
};
struct DualOrder : StaticOrder {
    __device__ bool next(int i, Unit& u) const { if (!StaticOrder::next(i >> 1, u)) return false; u.part = i & 1; return true; }
};
struct Src1 { const bf16_t* A; const bf16_t* Bt; int K;
    __device__ __forceinline__ const char* a(const Unit& u) const { return (const char*)A + (size_t)u.pm * BM * K * 2; }
    __device__ __forceinline__ const char* b(const Unit& u) const { return (const char*)Bt + (size_t)u.pn * BM * K * 2; } };
struct Src1V { const bf16_t* A; const bf16_t* Bt; int K;
    __device__ __forceinline__ const char* a(const Unit& u) const { const char* pa = (const char*)A + (size_t)u.pm * BM * K * 2; const char* pb = (const char*)Bt + (size_t)u.pn * BM * K * 2; const long sw = (u.pn >= 4 && u.pn < 8) ? 1 : 0; return pa + sw * (long)(pb - pa); }
    __device__ __forceinline__ const char* b(const Unit& u) const { const char* pa = (const char*)A + (size_t)u.pm * BM * K * 2; const char* pb = (const char*)Bt + (size_t)u.pn * BM * K * 2; const long sw = (u.pn >= 4 && u.pn < 8) ? 1 : 0; return pb - sw * (long)(pb - pa); } };
struct Src2 { const bf16_t* A0; const bf16_t* B0; long dA, dB; int K;
    __device__ __forceinline__ const char* a(const Unit& u) const { return (const char*)A0 + (long)u.part * dA + (size_t)u.pm * BM * K * 2; }
    __device__ __forceinline__ const char* b(const Unit& u) const { return (const char*)B0 + (long)u.part * dB + (size_t)u.pn * BM * K * 2; } };

template <class Epi, class Sched, class Src>
__device__ __forceinline__ void gemm_phase(LAS unsigned char* lds, const Src& g, const int K, const Sched& S, const Epi& E) {
    int tid_ = threadIdx.x; asm volatile("" : "+v"(tid_));
    const int tid = tid_, wid = __builtin_amdgcn_readfirstlane(tid >> 6), lane = tid & 63, wr = wid >> 2, wc = wid & 3, fr = lane & 15, fq = lane >> 4;
    const int nt = K / BK;
    unsigned voffA[2], voffB[2];
#pragma unroll
    for (int i = 0; i < 2; ++i) { int R, C; stage_rc(tid * 16 + i * 8192, R, C); const int Rb = Epi::PERM ? ((R & ~31) + perm32(R & 31)) : R;
        voffA[i] = (unsigned)(R * K + C) * 2u; voffB[i] = (unsigned)(Rb * K + C) * 2u; }
    const size_t kstep = (size_t)(BK * 2);
    const size_t hstep = (size_t)HALF * K * 2;
    const unsigned ldsw = (unsigned)wid * 1024u;
    const int aoff = lds_byte(wr * 64 + fr, fq * 8), boff = lds_byte(wc * 32 + fr, fq * 8);
#define PG8_SA(b, h) (((b) * 2 + (h)) * HTB)
#define PG8_SB(b, h) ((4 + (b) * 2 + (h)) * HTB)
#define PG8_STAGE(bufoff, gbase, voff) do { _Pragma("unroll") for (int _i = 0; _i < 2; ++_i) \
        __builtin_amdgcn_global_load_lds((const unsigned*)((const char*)(gbase) + (voff)[_i]), (LAS unsigned*)(lds + (bufoff) + ldsw + _i * 8192), 16, 0, 0); } while (0)
#define PG8_LDA(dst, b, h) do { _Pragma("unroll") for (int m = 0; m < 4; ++m) _Pragma("unroll") for (int k = 0; k < 2; ++k) dst[m][k] = *(const LAS bf16x8*)(lds + PG8_SA(b, h) + aoff + m * 2048 + k * 1024); } while (0)
#define PG8_LDB(dst, b, h) do { _Pragma("unroll") for (int n = 0; n < 2; ++n) _Pragma("unroll") for (int k = 0; k < 2; ++k) dst[n][k] = *(const LAS bf16x8*)(lds + PG8_SB(b, h) + boff + n * 2048 + k * 1024); } while (0)
#define PG8_MMA(ai, bj, At, Bt) do { __builtin_amdgcn_s_setprio(1); _Pragma("unroll") for (int m = 0; m < 4; ++m) _Pragma("unroll") for (int n = 0; n < 2; ++n) _Pragma("unroll") for (int k = 0; k < 2; ++k) \
        acc[ai][bj][m][n] = __builtin_amdgcn_mfma_f32_16x16x32_bf16(Bt[n][k], At[m][k], acc[ai][bj][m][n], 0, 0, 0); __builtin_amdgcn_s_setprio(0); } while (0)
#define PG8_WAIT_V(n) asm volatile("s_waitcnt vmcnt(" #n ")" ::: "memory")
#define PG8_WAIT_L(n) asm volatile("s_waitcnt lgkmcnt(" #n ")" ::: "memory")
#define PG8_BAR __builtin_amdgcn_s_barrier()
#define PG8_SCHED __builtin_amdgcn_sched_barrier(0)
    Unit cur, nxt; int ui = 0;
    if (!S.next(0, cur)) return;
    f32x4 acc[2][2][4][2];
#pragma unroll
    for (int a = 0; a < 2; ++a)
#pragma unroll
        for (int b = 0; b < 2; ++b)
#pragma unroll
            for (int m = 0; m < 4; ++m)
#pragma unroll
                for (int n = 0; n < 2; ++n) acc[a][b][m][n] = (f32x4){0.f, 0.f, 0.f, 0.f};
    bf16x8 At[4][2], B0[2][2], B1[2][2];
    const char* cA = g.a(cur); const char* cB = g.b(cur);
    PG8_STAGE(PG8_SB(0, 0), cB, voffB); PG8_STAGE(PG8_SA(0, 0), cA, voffA); PG8_STAGE(PG8_SB(0, 1), cB + hstep, voffB); PG8_STAGE(PG8_SA(0, 1), cA + hstep, voffA);
    if (wr == 1) PG8_BAR;
    PG8_WAIT_V(4); PG8_BAR;
    PG8_STAGE(PG8_SB(1, 0), cB + kstep, voffB); PG8_STAGE(PG8_SA(1, 0), cA + kstep, voffA); PG8_STAGE(PG8_SB(1, 1), cB + hstep + kstep, voffB);
    PG8_WAIT_V(6); PG8_BAR;
    for (;;) {
        const bool has_next = S.next(ui + 1, nxt);
        const char* nA = has_next ? g.a(nxt) : cA; const char* nB = has_next ? g.b(nxt) : cB;
        for (int t = 0; t < nt; t += 2) {
            const bool last = (t == nt - 2);
            const char* a1 = cA + (size_t)(t + 1) * kstep;
            const char* a2 = last ? nA : cA + (size_t)(t + 2) * kstep; const char* b2 = last ? nB : cB + (size_t)(t + 2) * kstep;
            const char* a3 = a2 + kstep; const char* b3 = b2 + kstep;
            PG8_LDB(B0, 0, 0); PG8_SCHED; PG8_LDA(At, 0, 0); PG8_STAGE(PG8_SA(1, 1), a1 + hstep, voffA);
            PG8_WAIT_L(8); PG8_BAR; PG8_WAIT_L(0); PG8_MMA(0, 0, At, B0); PG8_BAR; PG8_SCHED;
            PG8_LDB(B1, 0, 1); PG8_STAGE(PG8_SB(0, 0), b2, voffB);
            PG8_BAR; PG8_WAIT_L(0); PG8_MMA(0, 1, At, B1); PG8_BAR;
            PG8_LDA(At, 0, 1); PG8_STAGE(PG8_SA(0, 0), a2, voffA);
            PG8_BAR; PG8_WAIT_L(0); PG8_MMA(1, 0, At, B0); PG8_BAR; PG8_SCHED;
            PG8_STAGE(PG8_SB(0, 1), b2 + hstep, voffB);
            PG8_WAIT_V(6); PG8_BAR; PG8_MMA(1, 1, At, B1); PG8_BAR;
            PG8_LDB(B0, 1, 0); PG8_SCHED; PG8_LDA(At, 1, 0); PG8_STAGE(PG8_SA(0, 1), a2 + hstep, voffA);
            PG8_WAIT_L(8); PG8_BAR; PG8_WAIT_L(0); PG8_MMA(0, 0, At, B0); PG8_BAR; PG8_SCHED;
            PG8_LDB(B1, 1, 1); PG8_STAGE(PG8_SB(1, 0), b3, voffB);
            PG8_BAR; PG8_WAIT_L(0); PG8_MMA(0, 1, At, B1); PG8_BAR;
            PG8_LDA(At, 1, 1); PG8_STAGE(PG8_SA(1, 0), a3, voffA);
            PG8_BAR; PG8_WAIT_L(0); PG8_MMA(1, 0, At, B0); PG8_BAR; PG8_SCHED;
            PG8_STAGE(PG8_SB(1, 1), b3 + hstep, voffB);
            PG8_WAIT_V(6); PG8_BAR; PG8_MMA(1, 1, At, B1); PG8_BAR;
        }
        {
            int epm = cur.pm, epn = cur.pn, efr = fr, efq = fq; asm volatile("" : "+s"(epm), "+s"(epn), "+v"(efr), "+v"(efq));
            const Unit eu{epm, epn, cur.part};
            E(acc, eu, wr, wc, efr, efq);
        }
        if (!has_next) break;
        if (!E.keep(cur)) {
#pragma unroll
            for (int a = 0; a < 2; ++a)
#pragma unroll
                for (int b = 0; b < 2; ++b)
#pragma unroll
                    for (int m = 0; m < 4; ++m)
#pragma unroll
                        for (int n = 0; n < 2; ++n) acc[a][b][m][n] = (f32x4){0.f, 0.f, 0.f, 0.f};
        }
        cur = nxt; cA = nA; cB = nB; ++ui;
    }
    PG8_WAIT_V(0);
    if (wr == 0) PG8_BAR;
    PG8_BAR;
#undef PG8_SA
#undef PG8_SB
#undef PG8_STAGE
#undef PG8_LDA
#undef PG8_LDB
#undef PG8_MMA
#undef PG8_WAIT_V
#undef PG8_WAIT_L
#undef PG8_BAR
#undef PG8_SCHED
}
}
using pg8::Unit;
typedef f32x4 AccT[2][2][4][2];

__device__ __forceinline__ u32x4 pack8(f32x4 a, f32x4 b) { u32x4 w; w.x = cvt_pk_bf16(a[0], a[1]); w.y = cvt_pk_bf16(a[2], a[3]); w.z = cvt_pk_bf16(b[0], b[1]); w.w = cvt_pk_bf16(b[2], b[3]); return w; }
__device__ __forceinline__ u32x2 pack4(f32x4 a) { u32x2 w; w.x = cvt_pk_bf16(a[0], a[1]); w.y = cvt_pk_bf16(a[2], a[3]); return w; }
__device__ __forceinline__ void unpack8(u32x4 w, f32x4& a, f32x4& b) { a = (f32x4){bf_lo(w.x), bf_hi(w.x), bf_lo(w.y), bf_hi(w.y)}; b = (f32x4){bf_lo(w.z), bf_hi(w.z), bf_lo(w.w), bf_hi(w.w)}; }
__device__ __forceinline__ f32x4 unpack4(u32x2 w) { return (f32x4){bf_lo(w.x), bf_hi(w.x), bf_lo(w.y), bf_hi(w.y)}; }

struct Epi1 {
    static constexpr bool PERM = true;
    bf16_t *QK, *UG; const float* cs; const float* sn; int sl; float* svs;
    __device__ __forceinline__ bool keep(const Unit&) const { return false; }
    __device__ __forceinline__ void operator()(AccT& acc, const Unit& u, int wr, int wc, int fr, int fq) const {
        const int pn = u.pn, cl = wc * 32 + 8 * fq, row0 = u.pm * 256 + wr * 64 + fr;
        if (pn < 4) {
            const int isk = pn >> 1, t = pn & 1, head = 2 * t + (cl >> 6), dim0 = cl & 63;
            const float sc = isk ? 1.0f : 0.08838834764831845f;
            bf16_t* base = QK + isk * 512 + head * 128 + dim0;
            f32x4 tb[2][2][4];
#define ROT_LD(b, buf) do { _Pragma("unroll") for (int mm = 0; mm < 2; ++mm) { const int pos_ = (row0 + ((b) >> 1) * 128 + (((b) & 1) * 2 + mm) * 16) & 4095; \
                tb[buf][mm][0] = *(const f32x4*)(cs + pos_ * 64 + dim0); tb[buf][mm][1] = *(const f32x4*)(cs + pos_ * 64 + dim0 + 4); \
                tb[buf][mm][2] = *(const f32x4*)(sn + pos_ * 64 + dim0); tb[buf][mm][3] = *(const f32x4*)(sn + pos_ * 64 + dim0 + 4); } } while (0)
            ROT_LD(0, 0);
#pragma unroll
            for (int b = 0; b < 4; ++b) {
                if (b + 1 < 4) ROT_LD(b + 1, (b + 1) & 1);
#pragma unroll
                for (int mm = 0; mm < 2; ++mm) {
                    const int ai = b >> 1, m = (b & 1) * 2 + mm, row = row0 + ai * 128 + m * 16;
                    const f32x4 c0 = tb[b & 1][mm][0], c1 = tb[b & 1][mm][1], s0 = tb[b & 1][mm][2], s1 = tb[b & 1][mm][3];
                    const f32x4 x1a = acc[ai][0][m][0], x1b = acc[ai][0][m][1], x2a = acc[ai][1][m][0], x2b = acc[ai][1][m][1];
                    const f32x4 o1a = (x1a * c0 - x2a * s0) * sc, o1b = (x1b * c1 - x2b * s1) * sc, o2a = (x2a * c0 + x1a * s0) * sc, o2b = (x2b * c1 + x1b * s1) * sc;
                    *(u32x4*)(base + (size_t)row * 1024) = pack8(o1a, o1b);
                    *(u32x4*)(base + (size_t)row * 1024 + 64) = pack8(o2a, o2b);
                }
            }
#undef ROT_LD
        } else if (pn >= 12 && pn < 20) {
            bf16_t* base = UG + 128 * (pn - 12) + cl;
#pragma unroll
            for (int ai = 0; ai < 2; ++ai)
#pragma unroll
                for (int m = 0; m < 4; ++m) {
                    const int row = row0 + ai * 128 + m * 16;
                    const f32x4 ua = gelu4(acc[ai][0][m][0]), ub = gelu4(acc[ai][0][m][1]);
                    const f32x4 ga = acc[ai][1][m][0], gb = acc[ai][1][m][1];
                    *(u32x4*)(base + (size_t)row * 1024) = pack8(ua * ga * sig4(ga), ub * gb * sig4(gb));
                }
        } else if (pn >= 24) {
            bf16_t* rbase = QK + (size_t)(3 + 2 * NSL + sl) * ((size_t)TS * 1024) + 128 * (pn - 24) + cl;
            bf16_t* sbase = QK + (size_t)(3 + 3 * NSL + sl) * ((size_t)TS * 1024) + 128 * (pn - 24) + cl;
#pragma unroll
            for (int ai = 0; ai < 2; ++ai)
#pragma unroll
                for (int m = 0; m < 4; ++m) {
                    const int row = row0 + ai * 128 + m * 16;
                    f32x4 r[2], sg[2];
#pragma unroll
                    for (int n = 0; n < 2; ++n) {
                        const f32x4 b = acc[ai][1][m][n];
                        const f32x4 one = (f32x4){1.0f + __builtin_amdgcn_exp2f(-1.4426950408889634f * b[0]), 1.0f + __builtin_amdgcn_exp2f(-1.4426950408889634f * b[1]),
                                                  1.0f + __builtin_amdgcn_exp2f(-1.4426950408889634f * b[2]), 1.0f + __builtin_amdgcn_exp2f(-1.4426950408889634f * b[3])};
                        sg[n] = (f32x4){__builtin_amdgcn_rcpf(one[0]), __builtin_amdgcn_rcpf(one[1]), __builtin_amdgcn_rcpf(one[2]), __builtin_amdgcn_rcpf(one[3])};
                        r[n] = sig4(acc[ai][0][m][n]) * one;
                    }
                    *(u32x4*)(rbase + (size_t)row * 1024) = pack8(r[0], r[1]);
                    *(u32x4*)(sbase + (size_t)row * 1024) = pack8(sg[0], sg[1]);
                    asm volatile("" ::: "memory");
                }
        } else if (pn < 8) {
            bf16_t* vt = QK + (size_t)TS * 1024;
#pragma unroll
            for (int ai = 0; ai < 2; ++ai)
#pragma unroll
                for (int m = 0; m < 4; ++m) {
                    const int e = ai * 128 + wr * 64 + m * 16 + fr;
#pragma unroll
                    for (int bj = 0; bj < 2; ++bj)
                        *(u32x4*)(vt + (((size_t)(u.pm * 2 + bj) * 4 + (pn - 4)) * 256 + e) * 128 + cl) = pack8(acc[ai][bj][m][0], acc[ai][bj][m][1]);
                }
        } else {
            const int act = pn < 8 ? 0 : pn < 12 ? 1 : pn < 24 ? 2 : 3;
            const int bidx = pn < 8 ? 1 : pn < 12 ? 3 + sl : pn < 24 ? 2 : pn < 28 ? 7 + sl : 9 + sl;
            const int tl = pn < 8 ? pn - 4 : pn < 12 ? pn - 8 : pn < 24 ? pn - 20 : pn < 28 ? pn - 24 : pn - 28;
            bf16_t* base = QK + (size_t)bidx * ((size_t)TS * 1024) + tl * 256 + cl;
#pragma unroll
            for (int ai = 0; ai < 2; ++ai)
#pragma unroll
                for (int m = 0; m < 4; ++m) {
                    const int row = row0 + ai * 128 + m * 16; float ssum = 0.f, ssq = 0.f;
#pragma unroll
                    for (int bj = 0; bj < 2; ++bj) {
                        f32x4 a = acc[ai][bj][m][0], b = acc[ai][bj][m][1];
                        if (act == 1) { a = a * sig4(a); b = b * sig4(b); }
                        else if (act == 2) { a = gelu4(a); b = gelu4(b);
                            ssum += ((a[0] + a[1]) + (a[2] + a[3])) + ((b[0] + b[1]) + (b[2] + b[3]));
                            ssq += ((a[0] * a[0] + a[1] * a[1]) + (a[2] * a[2] + a[3] * a[3])) + ((b[0] * b[0] + b[1] * b[1]) + (b[2] * b[2] + b[3] * b[3])); }
                        else if (act == 3) { a = sig4(a); b = sig4(b); }
                        *(u32x4*)(base + (size_t)row * 1024 + bj * 128) = pack8(a, b);
                    }
                    if (act == 2) {
                        ssum += __shfl_xor(ssum, 16); ssum += __shfl_xor(ssum, 32); ssq += __shfl_xor(ssq, 16); ssq += __shfl_xor(ssq, 32);
                        if (fq == 0) *(f32x2*)(svs + (size_t)row * 32 + tl * 8 + wc * 2) = (f32x2){ssum, ssq};
                    }
                }
        }
    }
};
struct Epi6 {
    static constexpr bool PERM = true;
    const bf16_t* MR; const bf16_t* MS; bf16_t* O;
    __device__ __forceinline__ bool keep(const Unit& u) const { return u.part == 0; }
    __device__ __forceinline__ void operator()(AccT& acc, const Unit& u, int wr, int wc, int fr, int fq) const {
        const int row0 = u.pm * 256 + wr * 64 + fr, col0 = u.pn * 256 + wc * 32 + 8 * fq;
        u32x4 sb[4][2];
#define E6_LD(g) do { _Pragma("unroll") for (int bj = 0; bj < 2; ++bj) { const size_t off_ = (size_t)(row0 + ((g) >> 2) * 128 + ((g) & 3) * 16) * 1024 + col0 + bj * 128; \
            if (u.part == 0) sb[(g) & 3][bj] = *(const u32x4*)(MR + off_); else sb[(g) & 3][bj] = *(const u32x4*)(MS + off_); } } while (0)
        E6_LD(0); E6_LD(1); E6_LD(2);
#pragma unroll
        for (int g = 0; g < 8; ++g) {
            if (g + 3 < 8) E6_LD(g + 3);
            const int ai = g >> 2, m = g & 3;
#pragma unroll
            for (int bj = 0; bj < 2; ++bj) {
                const size_t off = (size_t)(row0 + ai * 128 + m * 16) * 1024 + col0 + bj * 128;
                f32x4 sa, sbv; unpack8(sb[g & 3][bj], sa, sbv);
                if (u.part == 0) {
#pragma unroll
                    for (int j = 0; j < 4; ++j) { acc[ai][bj][m][0][j] *= sa[j]; acc[ai][bj][m][1][j] *= sbv[j]; }
                } else {
                    *(u32x4*)(O + off) = pack8(acc[ai][bj][m][0] * sa, acc[ai][bj][m][1] * sbv);
                }
            }
        }
#undef E6_LD
    }
};
struct EpiStore {
    static constexpr bool PERM = true;
    bf16_t* O;
    __device__ __forceinline__ bool keep(const Unit&) const { return false; }
    __device__ __forceinline__ void operator()(AccT& acc, const Unit& u, int wr, int wc, int fr, int fq) const {
        const int row0 = u.pm * 256 + wr * 64 + fr, col0 = u.pn * 256 + wc * 32 + 8 * fq;
#pragma unroll
        for (int ai = 0; ai < 2; ++ai)
#pragma unroll
            for (int m = 0; m < 4; ++m)
#pragma unroll
                for (int bj = 0; bj < 2; ++bj)
                    *(u32x4*)(O + (size_t)(row0 + ai * 128 + m * 16) * 1024 + col0 + bj * 128) = pack8(acc[ai][bj][m][0], acc[ai][bj][m][1]);
    }
};
struct Epi7 {
    static constexpr bool PERM = true;
    const bf16_t* hb; const float* rs0; const float* gm; bf16_t* X1B; float* rsq; int tok0;
    __device__ __forceinline__ bool keep(const Unit&) const { return false; }
    __device__ __forceinline__ void operator()(AccT& acc, const Unit& u, int wr, int wc, int fr, int fq) const {
        const int row0 = u.pm * 256 + wr * 64 + fr, col0 = u.pn * 256 + wc * 32 + 8 * fq;
        f32x4 ig[2][2];
#pragma unroll
        for (int bj = 0; bj < 2; ++bj)
#pragma unroll
            for (int n = 0; n < 2; ++n) { const f32x4 g4 = *(const f32x4*)(gm + col0 + bj * 128 + n * 4);
                ig[bj][n] = (f32x4){__builtin_amdgcn_rcpf(g4[0]), __builtin_amdgcn_rcpf(g4[1]), __builtin_amdgcn_rcpf(g4[2]), __builtin_amdgcn_rcpf(g4[3])}; }
        u32x4 xb[4][2]; float rsv[4];
#define E7_LD(g) do { const size_t tr_ = (size_t)tok0 + row0 + ((g) >> 2) * 128 + ((g) & 3) * 16; rsv[(g) & 3] = rs0[tr_]; \
            _Pragma("unroll") for (int bj = 0; bj < 2; ++bj) xb[(g) & 3][bj] = *(const u32x4*)(hb + tr_ * 1024 + col0 + bj * 128); } while (0)
        E7_LD(0); E7_LD(1); E7_LD(2);
#pragma unroll
        for (int g = 0; g < 8; ++g) {
            if (g + 3 < 8) E7_LD(g + 3);
            const int ai = g >> 2, m = g & 3, row = row0 + ai * 128 + m * 16; const size_t tok = (size_t)tok0 + row; float ss = 0.f;
            const float sr = rsv[g & 3];
#pragma unroll
            for (int bj = 0; bj < 2; ++bj) {
                f32x4 ha, hb2; unpack8(xb[g & 3][bj], ha, hb2);
                const f32x4 o0 = ha * sr * ig[bj][0] + acc[ai][bj][m][0], o1 = hb2 * sr * ig[bj][1] + acc[ai][bj][m][1];
                *(u32x4*)(X1B + (size_t)row * 1024 + col0 + bj * 128) = pack8(o0, o1);
                ss += ((o0[0] * o0[0] + o0[1] * o0[1]) + (o0[2] * o0[2] + o0[3] * o0[3])) + ((o1[0] * o1[0] + o1[1] * o1[1]) + (o1[2] * o1[2] + o1[3] * o1[3]));
            }
            ss += __shfl_xor(ss, 16); ss += __shfl_xor(ss, 32);
            if (fq == 0) rsq[tok * 16 + u.pn * 4 + wc] = ss;
        }
#undef E7_LD
    }
};
struct Epi8 {
    static constexpr bool PERM = true;
    const bf16_t* X1B; bf16_t* X2B; const bf16_t* PP; const float* rsq1; float* rsq2; int tok0;
    __device__ __forceinline__ bool keep(const Unit&) const { return false; }
    __device__ __forceinline__ void operator()(AccT& acc, const Unit& u, int wr, int wc, int fr, int fq) const {
        const int row0 = u.pm * 256 + wr * 64 + fr, col0 = u.pn * 256 + wc * 32 + 8 * fq;
        float rs[8];
        {   f32x4 sl[8];
#pragma unroll
            for (int r = 0; r < 8; ++r) sl[r] = *(const f32x4*)(rsq1 + ((size_t)tok0 + row0 + (r >> 2) * 128 + (r & 3) * 16) * 16 + 4 * fq);
#pragma unroll
            for (int r = 0; r < 8; ++r) { float t = (sl[r][0] + sl[r][1]) + (sl[r][2] + sl[r][3]); t += __shfl_xor(t, 16); t += __shfl_xor(t, 32); rs[r] = t; } }
        u32x4 pb[4][2], xb[4][2];
#define E8_LD(g) do { _Pragma("unroll") for (int bj = 0; bj < 2; ++bj) { \
            const size_t off_ = (size_t)(row0 + ((g) >> 2) * 128 + ((g) & 3) * 16) * 1024 + col0 + bj * 128; \
            pb[(g) & 3][bj] = *(const u32x4*)(PP + off_); xb[(g) & 3][bj] = *(const u32x4*)(X1B + off_); } } while (0)
        E8_LD(0); E8_LD(1); E8_LD(2);
#pragma unroll
        for (int g = 0; g < 8; ++g) {
            if (g + 3 < 8) E8_LD(g + 3);
            const int ai = g >> 2, m = g & 3, row = row0 + ai * 128 + m * 16; const size_t tok = (size_t)tok0 + row; float ss = 0.f;
            const float rstd = rsqrtf(rs[g] * (1.0f / 1024.0f) + 1e-6f);
#pragma unroll
            for (int bj = 0; bj < 2; ++bj) {
                const size_t off = (size_t)row * 1024 + col0 + bj * 128;
                f32x4 pa, pc, xa, xc; unpack8(pb[g & 3][bj], pa, pc); unpack8(xb[g & 3][bj], xa, xc);
                const f32x4 o0 = xa + sig4(acc[ai][bj][m][0] * rstd) * pa, o1 = xc + sig4(acc[ai][bj][m][1] * rstd) * pc;
                *(u32x4*)(X2B + off) = pack8(o0, o1);
                ss += ((o0[0] * o0[0] + o0[1] * o0[1]) + (o0[2] * o0[2] + o0[3] * o0[3])) + ((o1[0] * o1[0] + o1[1] * o1[1]) + (o1[2] * o1[2] + o1[3] * o1[3]));
            }
            ss += __shfl_xor(ss, 16); ss += __shfl_xor(ss, 32);
            if (fq == 0) rsq2[tok * 16 + u.pn * 4 + wc] = ss;
        }
#undef E8_LD
    }
};

__device__ __forceinline__ int srccol_win(int np) {
    const int pn = np >> 8, L = np & 255;
    if (pn < 4) { const int isk = pn >> 1, t = pn & 1, half = L >> 7, i = L & 127, head = 2 * t + (i >> 6), dim = (i & 63) + 64 * half; return isk * 512 + head * 128 + dim; }
    if (pn < 8) return 1024 + (pn - 4) * 256 + L;
    if (pn < 12) return 2048 + (pn - 8) * 256 + L;
    if (pn < 20) { const int t = pn - 12; return L < 128 ? 3072 + 128 * t + L : 5120 + 128 * t + (L - 128); }
    if (pn < 24) return 4096 + (pn - 20) * 256 + L;
    { const int t = pn - 24; return L < 128 ? 6144 + 128 * t + L : 7168 + 128 * t + (L - 128); }
}
__device__ __forceinline__ void p0_transpose(LAS float* tile, const float* src, int ldsrc, int k0, int c0, bf16_t* dst, int ldk, int n0, const float* kscale, int tid) {
#pragma unroll
    for (int p = 0; p < 2; ++p) {
        const int r = (tid >> 4) + 32 * p, c4 = (tid & 15) * 4;
        const f32x4 v = *(const f32x4*)(src + (size_t)(k0 + r) * ldsrc + c0 + c4);
        const float s = kscale ? kscale[k0 + r] : 1.0f;
        tile[r * 65 + c4 + 0] = v[0] * s; tile[r * 65 + c4 + 1] = v[1] * s; tile[r * 65 + c4 + 2] = v[2] * s; tile[r * 65 + c4 + 3] = v[3] * s;
    }
    __syncthreads();
    {
        const int n = tid >> 3, kc = (tid & 7) * 8;
        u32x4 w;
        w.x = cvt_pk_bf16(tile[(kc + 0) * 65 + n], tile[(kc + 1) * 65 + n]); w.y = cvt_pk_bf16(tile[(kc + 2) * 65 + n], tile[(kc + 3) * 65 + n]);
        w.z = cvt_pk_bf16(tile[(kc + 4) * 65 + n], tile[(kc + 5) * 65 + n]); w.w = cvt_pk_bf16(tile[(kc + 6) * 65 + n], tile[(kc + 7) * 65 + n]);
        *(u32x4*)(dst + (size_t)(n0 + n) * ldk + k0 + kc) = w;
    }
    __syncthreads();
}

struct Params { const float *x, *p, *w_in, *w_ret, *w_sgu, *w_out, *sws, *sbs, *wpg, *wpp, *gm, *gp, *gf; float* out; unsigned char* ws; };

__device__ __forceinline__ void phase0(const Params& P, LAS unsigned char* lds, int tid, int wid, int lane) {
    unsigned char* ws = P.ws;
    const int G = gridDim.x, bx = blockIdx.x;
    LAS float* tile = (LAS float*)lds;
    for (int idx = bx; idx < 3136; idx += G) {
        if (idx < 2048) { const int kt = idx & 15, ntl = idx >> 4; p0_transpose(tile, P.w_in, 8192, kt * 64, srccol_win(ntl * 64), (bf16_t*)(ws + WS_WIN), 1024, ntl * 64, nullptr, tid); }
        else if (idx < 3072) { const int w = (idx - 2048) >> 8, r = (idx - 2048) & 255, kt = r & 15, ntl = r >> 4;
            const float* src = w == 0 ? P.w_ret : w == 1 ? P.w_sgu : w == 2 ? P.w_out : P.wpg;
            bf16_t* dst = (bf16_t*)(ws + (w == 0 ? WS_WR : w == 1 ? WS_WS : w == 2 ? WS_WO : WS_WG));
            p0_transpose(tile, src, 1024, kt * 64, ntl * 64, dst, 1024, ntl * 64, w == 3 ? P.gp : nullptr, tid); }
        else { const int r = idx - 3072, kt = r & 3, ntl = r >> 2; p0_transpose(tile, P.wpp, 1024, kt * 64, ntl * 64, (bf16_t*)(ws + WS_WPP), 256, ntl * 64, nullptr, tid); }
    }
    const int gt = bx * NTHR + tid, gn = G * NTHR;
    for (int i = gt; i < 4 * 128 * 128; i += gn) { const int r = (i >> 7) & 127, c = i & 127; const float v = c <= r ? P.sws[i] : 0.0f; ((bf16_t*)(ws + WS_WC))[i] = (bf16_t)(cvt_pk_bf16(v, 0.f) & 0xffffu); }
    for (int i = gt; i < 4096 * 64; i += gn) {
        const int pos = i >> 6, j = i & 63;
        const float inv = exp2f(-(float)j * (13.287712379549449f / 64.0f));
        const float ang = (float)pos * inv;
        const double a = (double)ang; const double nrev = rint(a * 0.15915494309189535); const float r = (float)(a - nrev * 6.283185307179586);
        ((float*)(ws + WS_COS))[i] = cosf(r); ((float*)(ws + WS_SIN))[i] = sinf(r);
    }
    for (size_t i = (size_t)gt * 8; i < (size_t)T_ALL * 256; i += (size_t)gn * 8) {
        const f32x4 a = *(const f32x4*)(P.p + i), b = *(const f32x4*)(P.p + i + 4);
        *(u32x4*)((bf16_t*)(ws + WS_PB) + i) = pack8(a, b);
    }
    {
        f32x4 gv[4];
#pragma unroll
        for (int i = 0; i < 4; ++i) gv[i] = *(const f32x4*)(P.gm + lane * 4 + 256 * i);
        for (int row = bx * 8 + wid; row < T_ALL; row += G * 8) {
            const float* xr = P.x + (size_t)row * 1024; f32x4 v[4]; float ss = 0.f;
#pragma unroll
            for (int i = 0; i < 4; ++i) { v[i] = *(const f32x4*)(xr + lane * 4 + 256 * i); ss += (v[i][0] * v[i][0] + v[i][1] * v[i][1]) + (v[i][2] * v[i][2] + v[i][3] * v[i][3]); }
            ss = wave_sum(ss);
            const float rstd = rsqrtf(ss * (1.0f / 1024.0f) + 1e-6f);
            if (lane == 0) ((float*)(ws + WS_RS0))[row] = sqrtf(ss * (1.0f / 1024.0f) + 1e-6f);
            bf16_t* hr = (bf16_t*)(ws + WS_H) + (size_t)row * 1024;
#pragma unroll
            for (int i = 0; i < 4; ++i) *(u32x2*)(hr + lane * 4 + 256 * i) = pack4(v[i] * rstd * gv[i]);
        }
    }
}

template <int ROWS, int COLS> struct TileRegs { u32x4 v[ROWS * (COLS / 8) / NTHR]; };
template <int ROWS, int COLS>
__device__ __forceinline__ void tile_load(TileRegs<ROWS, COLS>& t, const bf16_t* src, size_t gp, int tid) {
    constexpr int CPR = COLS / 8, IT = ROWS * CPR / NTHR;
#pragma unroll
    for (int i = 0; i < IT; ++i) { const int c = tid + i * NTHR, r = c / CPR, ch = c % CPR; t.v[i] = *(const u32x4*)(src + (size_t)r * gp + ch * 8); }
}
template <int ROWS, int COLS>
__device__ __forceinline__ void tile_store_b128(const TileRegs<ROWS, COLS>& t, LAS unsigned char* dst, int lp, int tid) {
    constexpr int CPR = COLS / 8, IT = ROWS * CPR / NTHR;
#pragma unroll
    for (int i = 0; i < IT; ++i) { const int c = tid + i * NTHR, r = c / CPR, ch = c % CPR; *(LAS u32x4*)(dst + r * lp + ch * 16) = t.v[i]; }
}
template <int ROWS, int COLS>
__device__ __forceinline__ void tile_store_b32(const TileRegs<ROWS, COLS>& t, LAS unsigned char* dst, int lp, int tid) {
    constexpr int CPR = COLS / 8, IT = ROWS * CPR / NTHR;
#pragma unroll
    for (int i = 0; i < IT; ++i) { const int c = tid + i * NTHR, r = c / CPR, ch = c % CPR; LAS unsigned* d = (LAS unsigned*)(dst + r * lp + ch * 16); d[0] = t.v[i].x; d[1] = t.v[i].y; d[2] = t.v[i].z; d[3] = t.v[i].w; }
}
__device__ __forceinline__ void gather8(const LAS unsigned char* base, int pitch, int r0, int col, unsigned short (&o)[8]) {
    const LAS unsigned char* p = base + r0 * pitch + col * 2;
#pragma unroll
    for (int j = 0; j < 8; ++j) o[j] = *(const LAS unsigned short*)(p + j * pitch);
}
__device__ __forceinline__ bf16x8 mk8(const unsigned short (&o)[8]) { bf16x8 r;
#pragma unroll
    for (int j = 0; j < 8; ++j) r[j] = (short)o[j];
    return r; }

__device__ __forceinline__ void p2_unit(LAS unsigned char* lds, const bf16_t* QK, const bf16_t* V, bf16_t* KV, int unit, int tid, int wid, int lane) {
    const int fr = lane & 15, fq = lane >> 4, h = unit & 3; const size_t tok0 = (size_t)(unit >> 2) * 128; const float lg = lgam(h);
    LAS unsigned char* sK = lds; LAS unsigned char* sV = lds + 33280;
    TileRegs<128, 128> tk; TileRegs<256, 128> tv;
    asm volatile("" : "+v"(tid));
    tile_load(tk, QK + tok0 * 1024 + 512 + h * 128, 1024, tid);
    tile_load(tv, V + (size_t)unit * 32768, 128, tid);
    __syncthreads();
    tile_store_b32(tk, sK, 260, tid);
    tile_store_b128(tv, sV, 272, tid);
    __syncthreads();
    f32x4 acc[2][8];
#pragma unroll
    for (int a = 0; a < 2; ++a)
#pragma unroll
        for (int b = 0; b < 8; ++b) acc[a][b] = (f32x4){0.f, 0.f, 0.f, 0.f};
#pragma unroll
    for (int ks = 0; ks < 4; ++ks) {
        const int j0 = 32 * ks + 8 * fq;
        bf16x8 vf[2];
#pragma unroll
        for (int e2 = 0; e2 < 2; ++e2) {
            const u32x4 vr = *(const LAS u32x4*)(sV + (16 * (2 * wid + e2) + fr) * 272 + j0 * 2);
            u32x4 w;
            w.x = cvt_pk_bf16(bf_lo(vr.x) * fexp(lg * (float)(127 - j0 - 0)), bf_hi(vr.x) * fexp(lg * (float)(127 - j0 - 1)));
            w.y = cvt_pk_bf16(bf_lo(vr.y) * fexp(lg * (float)(127 - j0 - 2)), bf_hi(vr.y) * fexp(lg * (float)(127 - j0 - 3)));
            w.z = cvt_pk_bf16(bf_lo(vr.z) * fexp(lg * (float)(127 - j0 - 4)), bf_hi(vr.z) * fexp(lg * (float)(127 - j0 - 5)));
            w.w = cvt_pk_bf16(bf_lo(vr.w) * fexp(lg * (float)(127 - j0 - 6)), bf_hi(vr.w) * fexp(lg * (float)(127 - j0 - 7)));
            vf[e2] = __builtin_bit_cast(bf16x8, w);
        }
#pragma unroll
        for (int db = 0; db < 8; ++db) {
            unsigned short o[8]; gather8(sK, 260, j0, 16 * db + fr, o);
            const bf16x8 kf = mk8(o);
#pragma unroll
            for (int e2 = 0; e2 < 2; ++e2) acc[e2][db] = __builtin_amdgcn_mfma_f32_16x16x32_bf16(kf, vf[e2], acc[e2][db], 0, 0, 0);
        }
    }
    bf16_t* dst = KV + (size_t)unit * 32768;
#pragma unroll
    for (int e2 = 0; e2 < 2; ++e2)
#pragma unroll
        for (int db = 0; db < 8; ++db) *(u32x2*)(dst + (16 * (2 * wid + e2) + fr) * 128 + 16 * db + 4 * fq) = pack4(acc[e2][db]);
}

__device__ __forceinline__ void p4_unit(LAS unsigned char* lds, const bf16_t* QK, const bf16_t* V, const bf16_t* PREV, const bf16_t* RG, bf16_t* RO, int unit, int tid, int wid, int lane) {
    const int fr = lane & 15, fq = lane >> 4, h = unit & 3; const size_t tok0 = (size_t)(unit >> 2) * 128; const float lg = lgam(h);
    LAS unsigned char* sK = lds; LAS unsigned char* sP = lds + 34816;
    TileRegs<128, 128> tk; TileRegs<256, 128> tp; TileRegs<256, 128> tv;
    asm volatile("" : "+v"(tid));
    tile_load(tk, QK + tok0 * 1024 + 512 + h * 128, 1024, tid);
    tile_load(tp, PREV + (size_t)unit * 32768, 128, tid);
    bf16x8 qf[4];
    { const bf16_t* qrow = QK + (tok0 + 16 * wid + fr) * 1024 + h * 128 + 8 * fq;
#pragma unroll
      for (int ks = 0; ks < 4; ++ks) qf[ks] = *(const bf16x8*)(qrow + 32 * ks); }
    __syncthreads();
    tile_store_b128(tk, sK, 272, tid);
    tile_store_b128(tp, sP, 272, tid);
    asm volatile("" : "+v"(tid));
    tile_load(tv, V + (size_t)unit * 32768, 128, tid);
    __syncthreads();
    f32x4 sacc[8];
#pragma unroll
    for (int jb = 0; jb < 8; ++jb) {
        sacc[jb] = (f32x4){0.f, 0.f, 0.f, 0.f};
        if (jb <= wid) {
#pragma unroll
            for (int ks = 0; ks < 4; ++ks) { const bf16x8 kf = *(const LAS bf16x8*)(sK + (16 * jb + fr) * 272 + (32 * ks + 8 * fq) * 2); sacc[jb] = __builtin_amdgcn_mfma_f32_16x16x32_bf16(kf, qf[ks], sacc[jb], 0, 0, 0); }
        }
    }
    f32x4 acc[16];
    const int i = 16 * wid + fr; const float xi = fexp(lg * (float)(i + 1));
#pragma unroll
    for (int eb = 0; eb < 16; ++eb) {
        f32x4 a = (f32x4){0.f, 0.f, 0.f, 0.f};
#pragma unroll
        for (int ks = 0; ks < 4; ++ks) { const bf16x8 pf = *(const LAS bf16x8*)(sP + (32 * (eb >> 1) + 8 * (fr >> 2) + 4 * (eb & 1) + (fr & 3)) * 272 + (32 * ks + 8 * fq) * 2); a = __builtin_amdgcn_mfma_f32_16x16x32_bf16(pf, qf[ks], a, 0, 0, 0); }
        acc[eb] = a * xi;
    }
    bf16x8 pfr[4];
#pragma unroll
    for (int ks = 0; ks < 4; ++ks) {
        float pv[8];
#pragma unroll
        for (int hf = 0; hf < 2; ++hf)
#pragma unroll
            for (int r = 0; r < 4; ++r) { const int jb = 2 * ks + hf, j = 16 * jb + 4 * fq + r; pv[4 * hf + r] = (j <= i) ? sacc[jb][r] * fexp(lg * (float)(i - j)) : 0.0f; }
        u32x4 w; w.x = cvt_pk_bf16(pv[0], pv[1]); w.y = cvt_pk_bf16(pv[2], pv[3]); w.z = cvt_pk_bf16(pv[4], pv[5]); w.w = cvt_pk_bf16(pv[6], pv[7]);
        pfr[ks] = __builtin_bit_cast(bf16x8, w);
    }
    __syncthreads();
    asm volatile("" : "+v"(tid));
    tile_store_b128(tv, lds, 272, tid);
    __syncthreads();
#pragma unroll
    for (int ks = 0; ks < 4; ++ks) {
        if (2 * ks <= wid) {
#pragma unroll
            for (int eb = 0; eb < 16; ++eb) {
                const LAS unsigned char* p = lds + (32 * (eb >> 1) + 8 * (fr >> 2) + 4 * (eb & 1) + (fr & 3)) * 272 + (32 * ks + 4 * fq) * 2;
                const u32x2 lo = *(const LAS u32x2*)p, hi = *(const LAS u32x2*)(p + 32);
                const u32x4 w = (u32x4){lo.x, lo.y, hi.x, hi.y};
                acc[eb] = __builtin_amdgcn_mfma_f32_16x16x32_bf16(__builtin_bit_cast(bf16x8, w), pfr[ks], acc[eb], 0, 0, 0);
            }
        }
    }
    float s = 0.f;
#pragma unroll
    for (int eb = 0; eb < 16; ++eb) s += (acc[eb][0] + acc[eb][1]) + (acc[eb][2] + acc[eb][3]);
    s += __shfl_xor(s, 16); s += __shfl_xor(s, 32);
    const float mu = s * (1.0f / 256.0f); float q = 0.f;
#pragma unroll
    for (int eb = 0; eb < 16; ++eb) { const f32x4 d = acc[eb] - mu; q += (d[0] * d[0] + d[1] * d[1]) + (d[2] * d[2] + d[3] * d[3]); }
    q += __shfl_xor(q, 16); q += __shfl_xor(q, 32);
    const float rstd = rsqrtf(q * (1.0f / 256.0f) + 1e-5f);
    const bf16_t* rgrow = RG + (tok0 + i) * 1024 + h * 256 + 8 * fq; bf16_t* rorow = RO + (tok0 + i) * 1024 + h * 256 + 8 * fq;
    u32x4 gl[8];
#pragma unroll
    for (int k = 0; k < 8; ++k) gl[k] = *(const u32x4*)(rgrow + 32 * k);
#pragma unroll
    for (int k = 0; k < 8; ++k) { f32x4 ga, gb; unpack8(gl[k], ga, gb); *(u32x4*)(rorow + 32 * k) = pack8((acc[2 * k] - mu) * rstd * ga, (acc[2 * k + 1] - mu) * rstd * gb); }
}

__device__ __forceinline__ void p5_unit(LAS unsigned char* lds, const bf16_t* SV, const float* SVS, bf16_t* UO, const bf16_t* WC, const float* bias, int chunk, int tid, int wid, int lane) {
    const int fr = lane & 15, fq = lane >> 4; const size_t tok0 = (size_t)chunk * 128;
    LAS unsigned char* sW = lds; LAS unsigned char* sV = lds + 34816; LAS float* st = (LAS float*)(lds + 34816 + 66048);
    __syncthreads();
    {
        const int r = 16 * wid + (lane >> 2);
        const float* sp = SVS + (tok0 + r) * 32 + (lane & 3) * 8;
        const f32x4 p0 = *(const f32x4*)sp, p1 = *(const f32x4*)(sp + 4);
        float sm = (p0[0] + p0[2]) + (p1[0] + p1[2]), sq = (p0[1] + p0[3]) + (p1[1] + p1[3]);
        sm += __shfl_xor(sm, 1); sm += __shfl_xor(sm, 2); sq += __shfl_xor(sq, 1); sq += __shfl_xor(sq, 2);
        const float mu = sm * (1.0f / 1024.0f), var = fmaxf(sq * (1.0f / 1024.0f) - mu * mu, 0.0f);
        if ((lane & 3) == 0) { st[2 * r] = mu; st[2 * r + 1] = rsqrtf(var + 1e-5f); }
    }
    TileRegs<128, 128> tw; TileRegs<128, 256> tv;
    { int tg = tid; asm volatile("" : "+v"(tg)); tile_load(tw, WC, 128, tg); tile_load(tv, SV + tok0 * 1024, 1024, tg); }
    for (int g = 0; g < 4; ++g) {
        __syncthreads();
        tile_store_b128(tw, sW, 272, tid);
#pragma unroll
        for (int i = 0; i < 8; ++i) {
            const int c = tid + i * NTHR, r = c >> 5, ch = c & 31;
            f32x4 a, b; unpack8(tv.v[i], a, b);
            const float mu = st[2 * r], rs = st[2 * r + 1];
            const u32x4 w = pack8((a - mu) * rs, (b - mu) * rs);
            LAS unsigned* d = (LAS unsigned*)(sV + r * 516 + ch * 16); d[0] = w.x; d[1] = w.y; d[2] = w.z; d[3] = w.w;
        }
        __syncthreads();
        int tg = tid; asm volatile("" : "+v"(tg));
        if (g < 3) { tile_load(tw, WC + (g + 1) * 16384, 128, tg); tile_load(tv, SV + tok0 * 1024 + (g + 1) * 256, 1024, tg); }
        u32x4 ul[8]; float bvl[8];
        {   const int lfr = tg & 15, lfq = (tg & 63) >> 4;
#pragma unroll
            for (int ib = 0; ib < 8; ++ib) { bvl[ib] = bias[g * 128 + 16 * ib + lfr];
                ul[ib] = *(const u32x4*)(UO + (tok0 + 16 * ib + lfr) * 1024 + g * 256 + 32 * wid + 8 * lfq); } }
        f32x4 acc[8][2];
#pragma unroll
        for (int a = 0; a < 8; ++a)
#pragma unroll
            for (int b = 0; b < 2; ++b) acc[a][b] = (f32x4){0.f, 0.f, 0.f, 0.f};
#pragma unroll
        for (int ks = 0; ks < 4; ++ks) {
            bf16x8 vf[2];
#pragma unroll
            for (int c2 = 0; c2 < 2; ++c2) { unsigned short o[8]; gather8(sV, 516, 32 * ks + 8 * fq, 32 * wid + 8 * (fr >> 2) + 4 * c2 + (fr & 3), o); vf[c2] = mk8(o); }
#pragma unroll
            for (int ib = 0; ib < 8; ++ib) {
                if (ib >= 2 * ks) {
                    const bf16x8 wf = *(const LAS bf16x8*)(sW + (16 * ib + fr) * 272 + (32 * ks + 8 * fq) * 2);
#pragma unroll
                    for (int c2 = 0; c2 < 2; ++c2) acc[ib][c2] = __builtin_amdgcn_mfma_f32_16x16x32_bf16(vf[c2], wf, acc[ib][c2], 0, 0, 0);
                }
            }
        }
#pragma unroll
        for (int ib = 0; ib < 8; ++ib) { f32x4 ua, ub; unpack8(ul[ib], ua, ub);
            *(u32x4*)(UO + (tok0 + 16 * ib + fr) * 1024 + g * 256 + 32 * wid + 8 * fq) = pack8((acc[ib][0] + bvl[ib]) * ua, (acc[ib][1] + bvl[ib]) * ub); }
    }
}

#define XB_TMO      128
#define XB_XCNT(j)  (256  + 64 * (j))
#define XB_XSUB(j)  (1280 + 64 * (j))
#define XB_XGEN(j)  (2304 + 64 * (j))
#define XB_TOP      3328
#define XB_TOPGEN   3392
#define XCD_BAR_WORDS 3456
#define XB_SPIN_CAP (1u << 22)
__device__ __forceinline__ unsigned xb_ld(unsigned* p)              { return __hip_atomic_load(p, __ATOMIC_RELAXED, __HIP_MEMORY_SCOPE_AGENT); }
__device__ __forceinline__ unsigned xb_add(unsigned* p, unsigned v) { return __hip_atomic_fetch_add(p, v, __ATOMIC_RELAXED, __HIP_MEMORY_SCOPE_AGENT); }
__device__ __forceinline__ unsigned xb_xcc_id() { return (unsigned)__builtin_amdgcn_s_getreg((3 << 11) | 20) & 0xFu; }
#define XB_SPIN(cond, bar) do { unsigned _sp = 0; while (cond) { __builtin_amdgcn_s_sleep(1); \
    if ((++_sp & 255u) == 0u) { if (xb_ld(&(bar)[XB_TMO])) break; if (_sp > XB_SPIN_CAP) { atomicAdd(&(bar)[XB_TMO], 1u); break; } } } } while (0)
struct XcdBarrier { unsigned* bar; unsigned x; volatile LAS unsigned* st; };
__device__ __forceinline__ XcdBarrier xcd_barrier_post(unsigned* bar, volatile LAS unsigned* st) {
    XcdBarrier b; b.bar = bar; b.x = xb_xcc_id(); b.st = st;
    if (threadIdx.x == 0) (void)xb_add(&bar[XB_XCNT(b.x)], 1u);
    return b;
}
__device__ __forceinline__ void xcd_barrier_complete(unsigned* bar, unsigned x, unsigned& nloc, unsigned& nx) {
    const unsigned G = gridDim.x * gridDim.y * gridDim.z;
    unsigned sum, cnt, mine, sp = 0u;
    for (;;) {
        sum = 0u; cnt = 0u; mine = 0u;
#pragma nounroll
        for (unsigned j = 0; j < 16; ++j) { const unsigned c = xb_ld(&bar[XB_XCNT(j)]); sum += c; cnt += (c > 0u) ? 1u : 0u; mine = (j == x) ? c : mine; }
        if (sum == G) break;
        __builtin_amdgcn_s_sleep(1);
        if ((++sp & 255u) == 0u) { if (xb_ld(&bar[XB_TMO])) break; if (sp > XB_SPIN_CAP) { atomicAdd(&bar[XB_TMO], 1u); break; } }
    }
    nloc = mine > 0u ? mine : 1u; nx = cnt > 0u ? cnt : 1u;
}
__device__ __forceinline__ void xcd_barrier(const XcdBarrier& b) {
    asm volatile("s_waitcnt vmcnt(0)" ::: "memory");
    __syncthreads();
    if (threadIdx.x == 0) {
        unsigned* bar = b.bar;
        __builtin_amdgcn_s_waitcnt(0);
        unsigned nloc = b.st[0], nx = b.st[1];
        if (nloc == 0u) { xcd_barrier_complete(bar, b.x, nloc, nx); b.st[0] = nloc; b.st[1] = nx; }
        const unsigned old = xb_add(&bar[XB_XSUB(b.x)], 1u);
        const unsigned gen = old / nloc;
        if (old + 1u == (gen + 1u) * nloc) {
            __builtin_amdgcn_fence(__ATOMIC_RELEASE, "agent");
            asm volatile("s_waitcnt vmcnt(0)" ::: "memory");
            const unsigned og = xb_add(&bar[XB_TOP], 1u);
            const unsigned tg = og / nx;
            if (og + 1u == (tg + 1u) * nx) xb_add(&bar[XB_TOPGEN], 1u);
            else XB_SPIN(xb_ld(&bar[XB_TOPGEN]) == tg, bar);
            __builtin_amdgcn_fence(__ATOMIC_ACQUIRE, "agent");
            xb_add(&bar[XB_XGEN(b.x)], 1u);
            asm volatile("s_waitcnt vmcnt(0)" ::: "memory");
        } else {
            XB_SPIN(xb_ld(&bar[XB_XGEN(b.x)]) == gen, bar);
            __builtin_amdgcn_fence(__ATOMIC_ACQUIRE, "agent");
            asm volatile("s_waitcnt vmcnt(0)" ::: "memory");
        }
    }
    __syncthreads();
}

#if defined(EXPM) && (EXPM & 64)
#define GSYNC() do { xcd_barrier(xbar); xcd_barrier(xbar); } while (0)
#else
#define GSYNC() xcd_barrier(xbar)
#endif
#define FRESH_IDS int tid_ = threadIdx.x; asm volatile("" : "+v"(tid_)); const int tid = tid_, wid = __builtin_amdgcn_readfirstlane(tid >> 6), lane = tid & 63; (void)wid; (void)lane;
__global__ void __launch_bounds__(NTHR, 2) mega(Params P) {
    extern __shared__ __attribute__((aligned(16))) unsigned char lds_raw[];
    LAS unsigned char* lds = (LAS unsigned char*)lds_raw;
    cg::grid_group grid = cg::this_grid();
    const int G = gridDim.x, bx = blockIdx.x;
    unsigned char* ws = P.ws;
    bf16_t* const WIN = (bf16_t*)(ws + WS_WIN); bf16_t* const WR = (bf16_t*)(ws + WS_WR); bf16_t* const WSG = (bf16_t*)(ws + WS_WS); bf16_t* const WO = (bf16_t*)(ws + WS_WO);
    bf16_t* const WG = (bf16_t*)(ws + WS_WG); bf16_t* const WPP = (bf16_t*)(ws + WS_WPP); bf16_t* const WC = (bf16_t*)(ws + WS_WC);
    float* const RSQ1 = (float*)(ws + WS_SV); float* const RSQ2 = (float*)(ws + WS_SV + 8 * MiB);
    bf16_t* const H = (bf16_t*)(ws + WS_H); bf16_t* const PB = (bf16_t*)(ws + WS_PB);
    bf16_t* const QK = (bf16_t*)(ws + WS_QK); bf16_t* const V = (bf16_t*)(ws + WS_V); bf16_t* const SV = (bf16_t*)(ws + WS_SV);
    bf16_t* const RG2 = (bf16_t*)(ws + WS_RG2); bf16_t* const UG2 = (bf16_t*)(ws + WS_UG2); bf16_t* const MR2 = (bf16_t*)(ws + WS_MR2); bf16_t* const MS2 = (bf16_t*)(ws + WS_MS2);
    bf16_t* const PREV = (bf16_t*)P.out;
    bf16_t* const MERGED = (bf16_t*)P.out; bf16_t* const X2B = H; bf16_t* const X1B = QK;
    bf16_t* const PP = (bf16_t*)(ws + WS_PP);
    volatile LAS unsigned* xst = (volatile LAS unsigned*)(lds + LDS_STAGE);
    if (threadIdx.x < 4) xst[threadIdx.x] = 0u;
    __syncthreads();
    const XcdBarrier xbar = xcd_barrier_post((unsigned*)(ws + WS_BAR), xst);

    { FRESH_IDS phase0(P, lds, tid, wid, lane); }
    if (P.ws == nullptr) grid.sync();

    for (int sl = 0; sl < NSL; ++sl) {
        const int tokb = sl * TS;
        bf16_t* const RG = RG2 + (size_t)tokb * 1024; bf16_t* const UG = UG2 + (size_t)tokb * 1024;
        GSYNC();
        {
            pg8::Src1V g{H + (size_t)tokb * 1024, WIN, 1024}; pg8::StaticOrder S; S.init(TS, 8192, G, bx);
            Epi1 E{QK, UG, (const float*)(ws + WS_COS), (const float*)(ws + WS_SIN), sl, (float*)((unsigned char*)P.out + 64 * MiB)};
            pg8::gemm_phase(lds, g, 1024, S, E);
        }
        GSYNC();
        { FRESH_IDS for (int u = bx; u < BSL * 32 * 4; u += G) p2_unit(lds, QK, V, PREV, u, tid, wid, lane); }
        { FRESH_IDS for (int c = bx; c < BSL * 32; c += G) p5_unit(lds, SV, (const float*)((unsigned char*)P.out + 64 * MiB), UG, WC, P.sbs, c, tid, wid, lane); }
        GSYNC();
        { FRESH_IDS
        for (int it = bx * NTHR + tid; it < BSL * 4 * 256 * 16; it += G * NTHR) {
            const int d8 = it & 15, e = (it >> 4) & 255, h = (it >> 12) & 3, bl = it >> 14;
            const float cd = fexp(128.0f * lgam(h));
            f32x4 run0 = (f32x4){0.f, 0.f, 0.f, 0.f}, run1 = (f32x4){0.f, 0.f, 0.f, 0.f};
            const size_t base = ((size_t)(bl * 32) * 4 + h) * 32768 + e * 128 + d8 * 8;
#pragma unroll 8
            for (int n = 0; n < 32; ++n) {
                const size_t o = base + (size_t)n * 4 * 32768;
                f32x4 k0, k1; unpack8(*(const u32x4*)(PREV + o), k0, k1);
                *(u32x4*)(PREV + o) = pack8(run0, run1);
                run0 = k0 + run0 * cd; run1 = k1 + run1 * cd;
            }
        } }
        GSYNC();
        { FRESH_IDS for (int u = bx; u < BSL * 32 * 4; u += G) p4_unit(lds, QK, V, PREV, RG, RG, u, tid, wid, lane); }
    }
    GSYNC();
    {
        pg8::Src2 g{RG2, WR, (long)((const char*)UG2 - (const char*)RG2), (long)((const char*)WSG - (const char*)WR), 1024}; pg8::DualOrder S; S.init(T_ALL, 1024, G, bx);
        Epi6 E{MR2, MS2, MERGED};
        pg8::gemm_phase(lds, g, 1024, S, E);
    }
    GSYNC();
    {
        pg8::Src1 g{MERGED, WO, 1024}; pg8::StaticOrder S; S.init(T_ALL, 1024, G, bx);
        Epi7 E{H, (const float*)(ws + WS_RS0), P.gm, X1B, RSQ1, 0};
        pg8::gemm_phase(lds, g, 1024, S, E);
        pg8::Src1 g2{PB, WPP, 256};
        EpiStore E2{PP};
        pg8::gemm_phase(lds, g2, 256, S, E2);
    }
    GSYNC();
    {
        pg8::Src1 g{X1B, WG, 1024}; pg8::StaticOrder S; S.init(T_ALL, 1024, G, bx);
        Epi8 E{X1B, X2B, PP, RSQ1, RSQ2, 0};
        pg8::gemm_phase(lds, g, 1024, S, E);
    }
    GSYNC();
    {
        FRESH_IDS
        f32x4 gv[4];
#pragma unroll
        for (int i = 0; i < 2; ++i) { gv[2 * i] = *(const f32x4*)(P.gf + lane * 8 + 512 * i); gv[2 * i + 1] = *(const f32x4*)(P.gf + lane * 8 + 512 * i + 4); }
        for (int row = bx * 8 + wid; row < T_ALL; row += G * 8) {
            float sq = RSQ2[(size_t)row * 16 + (lane & 15)]; sq += __shfl_xor(sq, 1); sq += __shfl_xor(sq, 2); sq += __shfl_xor(sq, 4); sq += __shfl_xor(sq, 8);
            const float rstd = rsqrtf(sq * (1.0f / 1024.0f) + 1e-6f); float* o = P.out + (size_t)row * 1024; const bf16_t* xr = X2B + (size_t)row * 1024;
#pragma unroll
            for (int i = 0; i < 2; ++i) { f32x4 a, b; unpack8(*(const u32x4*)(xr + lane * 8 + 512 * i), a, b);
                *(f32x4*)(o + lane * 8 + 512 * i) = a * rstd * gv[2 * i]; *(f32x4*)(o + lane * 8 + 512 * i + 4) = b * rstd * gv[2 * i + 1]; }
        }
    }
}

extern "C" void kernel_launch(void* const* d_in, const int* in_sizes, int n_in, void* d_out, int out_size, void* d_ws, size_t ws_size, hipStream_t stream) {
    static int grid_blocks = 0;
    if (grid_blocks == 0) {
        int dev = 0, cus = 0, per_cu = 0;
        hipGetDevice(&dev);
        hipDeviceGetAttribute(&cus, hipDeviceAttributeMultiprocessorCount, dev);
        if (hipFuncSetAttribute((const void*)mega, hipFuncAttributeMaxDynamicSharedMemorySize, LDS_BYTES) != hipSuccess) fprintf(stderr, "hipFuncSetAttribute failed\n");
        if (hipOccupancyMaxActiveBlocksPerMultiprocessor(&per_cu, (const void*)mega, NTHR, LDS_BYTES) != hipSuccess || per_cu < 1) { per_cu = 1; (void)hipGetLastError(); }
        grid_blocks = cus * (per_cu > 1 ? 1 : per_cu);
        if (ws_size < WS_END) fprintf(stderr, "workspace too small: %zu < %zu\n", ws_size, (size_t)WS_END);
    }
    Params p{};
    p.x = (const float*)d_in[0]; p.p = (const float*)d_in[1]; p.w_in = (const float*)d_in[2]; p.w_ret = (const float*)d_in[3]; p.w_sgu = (const float*)d_in[4];
    p.w_out = (const float*)d_in[5]; p.sws = (const float*)d_in[6]; p.sbs = (const float*)d_in[7]; p.wpg = (const float*)d_in[8]; p.wpp = (const float*)d_in[9];
    p.gm = (const float*)d_in[10]; p.gp = (const float*)d_in[11]; p.gf = (const float*)d_in[12];
    p.out = (float*)d_out; p.ws = (unsigned char*)d_ws;
    (void)hipMemsetAsync((char*)d_ws + WS_BAR, 0, XCD_BAR_WORDS * 4, stream);
    void* args[] = {&p};
    hipError_t e = hipLaunchCooperativeKernel((const void*)mega, dim3(grid_blocks), dim3(NTHR), args, LDS_BYTES, stream);
    if (e != hipSuccess) fprintf(stderr, "cooperative launch failed: %s (grid %d)\n", hipGetErrorString(e), grid_blocks);
}
```
